# Optimizing an MI355X kernel written in HIP

```python
import math
import jax, jax.numpy as jnp
from jax import lax
import numpy as np

D_MODEL = 1024
BATCH = 4
SEQ = 4096
DEPTH = 1
DEC_BATCH = 32
DEC_SEQ = 4
PAST_LEN = 8192
PAGE_SIZE = 128

HEAD_DIM = 64
N_HEADS = (D_MODEL // 2) // HEAD_DIM
H_KV = 2
GROUP = N_HEADS // H_KV
CMP_BLOCK = 32
CMP_STRIDE = 16
CMP_HIDDEN = 2 * HEAD_DIM
SEL_BLOCK = 64
TOP_N = 16
WINDOW = 512
D_CONV = D_MODEL // 2
CONV_WIDTH = 3
D_FF = 128 * ((8 * D_MODEL // 3 + 127) // 128)
N_BUCKETS = 32
MAX_DISTANCE = 128
Q_BLOCK = 64
N_SUB = 3
EPS = 1e-6
NEG_INF = -1e9
FORCE_BONUS = 1e3
IN_SIZES = (N_HEADS * HEAD_DIM, 2 * H_KV * HEAD_DIM, 2 * H_KV * HEAD_DIM, 2 * H_KV * HEAD_DIM,
            3 * N_HEADS, D_CONV, D_CONV, D_CONV, 2 * D_MODEL)
IN_WIDTH = sum(IN_SIZES)

kernel_name = "nsa_shortconv_macaron_adaln_step"


def rms_norm(x, g):
    xf = x.astype(jnp.float32)
    y = xf * lax.rsqrt(jnp.mean(xf * xf, axis=-1, keepdims=True) + EPS)
    return (y * g.astype(jnp.float32)).astype(x.dtype)


def modulate(x, g, shift, scale):
    return rms_norm(x, g) * (1 + scale[:, None, :]) + shift[:, None, :]


def swiglu(u, w_gu, w_down):
    gate, val = jnp.split(u @ w_gu, 2, axis=-1)
    return (jax.nn.silu(gate) * val) @ w_down


def masked_softmax(s, mask):
    s = s.astype(jnp.float32)
    m = jnp.max(jnp.where(mask, s, NEG_INF), axis=-1, keepdims=True)
    e = jnp.exp(jnp.where(mask, s - m, NEG_INF))
    return e / jnp.maximum(jnp.sum(e, axis=-1, keepdims=True), 1e-30)


def rel_bucket(dist):
    n = jnp.maximum(dist, 0)
    max_exact = N_BUCKETS // 2
    nf = jnp.maximum(n, 1).astype(jnp.float32)
    large = max_exact + (jnp.log(nf / max_exact) / math.log(MAX_DISTANCE / max_exact)
                         * (N_BUCKETS - max_exact)).astype(jnp.int32)
    return jnp.where(n < max_exact, n, jnp.minimum(large, N_BUCKETS - 1))


def pos_bias(qpos, kpos, rel_bias):
    b = rel_bias[rel_bucket(qpos[:, None] - kpos[None, :])]
    b = b.reshape(b.shape[0], b.shape[1], H_KV, GROUP)
    return jnp.transpose(b, (2, 3, 0, 1)).astype(jnp.float32)


def compress_kv(rows, pe, w1, w2):
    B, L = rows.shape[:2]
    r = CMP_BLOCK // CMP_STRIDE
    n_ch = L // CMP_STRIDE
    n_c = (L - CMP_BLOCK) // CMP_STRIDE + 1
    ch = rows[:, :n_ch * CMP_STRIDE].reshape((B, n_ch, CMP_STRIDE) + rows.shape[2:])
    w1c = w1.reshape(2, r, CMP_STRIDE, HEAD_DIM, CMP_HIDDEN)
    pre = jnp.einsum('cld,clde->ce', pe, w1)[None, None, :, None, :]
    for m in range(r):
        pre = pre + jnp.einsum('bnlcgd,clde->bncge', ch[:, m:m + n_c], w1c[:, m])
    out = jnp.einsum('bncge,ced->bncgd', jax.nn.gelu(pre), w2)
    c_end = jnp.arange(n_c) * CMP_STRIDE + CMP_BLOCK - 1
    return out, c_end


def cmp_to_sel(p, n_sel):
    r_sel = SEL_BLOCK // CMP_STRIDE
    r_cmp = CMP_BLOCK // CMP_STRIDE
    left = r_cmp - 1
    right = r_sel * n_sel + r_cmp - 1 - left - p.shape[-1]
    pp = jnp.pad(p, [(0, 0)] * (p.ndim - 1) + [(left, right)])
    out = None
    for m in range(r_sel):
        for n in range(r_cmp):
            term = pp[..., m + n: m + n + r_sel * (n_sel - 1) + 1: r_sel]
            out = term if out is None else out + term
    return out


def sel_blocks(rows):
    B, L = rows.shape[:2]
    n_sel = -(-L // SEL_BLOCK)
    rows = jnp.pad(rows, ((0, 0), (0, n_sel * SEL_BLOCK - L), (0, 0), (0, 0), (0, 0)))
    return jnp.transpose(rows.reshape(B, n_sel, SEL_BLOCK, 2, H_KV, HEAD_DIM), (0, 4, 1, 2, 3, 5))


def nsa_attend(q, qpos, gates, kv_c, c_end, kv_s_blocks, kv_w, w_pos, rel_bias):
    B, Q = q.shape[:2]
    n_sel = kv_s_blocks.shape[2]
    qg = (q * HEAD_DIM ** -0.5).reshape(B, Q, H_KV, GROUP, HEAD_DIM)
    s_c = jnp.einsum('bqgrd,bngd->bgrqn', qg, kv_c[:, :, 0]) + pos_bias(qpos, c_end, rel_bias)
    p_c = masked_softmax(s_c, c_end[None, :] <= qpos[:, None])
    o_c = jnp.einsum('bgrqn,bngd->bqgrd', p_c, kv_c[:, :, 1])
    p_slc = cmp_to_sel(p_c.sum(axis=2), n_sel)
    blk = jnp.arange(n_sel)[None, :]
    cur = (qpos // SEL_BLOCK)[:, None]
    valid = blk * SEL_BLOCK <= qpos[:, None]
    forced = (blk == 0) | (blk == cur) | (blk == cur - 1)
    score = jnp.where(valid, p_slc + jnp.where(forced, FORCE_BONUS, 0.0), NEG_INF)
    _, idx = lax.top_k(score, min(TOP_N, n_sel))
    bi = jnp.arange(B)[:, None, None, None]
    gi = jnp.arange(H_KV)[None, :, None, None]
    n_keys = idx.shape[-1] * SEL_BLOCK
    sel = kv_s_blocks[bi, gi, idx].reshape(B, H_KV, Q, n_keys, 2, HEAD_DIM)
    k_pos = (idx[..., None] * SEL_BLOCK + jnp.arange(SEL_BLOCK)).reshape(B, H_KV, Q, n_keys)
    table = rel_bias.T.reshape(H_KV, GROUP, N_BUCKETS)
    b_s = jnp.moveaxis(table[gi, :, rel_bucket(qpos[None, None, :, None] - k_pos)], -1, 2)
    s_s = jnp.einsum('bqgrd,bgqkd->bgrqk', qg, sel[..., 0, :]) + b_s.astype(jnp.float32)
    p_s = masked_softmax(s_s, (k_pos <= qpos[None, None, :, None])[:, :, None])
    o_s = jnp.einsum('bgrqk,bgqkd->bqgrd', p_s, sel[..., 1, :])
    dist = qpos[:, None] - w_pos[None, :]
    s_w = jnp.einsum('bqgrd,bkgd->bgrqk', qg, kv_w[:, :, 0]) + pos_bias(qpos, w_pos, rel_bias)
    p_w = masked_softmax(s_w, (w_pos[None, :] >= 0) & (dist >= 0) & (dist < WINDOW))
    o_w = jnp.einsum('bgrqk,bkgd->bqgrd', p_w, kv_w[:, :, 1])
    g = gates.reshape(B, Q, 3, H_KV, GROUP)[..., None]
    o = g[:, :, 0] * o_c + g[:, :, 1] * o_s + g[:, :, 2] * o_w
    return o.reshape(B, Q, N_HEADS * HEAD_DIM).astype(q.dtype)


def nsa_prompt(q, kv_c_rows, kv_s_rows, kv_w_rows, gates, lw, rel_bias):
    B, T = q.shape[:2]
    kv_c, c_end = compress_kv(kv_c_rows, lw['pe_cmp'], lw['w_cmp1'], lw['w_cmp2'])
    kv_s_blocks = sel_blocks(kv_s_rows)
    n_q = T // Q_BLOCK
    band = WINDOW + Q_BLOCK
    w_idx = (jnp.arange(n_q) * Q_BLOCK)[:, None] + jnp.arange(band)[None, :]
    kv_w_pad = jnp.pad(kv_w_rows, ((0, 0), (WINDOW, 0), (0, 0), (0, 0), (0, 0)))
    kv_w_bands = jnp.moveaxis(kv_w_pad[:, w_idx], 1, 0)
    blocks = lambda t: jnp.moveaxis(t.reshape((B, n_q, Q_BLOCK) + t.shape[2:]), 1, 0)
    xs = (blocks(q), jnp.arange(T).reshape(n_q, Q_BLOCK), blocks(gates), kv_w_bands, w_idx - WINDOW)
    o = lax.map(lambda a: nsa_attend(a[0], a[1], a[2], kv_c, c_end, kv_s_blocks, a[3], a[4], rel_bias), xs)
    return jnp.moveaxis(o, 0, 1).reshape(B, T, N_HEADS * HEAD_DIM)


def nsa_sample(q, kv_c_new, kv_s_new, kv_w_new, gates, cache_c, cache_s, win_buf, page_table, lw, rel_bias):
    B, S = q.shape[:2]
    past = page_table.shape[1] * PAGE_SIZE
    gather = lambda pool: pool[page_table].reshape((B, past) + pool.shape[2:]).astype(kv_c_new.dtype)
    kv_c, c_end = compress_kv(jnp.concatenate([gather(cache_c), kv_c_new], axis=1),
                              lw['pe_cmp'], lw['w_cmp1'], lw['w_cmp2'])
    kv_s_blocks = sel_blocks(jnp.concatenate([gather(cache_s), kv_s_new], axis=1))
    kv_w = jnp.concatenate([win_buf.astype(kv_w_new.dtype), kv_w_new], axis=1)
    w_pos = past - win_buf.shape[1] + jnp.arange(kv_w.shape[1])
    qpos = past + jnp.arange(S)
    o = nsa_attend(q, qpos, gates, kv_c, c_end, kv_s_blocks, kv_w, w_pos, rel_bias)
    keep = min(WINDOW, kv_w.shape[1])
    return o, kv_w[:, kv_w.shape[1] - keep:]


def split_projection(u, w_in):
    B, T = u.shape[:2]
    p = u @ w_in
    parts = []
    off = 0
    for size in IN_SIZES:
        parts.append(p[..., off:off + size])
        off += size
    q, kc, ks, kw, gn, ch, cb, cc, mg = parts
    kv = lambda t: t.reshape(B, T, 2, H_KV, HEAD_DIM)
    return (q.reshape(B, T, N_HEADS, HEAD_DIM), kv(kc), kv(ks), kv(kw),
            jax.nn.sigmoid(gn).reshape(B, T, 3, N_HEADS), ch, cb, cc,
            jax.nn.sigmoid(mg).reshape(B, T, 2, D_MODEL))


def short_conv(h, gate_b, gate_c, w_conv, buf):
    T = h.shape[1]
    full = jnp.concatenate([buf.astype(h.dtype), gate_c * h], axis=1)
    out = w_conv[0] * full[:, 0:T]
    for k in range(1, CONV_WIDTH):
        out = out + w_conv[k] * full[:, k:k + T]
    return gate_b * out, full[:, T:]


def token_mixer(u, lw, rel_bias, past):
    B, T = u.shape[:2]
    q, kv_c, kv_s, kv_w, g_nsa, h_cv, b_cv, c_cv, g_merge = split_projection(u, lw['w_in'])
    if past is None:
        o_nsa = nsa_prompt(q, kv_c, kv_s, kv_w, g_nsa, lw, rel_bias)
        keep = min(WINDOW, T)
        win_new = kv_w[:, T - keep:]
        conv_buf = jnp.zeros((B, CONV_WIDTH - 1, D_CONV), u.dtype)
    else:
        cache_c, cache_s, win_buf, conv_buf, page_table = past
        o_nsa, win_new = nsa_sample(q, kv_c, kv_s, kv_w, g_nsa, cache_c, cache_s, win_buf, page_table, lw, rel_bias)
    y_cv, conv_new = short_conv(h_cv, b_cv, c_cv, lw['w_conv'], conv_buf)
    merged = g_merge[:, :, 0] * (o_nsa @ lw['w_nsa_out']) + g_merge[:, :, 1] * (y_cv @ lw['w_conv_out'])
    return merged @ lw['w_out'], (kv_c, kv_s, win_new, conv_new)


def decoder_layer(x, c, lw, rel_bias, past):
    B = x.shape[0]
    mod = (jax.nn.silu(c) @ lw['w_ada'] + lw['b_ada']).reshape(B, N_SUB, 3, D_MODEL)
    gn = lw['g_norm']
    h = x + 0.5 * mod[:, 0, 2][:, None] * swiglu(modulate(x, gn[0], mod[:, 0, 0], mod[:, 0, 1]),
                                                 lw['w_ffn1_gu'], lw['w_ffn1_down'])
    mix, state = token_mixer(modulate(h, gn[1], mod[:, 1, 0], mod[:, 1, 1]), lw, rel_bias, past)
    h = h + mod[:, 1, 2][:, None] * mix
    h = h + 0.5 * mod[:, 2, 2][:, None] * swiglu(modulate(h, gn[2], mod[:, 2, 0], mod[:, 2, 1]),
                                                 lw['w_ffn2_gu'], lw['w_ffn2_down'])
    return h, state


def setup_inputs(seed: int = 0) -> dict:
    key = jax.random.key(seed)
    ks = iter(jax.random.split(key, 32))
    nrm = lambda shape, scale: jax.random.normal(next(ks), shape, jnp.float32) * scale
    n_pages = PAST_LEN // PAGE_SIZE
    n_used = DEC_BATCH * n_pages
    n_phys = n_used + max(1, n_used // 4)
    win_buf = min(WINDOW, PAST_LEN)
    kv_row = (2, H_KV, HEAD_DIM)
    inputs = {
        "x_prompt": nrm((BATCH, SEQ, D_MODEL), 1.0),
        "x_sample": nrm((DEC_BATCH, DEC_SEQ, D_MODEL), 1.0),
        "cache_kv_cmp": nrm((DEPTH, n_phys, PAGE_SIZE) + kv_row, 1.0),
        "cache_kv_sel": nrm((DEPTH, n_phys, PAGE_SIZE) + kv_row, 1.0),
        "state_kv_win": nrm((DEPTH, DEC_BATCH, win_buf) + kv_row, 1.0),
        "state_conv": nrm((DEPTH, DEC_BATCH, CONV_WIDTH - 1, D_CONV), 1.0),
        "page_table": jax.random.permutation(next(ks), n_phys)[:n_used].reshape(DEC_BATCH, n_pages).astype(jnp.int32),
        "c_prompt": nrm((BATCH, D_MODEL), 1.0),
        "c_sample": nrm((DEC_BATCH, D_MODEL), 1.0),
        "w_ada": nrm((DEPTH, D_MODEL, N_SUB * 3 * D_MODEL), 0.5 * D_MODEL ** -0.5),
        "b_ada": nrm((DEPTH, N_SUB * 3 * D_MODEL), 0.02),
        "g_norm": 1.0 + nrm((DEPTH, N_SUB, D_MODEL), 0.05),
        "w_ffn1_gu": nrm((DEPTH, D_MODEL, 2 * D_FF), D_MODEL ** -0.5),
        "w_ffn1_down": nrm((DEPTH, D_FF, D_MODEL), D_FF ** -0.5),
        "w_ffn2_gu": nrm((DEPTH, D_MODEL, 2 * D_FF), D_MODEL ** -0.5),
        "w_ffn2_down": nrm((DEPTH, D_FF, D_MODEL), D_FF ** -0.5),
        "w_in": nrm((DEPTH, D_MODEL, IN_WIDTH), D_MODEL ** -0.5),
        "w_cmp1": nrm((DEPTH, 2, CMP_BLOCK, HEAD_DIM, CMP_HIDDEN), (CMP_BLOCK * HEAD_DIM) ** -0.5),
        "w_cmp2": nrm((DEPTH, 2, CMP_HIDDEN, HEAD_DIM), CMP_HIDDEN ** -0.5),
        "pe_cmp": nrm((DEPTH, 2, CMP_BLOCK, HEAD_DIM), 0.1),
        "w_conv": nrm((DEPTH, CONV_WIDTH, D_CONV), CONV_WIDTH ** -0.5),
        "w_nsa_out": nrm((DEPTH, N_HEADS * HEAD_DIM, D_MODEL), (N_HEADS * HEAD_DIM) ** -0.5),
        "w_conv_out": nrm((DEPTH, D_CONV, D_MODEL), D_CONV ** -0.5),
        "w_out": nrm((DEPTH, D_MODEL, D_MODEL), D_MODEL ** -0.5),
        "rel_bias": nrm((N_BUCKETS, N_HEADS), 0.5),
        "g_final": 1.0 + nrm((D_MODEL,), 0.05),
    }
    return inputs


def reference(x_prompt, x_sample, cache_kv_cmp, cache_kv_sel, state_kv_win, state_conv, page_table,
              c_prompt, c_sample, w_ada, b_ada, g_norm, w_ffn1_gu, w_ffn1_down, w_ffn2_gu, w_ffn2_down,
              w_in, w_cmp1, w_cmp2, pe_cmp, w_conv, w_nsa_out, w_conv_out, w_out, rel_bias, g_final):
    hp, hs = x_prompt, x_sample
    st_p, st_s = [], []
    for l in range(DEPTH):
        lw = dict(w_ada=w_ada[l], b_ada=b_ada[l], g_norm=g_norm[l], w_ffn1_gu=w_ffn1_gu[l],
                  w_ffn1_down=w_ffn1_down[l], w_ffn2_gu=w_ffn2_gu[l], w_ffn2_down=w_ffn2_down[l],
                  w_in=w_in[l], w_cmp1=w_cmp1[l], w_cmp2=w_cmp2[l], pe_cmp=pe_cmp[l], w_conv=w_conv[l],
                  w_nsa_out=w_nsa_out[l], w_conv_out=w_conv_out[l], w_out=w_out[l])
        hp, sp = decoder_layer(hp, c_prompt, lw, rel_bias, None)
        hs, ss = decoder_layer(hs, c_sample, lw, rel_bias,
                               (cache_kv_cmp[l], cache_kv_sel[l], state_kv_win[l], state_conv[l], page_table))
        st_p.append(sp)
        st_s.append(ss)
    y_prompt = rms_norm(hp, g_final)
    y_sample = rms_norm(hs, g_final)
    kv_cmp_p = jnp.stack([s[0] for s in st_p])
    kv_sel_p = jnp.stack([s[1] for s in st_p])
    kv_win_p = jnp.stack([s[2] for s in st_p])
    conv_p = jnp.stack([s[3] for s in st_p])
    kv_cmp_s = jnp.stack([s[0] for s in st_s])
    kv_sel_s = jnp.stack([s[1] for s in st_s])
    kv_win_s = jnp.stack([s[2] for s in st_s])
    conv_s = jnp.stack([s[3] for s in st_s])
    return (y_prompt, y_sample, kv_cmp_p, kv_sel_p, kv_win_p, conv_p, kv_cmp_s, kv_sel_s, kv_win_s, conv_s)
```

```cpp
#include <hip/hip_runtime.h>
#include <hip/hip_bf16.h>
#include <cstdio>
#include <cstdint>
#include <cmath>

#ifndef MK_PER_PHASE
#define MK_PER_PHASE 0
#endif
#ifndef MK_PH_MASK
#define MK_PH_MASK 0xffffffffu
#endif
#define MK_PH_ON(k) ((MK_PH_MASK >> (k)) & 1u)
#ifndef MK_PROBE
#define MK_PROBE 0
#endif
#ifndef MK_LAST_PHASE
#define MK_LAST_PHASE 12
#endif

constexpr int DM = 1024, NBP = 4, TP = 4096, MP = NBP * TP, NBS = 32, TS = 4, MS = NBS * TS, MTOT = MP + MS, MPAD = 16640;
constexpr int HD = 64, NH = 8, HKV = 2, GRP = 4, DFF = 2816, NGU = 2 * DFF, INW = 4888, INWP = 5120, DCONV = 512;
constexpr int PAST = 8192, NPAGE = 64, PAGE = 128, NPHYS = 2560;
constexpr int NBIDX = NBP + NBS;
constexpr int NMOD = 9 * DM;
constexpr float EPS = 1e-6f;
constexpr float LOG2E = 1.4426950408889634f;
constexpr float QSCALE = 0.125f * LOG2E;

constexpr size_t O_Y = 0;
constexpr size_t O_KVC_P = (size_t)MTOT * DM;
constexpr size_t O_KVS_P = O_KVC_P + (size_t)MP * 256;
constexpr size_t O_KVW_P = O_KVS_P + (size_t)MP * 256;
constexpr size_t O_CONV_P = O_KVW_P + (size_t)NBP * 512 * 256;
constexpr size_t O_KVC_S = O_CONV_P + (size_t)NBP * 2 * 512;
constexpr size_t O_KVS_S = O_KVC_S + (size_t)MS * 256;
constexpr size_t O_KVW_S = O_KVS_S + (size_t)MS * 256;
constexpr size_t O_CONV_S = O_KVW_S + (size_t)NBS * 512 * 256;
constexpr size_t O_TOTAL = O_CONV_S + (size_t)NBS * 2 * 512;
static_assert(O_TOTAL == 30117888, "output size");

constexpr size_t MiB = 1u << 20;
constexpr size_t WS_CTL = 0, CTL_ZERO_BYTES = 1 * MiB;
constexpr size_t WS_MOD = 1 * MiB;
constexpr size_t WS_PETERM = 3 * MiB;
constexpr size_t WS_SW2 = 4 * MiB;
constexpr size_t WS_SW3 = 5 * MiB;
constexpr size_t WS_SSQ2 = 6 * MiB, WS_SSQ3 = 8 * MiB;
constexpr size_t WS_GATES = 10 * MiB;
constexpr size_t WS_WGU1 = 16 * MiB;
constexpr size_t WS_WD1 = 28 * MiB;
constexpr size_t WS_WIN = 34 * MiB;
constexpr size_t WS_WM = 46 * MiB;
constexpr size_t WS_WO = 48 * MiB;
constexpr size_t WS_WGU2 = 50 * MiB;
constexpr size_t WS_WD2 = 62 * MiB;
constexpr size_t WS_WC1 = 68 * MiB;
constexpr size_t WS_A1 = 72 * MiB;
constexpr size_t WS_A2 = 106 * MiB;
constexpr size_t WS_A3 = 140 * MiB;
constexpr size_t WS_ACT = 174 * MiB;
constexpr size_t WS_H1 = 266 * MiB;
constexpr size_t WS_Q = 332 * MiB;
constexpr size_t WS_KS = 350 * MiB, WS_VS = 354 * MiB, WS_KW = 358 * MiB, WS_VW = 362 * MiB;
constexpr size_t WS_ACP = 366 * MiB;
constexpr size_t WS_PCP = 376 * MiB;
constexpr size_t WS_KCP = 380 * MiB, WS_VCP = 381 * MiB;
constexpr size_t WS_KVCS = 382 * MiB;
constexpr size_t WS_PROD = 400 * MiB;
constexpr size_t WS_CB = 418 * MiB;
constexpr size_t WS_RATIO = 436 * MiB;
constexpr size_t WS_GB = 470 * MiB;
constexpr size_t WS_ACAT = 504 * MiB;
constexpr size_t WS_MERGED = 538 * MiB;
constexpr size_t WS_PCS = 572 * MiB;
constexpr size_t WS_ACS = 608 * MiB;
constexpr size_t WS_END = 740 * MiB;

constexpr int CW_TMO = 0, CW_CODE = 1, CW_BAR = 4096;

#define GAS __attribute__((address_space(1)))
#define LAS __attribute__((address_space(3)))
typedef unsigned short bf16_t;
typedef short bf16x8 __attribute__((ext_vector_type(8)));
typedef float f32x4 __attribute__((ext_vector_type(4)));
typedef float f32x2 __attribute__((ext_vector_type(2)));
typedef unsigned u32x4 __attribute__((ext_vector_type(4)));
typedef unsigned u32x2 __attribute__((ext_vector_type(2)));
typedef GAS unsigned gu32;

__device__ __forceinline__ unsigned f2bf(float f) { unsigned u = __builtin_bit_cast(unsigned, f); return (u + 0x7fffu + ((u >> 16) & 1u)) >> 16; }
__device__ __forceinline__ unsigned pk2(float lo, float hi) { return f2bf(lo) | (f2bf(hi) << 16); }
__device__ __forceinline__ float bf2f(unsigned short b) { return __builtin_bit_cast(float, (unsigned)b << 16); }
__device__ __forceinline__ float bflo(unsigned w) { return __builtin_bit_cast(float, w << 16); }
__device__ __forceinline__ float bfhi(unsigned w) { return __builtin_bit_cast(float, w & 0xffff0000u); }
__device__ __forceinline__ float fast_exp2(float x) { return __builtin_amdgcn_exp2f(x); }
__device__ __forceinline__ float fast_rcp(float x) { return __builtin_amdgcn_rcpf(x); }
__device__ __forceinline__ float sigmoidf_(float x) { return fast_rcp(1.0f + fast_exp2(-x * LOG2E)); }
__device__ __forceinline__ float siluf_(float x) { return x * sigmoidf_(x); }
__device__ __forceinline__ int bidx_of_row(int row) { int b = row < MP ? (row >> 12) : NBP + ((row - MP) >> 2); return b < NBIDX ? b : NBIDX - 1; }
__device__ __forceinline__ const float* modp(const float* modv, int bidx, int sub, int kind) { return modv + ((size_t)(bidx * 3 + sub) * 3 + kind) * DM; }

namespace pg8 {
constexpr int BM = 256, BK = 64, HALF = 128, HTB = HALF * BK * 2, STAGE_BYTES = 8 * HTB, NXCD = 8, WGM = 8;
__host__ __device__ __forceinline__ int lds_byte(int r, int c) { const int st = (r >> 4) * 2 + (c >> 5), rr = r & 15, cc = c & 31, ob = rr * 64 + cc * 2; return st * 1024 + (ob ^ (((ob >> 9) & 1) << 5)); }
__host__ __device__ __forceinline__ void stage_rc(int b, int& R, int& C) { const int st = b / 1024, sb = b % 1024, swz = sb ^ (((sb >> 9) & 1) << 5); R = (st >> 1) * 16 + swz / 64; C = (st & 1) * 32 + (swz % 64) / 2; }
__host__ __device__ __forceinline__ int perm32(int rho) { const int n = rho >> 4, i = rho & 15; return 8 * (i >> 2) + 4 * n + (i & 3); }
struct Unit { int pm, pn; };
struct Gemm { const bf16_t* A; const bf16_t* Bt; int M, N, K; };
struct StaticOrder {
    int nM, nN, nwg, G, c;
    __host__ __device__ void init(int M, int N, int G_, int c_) { nM = M / BM; nN = N / BM; nwg = nM * nN; G = G_; c = c_; }
    __host__ __device__ bool next(int i, Unit& u) const {
        const long L = (long)i * G + c; if (L >= nwg) return false;
        int wgid = (int)L; { const int q = nwg / NXCD, r = nwg % NXCD, xcd = wgid % NXCD, off = wgid / NXCD; wgid = (xcd < r ? xcd * (q + 1) : r * (q + 1) + (xcd - r) * q) + off; }
        const int nig = WGM * nN, gid = wgid / nig, fm = gid * WGM, gsz = (nM - fm) < WGM ? (nM - fm) : WGM;
        u.pm = fm + ((wgid % nig) % gsz); u.pn = (wgid % nig) / gsz; return true;
    }
    __device__ __forceinline__ void a_ready(const Unit&) const {}
    __device__ __forceinline__ void done(const Unit&) const {}
};
template <class Epi, class Sched>
__device__ __forceinline__ void gemm_phase(LAS unsigned char* lds, const Gemm g, const Sched& S, const Epi& E) {
    const int tid = threadIdx.x, wid = __builtin_amdgcn_readfirstlane(tid >> 6), lane = tid & 63, wr = wid >> 2, wc = wid & 3, fr = lane & 15, fq = lane >> 4;
    const int K = g.K, nt = K / BK;
    unsigned voffA[2], voffB[2];
#pragma unroll
    for (int i = 0; i < 2; ++i) { int R, C; stage_rc(tid * 16 + i * 8192, R, C); const int Rb = Epi::PERM ? ((R & ~31) + perm32(R & 31)) : R;
        voffA[i] = (unsigned)(R * K + C) * 2u; voffB[i] = (unsigned)(Rb * K + C) * 2u; }
    const size_t kstep = (size_t)(BK * 2);
    const size_t hstep = (size_t)HALF * K * 2;
    const size_t tstep = 2 * hstep;
    const unsigned ldsw = (unsigned)wid * 1024u;
    const int aoff = lds_byte(wr * 64 + fr, fq * 8), boff = lds_byte(wc * 32 + fr, fq * 8);
#define PG8_SA(b, h) (((b) * 2 + (h)) * HTB)
#define PG8_SB(b, h) ((4 + (b) * 2 + (h)) * HTB)
#define PG8_STAGE(bufoff, gbase, voff) do { _Pragma("unroll") for (int _i = 0; _i < 2; ++_i) \
        __builtin_amdgcn_global_load_lds((const unsigned*)((const char*)(gbase) + (voff)[_i]), (LAS unsigned*)(lds + (bufoff) + ldsw + _i * 8192), 16, 0, 0); } while (0)
#define PG8_LDA(dst, b, h) do { _Pragma("unroll") for (int m = 0; m < 4; ++m) _Pragma("unroll") for (int k = 0; k < 2; ++k) dst[m][k] = *(const LAS bf16x8*)(lds + PG8_SA(b, h) + aoff + m * 2048 + k * 1024); } while (0)
#define PG8_LDB(dst, b, h) do { _Pragma("unroll") for (int n = 0; n < 2; ++n) _Pragma("unroll") for (int k = 0; k < 2; ++k) dst[n][k] = *(const LAS bf16x8*)(lds + PG8_SB(b, h) + boff + n * 2048 + k * 1024); } while (0)
#define PG8_MMA(ai, bj, At, Bt) do { __builtin_amdgcn_s_setprio(1); _Pragma("unroll") for (int m = 0; m < 4; ++m) _Pragma("unroll") for (int n = 0; n < 2; ++n) _Pragma("unroll") for (int k = 0; k < 2; ++k) \
        acc[ai][bj][m][n] = __builtin_amdgcn_mfma_f32_16x16x32_bf16(Bt[n][k], At[m][k], acc[ai][bj][m][n], 0, 0, 0); __builtin_amdgcn_s_setprio(0); } while (0)
#define PG8_WAIT_V(n) asm volatile("s_waitcnt vmcnt(" #n ")" ::: "memory")
#define PG8_WAIT_L(n) asm volatile("s_waitcnt lgkmcnt(" #n ")" ::: "memory")
#define PG8_BAR __builtin_amdgcn_s_barrier()
#define PG8_SCHED __builtin_amdgcn_sched_barrier(0)
    Unit cur, nxt; int ui = 0;
    if (!S.next(0, cur)) return;
    f32x4 acc[2][2][4][2];
#pragma unroll
    for (int a = 0; a < 2; ++a)
#pragma unroll
        for (int b = 0; b < 2; ++b)
#pragma unroll
            for (int m = 0; m < 4; ++m)
#pragma unroll
                for (int n = 0; n < 2; ++n) acc[a][b][m][n] = (f32x4){0.f, 0.f, 0.f, 0.f};
    bf16x8 At[4][2], B0[2][2], B1[2][2];
    const char* cA = (const char*)g.A + (size_t)cur.pm * tstep; const char* cB = (const char*)g.Bt + (size_t)cur.pn * tstep;
    S.a_ready(cur);
    PG8_STAGE(PG8_SB(0, 0), cB, voffB); PG8_STAGE(PG8_SB(0, 1), cB + hstep, voffB); PG8_STAGE(PG8_SA(0, 0), cA, voffA); PG8_STAGE(PG8_SA(0, 1), cA + hstep, voffA);
    if (wr == 1) PG8_BAR;
    PG8_WAIT_V(2); PG8_BAR;
    PG8_STAGE(PG8_SB(1, 0), cB + kstep, voffB); PG8_STAGE(PG8_SA(1, 0), cA + kstep, voffA); PG8_STAGE(PG8_SB(1, 1), cB + hstep + kstep, voffB);
    PG8_WAIT_V(6); PG8_BAR;
    for (;;) {
        const bool has_next = S.next(ui + 1, nxt);
        const char* nA = has_next ? (const char*)g.A + (size_t)nxt.pm * tstep : cA; const char* nB = has_next ? (const char*)g.Bt + (size_t)nxt.pn * tstep : cB;
        for (int t = 0; t < nt; t += 2) {
            const bool last = (t == nt - 2);
            const char* a1 = cA + (size_t)(t + 1) * kstep;
            const char* a2 = last ? nA : cA + (size_t)(t + 2) * kstep; const char* b2 = last ? nB : cB + (size_t)(t + 2) * kstep;
            const char* a3 = a2 + kstep; const char* b3 = b2 + kstep;
            if (last && has_next) S.a_ready(nxt);
            if constexpr (Epi::HAS_MID) { if (t == E.mid_t) E.mid(acc, cur, wr, wc, fr, fq); }
            PG8_LDB(B0, 0, 0); PG8_LDB(B1, 0, 1); PG8_SCHED; PG8_LDA(At, 0, 0); PG8_STAGE(PG8_SA(1, 1), a1 + hstep, voffA);
            PG8_WAIT_V(8); PG8_WAIT_L(0); PG8_BAR; PG8_MMA(0, 0, At, B0); PG8_MMA(0, 1, At, B1); PG8_BAR; PG8_SCHED;
            PG8_LDA(At, 0, 1); PG8_STAGE(PG8_SB(0, 0), b2, voffB); PG8_STAGE(PG8_SB(0, 1), b2 + hstep, voffB); PG8_STAGE(PG8_SA(0, 0), a2, voffA);
            PG8_WAIT_V(8); PG8_WAIT_L(0); PG8_BAR; PG8_MMA(1, 0, At, B0); PG8_MMA(1, 1, At, B1); PG8_BAR; PG8_SCHED;
            PG8_LDB(B0, 1, 0); PG8_LDB(B1, 1, 1); PG8_SCHED; PG8_LDA(At, 1, 0); PG8_STAGE(PG8_SA(0, 1), a2 + hstep, voffA);
            PG8_WAIT_V(8); PG8_WAIT_L(0); PG8_BAR; PG8_MMA(0, 0, At, B0); PG8_MMA(0, 1, At, B1); PG8_BAR; PG8_SCHED;
            PG8_LDA(At, 1, 1); PG8_STAGE(PG8_SB(1, 0), b3, voffB); PG8_STAGE(PG8_SB(1, 1), b3 + hstep, voffB); PG8_STAGE(PG8_SA(1, 0), a3, voffA);
            PG8_WAIT_V(8); PG8_WAIT_L(0); PG8_BAR; PG8_MMA(1, 0, At, B0); PG8_MMA(1, 1, At, B1); PG8_BAR; PG8_SCHED;
        }
        if (wr == 0) PG8_BAR;
        E(acc, cur, wr, wc, fr, fq); S.done(cur);
        if (!has_next) break;
#pragma unroll
        for (int a = 0; a < 2; ++a)
#pragma unroll
            for (int b = 0; b < 2; ++b)
#pragma unroll
                for (int m = 0; m < 4; ++m)
#pragma unroll
                    for (int n = 0; n < 2; ++n) acc[a][b][m][n] = (f32x4){0.f, 0.f, 0.f, 0.f};
        cur = nxt; cA = nA; cB = nB; ++ui;
        if (wr == 1) PG8_BAR;
    }
    PG8_WAIT_V(0);
    PG8_BAR;
#undef PG8_SA
#undef PG8_SB
#undef PG8_STAGE
#undef PG8_LDA
#undef PG8_LDB
#undef PG8_MMA
#undef PG8_WAIT_V
#undef PG8_WAIT_L
#undef PG8_BAR
#undef PG8_SCHED
}
typedef f32x4 Acc[2][2][4][2];

struct EpiGU {
    static constexpr bool PERM = true, HAS_MID = false;
    bf16_t* ACT; const float* ssq; const float* shiftW; int ldsw;
    __device__ __forceinline__ void operator()(const Acc& acc, const Unit& u, int wr, int wc, int fr, int fq) const {
        const int cl = wc * 32 + 8 * fq;
#pragma unroll
        for (int ai = 0; ai < 2; ++ai)
#pragma unroll
            for (int m = 0; m < 4; ++m) {
                const int row = u.pm * BM + ai * HALF + wr * 64 + m * 16 + fr;
                float rt = 1.f; f32x4 sg[2], sv[2]; sg[0] = sg[1] = sv[0] = sv[1] = (f32x4){0.f, 0.f, 0.f, 0.f};
                if (ssq) {
                    const f32x4* sp = (const f32x4*)(ssq + (size_t)row * 16); const f32x4 s0 = sp[0], s1 = sp[1], s2 = sp[2], s3 = sp[3];
                    const float s = ((s0[0] + s0[1]) + (s0[2] + s0[3])) + ((s1[0] + s1[1]) + (s1[2] + s1[3])) + ((s2[0] + s2[1]) + (s2[2] + s2[3])) + ((s3[0] + s3[1]) + (s3[2] + s3[3]));
                    rt = 1.0f / sqrtf(s * (1.0f / DM) + EPS);
                    const float* sw = shiftW + (size_t)bidx_of_row(row) * ldsw + u.pn * BM + cl;
                    sg[0] = *(const f32x4*)(sw); sg[1] = *(const f32x4*)(sw + 4); sv[0] = *(const f32x4*)(sw + HALF); sv[1] = *(const f32x4*)(sw + HALF + 4);
                }
                u32x4 w;
#pragma unroll
                for (int n = 0; n < 2; ++n) {
                    const f32x4 gv = acc[ai][0][m][n] * rt + sg[n], vv = acc[ai][1][m][n] * rt + sv[n];
                    const float a0 = siluf_(gv[0]) * vv[0], a1 = siluf_(gv[1]) * vv[1], a2 = siluf_(gv[2]) * vv[2], a3 = siluf_(gv[3]) * vv[3];
                    w[2 * n] = pk2(a0, a1); w[2 * n + 1] = pk2(a2, a3);
                }
                *(u32x4*)(ACT + (size_t)row * DFF + u.pn * HALF + cl) = w;
            }
    }
};
struct EpiRes {
    static constexpr bool PERM = false, HAS_MID = false;
    const float* res_p; const float* res_s;
    float* out_p; float* out_s;
    const float* modv; int gsub; float gfac;
    bf16_t* Aout; const float* gnorm; int ssub;
    float* ssq;
    __device__ __forceinline__ void operator()(const Acc& acc, const Unit& u, int wr, int wc, int fr, int fq) const {
#pragma unroll
        for (int ai = 0; ai < 2; ++ai)
#pragma unroll
            for (int m = 0; m < 4; ++m) {
                const int row = u.pm * BM + ai * HALF + wr * 64 + m * 16 + fr;
                const bool live = row < MTOT;
                const int bi = bidx_of_row(row);
                const float* rp = row < MP ? res_p + (size_t)row * DM : res_s + (size_t)(live ? row - MP : 0) * DM;
                float* op = row < MP ? out_p + (size_t)row * DM : out_s + (size_t)(live ? row - MP : 0) * DM;
                const float* gp = modp(modv, bi, gsub, 2); const float* scp = modp(modv, bi, ssub, 1);
                float sq = 0.f;
#pragma unroll
                for (int bj = 0; bj < 2; ++bj)
#pragma unroll
                    for (int n = 0; n < 2; ++n) {
                        const int c = u.pn * BM + bj * HALF + wc * 32 + n * 16 + 4 * fq;
                        const f32x4 r4 = *(const f32x4*)(rp + c), g4 = *(const f32x4*)(gp + c);
                        const f32x4 h = r4 + (g4 * gfac) * acc[ai][bj][m][n];
                        if (live) *(f32x4*)(op + c) = h;
                        sq += (h[0] * h[0] + h[1] * h[1]) + (h[2] * h[2] + h[3] * h[3]);
                        if (Aout) { const f32x4 gn = *(const f32x4*)(gnorm + c), sc = *(const f32x4*)(scp + c); const f32x4 a = h * gn * (sc + 1.0f);
                            u32x2 w; w.x = pk2(a[0], a[1]); w.y = pk2(a[2], a[3]); if (live) *(u32x2*)(Aout + (size_t)row * DM + c) = w; }
                    }
                if (ssq) { sq += __shfl_xor(sq, 16); sq += __shfl_xor(sq, 32); if (fq == 0) ssq[(size_t)row * 16 + u.pn * 4 + wc] = sq; }
            }
    }
};
struct EpiStoreBf16 {
    static constexpr bool PERM = true, HAS_MID = false;
    bf16_t* O; int ldc;
    __device__ __forceinline__ void operator()(const Acc& acc, const Unit& u, int wr, int wc, int fr, int fq) const {
#pragma unroll
        for (int ai = 0; ai < 2; ++ai)
#pragma unroll
            for (int m = 0; m < 4; ++m) { const int row = u.pm * BM + ai * HALF + wr * 64 + m * 16 + fr;
#pragma unroll
                for (int bj = 0; bj < 2; ++bj) { const f32x4 v0 = acc[ai][bj][m][0], v1 = acc[ai][bj][m][1]; u32x4 w; w.x = pk2(v0[0], v0[1]); w.y = pk2(v0[2], v0[3]); w.z = pk2(v1[0], v1[1]); w.w = pk2(v1[2], v1[3]);
                    *(u32x4*)(O + (size_t)row * ldc + u.pn * BM + bj * HALF + wc * 32 + 8 * fq) = w; } }
    }
};
}

#define XB_TMO      128
#define XB_XCNT(j)  (256  + 64 * (j))
#define XB_XSUB(j)  (1280 + 64 * (j))
#define XB_XGEN(j)  (2304 + 64 * (j))
#define XB_TOP      3328
#define XB_TOPGEN   3392
#define XCD_BAR_WORDS 3456
#define XB_SPIN_CAP (1u << 18)
__device__ __forceinline__ unsigned xb_ld(unsigned* p)              { return __hip_atomic_load(p, __ATOMIC_RELAXED, __HIP_MEMORY_SCOPE_AGENT); }
__device__ __forceinline__ unsigned xb_add(unsigned* p, unsigned v) { return __hip_atomic_fetch_add(p, v, __ATOMIC_RELAXED, __HIP_MEMORY_SCOPE_AGENT); }
__device__ __forceinline__ unsigned xb_xcc_id() { return (unsigned)__builtin_amdgcn_s_getreg((3 << 11) | 20) & 0xFu; }
#define XB_SPIN(cond, bar) do { unsigned _sp = 0; while (cond) { __builtin_amdgcn_s_sleep(1); \
    if ((++_sp & 255u) == 0u) { if (xb_ld(&(bar)[XB_TMO])) break; if (_sp > XB_SPIN_CAP) { atomicAdd(&(bar)[XB_TMO], 1u); break; } } } } while (0)
struct XcdBarrier { unsigned* bar; unsigned x; volatile LAS unsigned* st; };
__device__ __forceinline__ XcdBarrier xcd_barrier_post(unsigned* bar, volatile LAS unsigned* st) {
    XcdBarrier b; b.bar = bar; b.x = xb_xcc_id(); b.st = st;
    if (threadIdx.x == 0) (void)xb_add(&bar[XB_XCNT(b.x)], 1u);
    return b;
}
__device__ __forceinline__ void xcd_barrier_complete(unsigned* bar, unsigned x, unsigned& nloc, unsigned& nx) {
    const unsigned G = gridDim.x * gridDim.y * gridDim.z;
    unsigned sum, cnt, mine, sp = 0u;
    for (;;) {
        sum = 0u; cnt = 0u; mine = 0u;
#pragma unroll
        for (unsigned j = 0; j < 16; ++j) { const unsigned c = xb_ld(&bar[XB_XCNT(j)]); sum += c; cnt += (c > 0u) ? 1u : 0u; mine = (j == x) ? c : mine; }
        if (sum == G) break;
        __builtin_amdgcn_s_sleep(1);
        if ((++sp & 255u) == 0u) { if (xb_ld(&bar[XB_TMO])) break; if (sp > XB_SPIN_CAP) { atomicAdd(&bar[XB_TMO], 1u); break; } }
    }
    nloc = mine > 0u ? mine : 1u; nx = cnt > 0u ? cnt : 1u;
}
__device__ __forceinline__ void xcd_barrier(const XcdBarrier& b) {
    asm volatile("s_waitcnt vmcnt(0)" ::: "memory");
    __syncthreads();
    if (threadIdx.x == 0) {
        unsigned* bar = b.bar;
        __builtin_amdgcn_s_waitcnt(0);
        unsigned nloc = b.st[0], nx = b.st[1];
        if (nloc == 0u) { xcd_barrier_complete(bar, b.x, nloc, nx); b.st[0] = nloc; b.st[1] = nx; }
        const unsigned old = xb_add(&bar[XB_XSUB(b.x)], 1u);
        const unsigned gen = old / nloc;
        if (old + 1u == (gen + 1u) * nloc) {
            __builtin_amdgcn_fence(__ATOMIC_RELEASE, "agent");
            asm volatile("s_waitcnt vmcnt(0)" ::: "memory");
            const unsigned og = xb_add(&bar[XB_TOP], 1u);
            const unsigned tg = og / nx;
            if (og + 1u == (tg + 1u) * nx) xb_add(&bar[XB_TOPGEN], 1u);
            else XB_SPIN(xb_ld(&bar[XB_TOPGEN]) == tg, bar);
            __builtin_amdgcn_fence(__ATOMIC_ACQUIRE, "agent");
            xb_add(&bar[XB_XGEN(b.x)], 1u);
            asm volatile("s_waitcnt vmcnt(0)" ::: "memory");
        } else {
            XB_SPIN(xb_ld(&bar[XB_XGEN(b.x)]) == gen, bar);
            __builtin_amdgcn_fence(__ATOMIC_ACQUIRE, "agent");
            asm volatile("s_waitcnt vmcnt(0)" ::: "memory");
        }
    }
    __syncthreads();
}

constexpr int NWAVES = 8, NTHR = 512;
constexpr int RING_BYTES = 131072, LDSCTL_OFF = RING_BYTES, MISC_OFF = LDSCTL_OFF + 320, LDS_BYTES = 147456;
#define LDS_WAIT() asm volatile("s_waitcnt lgkmcnt(0)" ::: "memory")

struct Args {
    const float* in[26]; float* out; unsigned char* ws; int ph_lo, ph_hi, li, pad;
};
struct Ctx {
    LAS unsigned char* lds; int tid, lane, wave, vcu, G, gw, NGW;
};

__device__ __forceinline__ void ada_item(const Ctx& X, int it, const float* cp, const float* cs, const float* w_ada, const float* b_ada, float* modv) {
    const int j0 = it * 64, w = X.wave, lane = X.lane;
    LAS float* sl = (LAS float*)X.lds + w * (18 * 128);
    LAS float* part = (LAS float*)(X.lds + 73728);
    for (int rh = 0; rh < 2; ++rh) {
        for (int idx = lane; idx < 18 * 128; idx += 64) { const int r = rh * 18 + idx / 128, kk = idx % 128, k = w * 128 + kk;
            const float cv = r < NBP ? cp[r * DM + k] : cs[(r - NBP) * DM + k]; sl[idx] = cv / (1.0f + __expf(-cv)); }
        LDS_WAIT(); __syncthreads();
        float acc[18];
#pragma unroll
        for (int r = 0; r < 18; ++r) acc[r] = 0.f;
        const float* wp = w_ada + (size_t)(w * 128) * NMOD + j0 + lane;
#pragma unroll 4
        for (int kk = 0; kk < 128; ++kk) { const float wv = wp[(size_t)kk * NMOD];
#pragma unroll
            for (int r = 0; r < 18; ++r) acc[r] += sl[r * 128 + kk] * wv; }
#pragma unroll
        for (int r = 0; r < 18; ++r) part[(w * 18 + r) * 64 + lane] = acc[r];
        LDS_WAIT(); __syncthreads();
        for (int o = X.tid; o < 18 * 64; o += NTHR) { const int r = o / 64, j = o % 64; float s = b_ada[j0 + j];
#pragma unroll
            for (int ww = 0; ww < 8; ++ww) s += part[(ww * 18 + r) * 64 + j];
            modv[(size_t)(rh * 18 + r) * NMOD + j0 + j] = s; }
        __syncthreads();
    }
}
struct TJ { int src, srcoff_stride, N, K, col0, col_stride, ncols, dst, dpitch, drow0, drow_stride, dcol0, rep; };
__constant__ TJ kJobs[] = {
    {12, 0, NGU, DM, 0,    128, 128, 0, DM, 0,   256, 0, 22},
    {12, 0, NGU, DM, DFF,  128, 128, 0, DM, 128, 256, 0, 22},
    {13, 0, DM, DFF, 0, 0, DM, 1, DFF, 0, 0, 0, 1},
    {16, 0, INW, DM, 0,    0, 1280, 2, DM, 0, 0, 0, 1},
    {16, 0, INW, DM, 1304, 128, 128, 2, DM, 1280, 256, 0, 4},
    {16, 0, INW, DM, 2328, 128, 128, 2, DM, 1408, 256, 0, 4},
    {16, 0, INW, DM, 1816, 0, 512, 2, DM, 2304, 0, 0, 1},
    {16, 0, INW, DM, 2840, 128, 128, 2, DM, 2816, 256, 0, 8},
    {16, 0, INW, DM, 3864, 128, 128, 2, DM, 2944, 256, 0, 8},
    {16, 0, INW, DM, 1280, 0, 24, 2, DM, 4864, 0, 0, 1},
    {21, 0, DM, 512, 0, 0, DM, 3, DM, 0, 0, 0, 1},
    {22, 0, DM, 512, 0, 0, DM, 3, DM, 0, 0, 512, 1},
    {23, 0, DM, DM, 0, 0, DM, 4, DM, 0, 0, 0, 1},
    {14, 0, NGU, DM, 0,    128, 128, 5, DM, 0,   256, 0, 22},
    {14, 0, NGU, DM, DFF,  128, 128, 5, DM, 128, 256, 0, 22},
    {15, 0, DM, DFF, 0, 0, DM, 6, DFF, 0, 0, 0, 1},
    {17, 1024 * 128, 128, DM, 0, 0, 128, 7, DM, 0, 128, 0, 4},
};
constexpr int NJOBS = sizeof(kJobs) / sizeof(TJ);
__device__ __forceinline__ int tj_items(const TJ& j) { return j.rep * (j.K / 64) * ((j.ncols + 31) / 32); }
__device__ __forceinline__ void transpose_item(const float* W, int N, int ncols, bf16_t* WT, int dpitch, LAS float* scr, int kb, int nb, int lane) {
    const int k0 = 64 * kb, n0 = 32 * nb; const bool okc = (n0 + (lane & 31)) < ncols;
#pragma unroll 8
    for (int i = 0; i < 32; ++i) { const int kk = 2 * i + (lane >> 5); scr[kk * 33 + (lane & 31)] = okc ? W[(size_t)(k0 + kk) * N + n0 + (lane & 31)] : 0.f; }
    LDS_WAIT(); asm volatile("" ::: "memory");
    const int c = lane & 7;
#pragma unroll
    for (int j = 0; j < 4; ++j) { const int n = (lane >> 3) + 8 * j; const LAS float* s = scr + (8 * c) * 33 + n;
        u32x4 o; o.x = pk2(s[0 * 33], s[1 * 33]); o.y = pk2(s[2 * 33], s[3 * 33]); o.z = pk2(s[4 * 33], s[5 * 33]); o.w = pk2(s[6 * 33], s[7 * 33]);
        if (n0 + n < ncols) *(u32x4*)(WT + (size_t)(n0 + n) * dpitch + k0 + 8 * c) = o; }
    LDS_WAIT(); asm volatile("" ::: "memory");
}
__device__ __forceinline__ bf16_t* wdst(unsigned char* ws, int id) {
    const size_t off = id == 0 ? WS_WGU1 : id == 1 ? WS_WD1 : id == 2 ? WS_WIN : id == 3 ? WS_WM : id == 4 ? WS_WO : id == 5 ? WS_WGU2 : id == 6 ? WS_WD2 : WS_WC1;
    return (bf16_t*)(ws + off);
}

struct EpiIn {
    static constexpr bool PERM = false, HAS_MID = false;
    const float* ssq; const float* shiftW; float* out; unsigned char* ws;
    template <int CASE> __device__ __forceinline__ void body(const pg8::Acc& acc, const pg8::Unit& u, int wr, int wc, int fr, int fq) const {
        using namespace pg8;
        const int pn = u.pn, cw = wc * 32 + 4 * fq;
#pragma unroll
        for (int ai = 0; ai < 2; ++ai)
#pragma unroll
            for (int m = 0; m < 4; ++m) {
                const int row = u.pm * BM + ai * HALF + wr * 64 + m * 16 + fr;
                const bool live = row < MTOT, isp = row < MP;
                const f32x4* sp = (const f32x4*)(ssq + (size_t)row * 16); const f32x4 s0 = sp[0], s1 = sp[1], s2 = sp[2], s3 = sp[3];
                const float ssum = ((s0[0] + s0[1]) + (s0[2] + s0[3])) + ((s1[0] + s1[1]) + (s1[2] + s1[3])) + ((s2[0] + s2[1]) + (s2[2] + s2[3])) + ((s3[0] + s3[1]) + (s3[2] + s3[3]));
                const float rt = 1.0f / sqrtf(ssum * (1.0f / DM) + EPS);
                const float* sw = shiftW + (size_t)bidx_of_row(row) * INWP + pn * BM + cw;
                const int b = isp ? (row >> 12) : ((row - MP) >> 2), t = isp ? (row & (TP - 1)) : ((row - MP) & 3);
#define PV(bj, n) (acc[ai][bj][m][n] * rt + *(const f32x4*)(sw + (bj) * HALF + (n) * 16))
                if constexpr (CASE == 0) {
                    bf16_t* Q = (bf16_t*)(ws + WS_Q) + (size_t)row * 512 + pn * BM + cw;
#pragma unroll
                    for (int bj = 0; bj < 2; ++bj)
#pragma unroll
                        for (int n = 0; n < 2; ++n) { const f32x4 v = PV(bj, n) * QSCALE; u32x2 w; w.x = pk2(v[0], v[1]); w.y = pk2(v[2], v[3]); *(u32x2*)(Q + bj * HALF + n * 16) = w; }
                } else if constexpr (CASE >= 1 && CASE <= 3) {
                    const size_t obase = CASE == 1 ? (isp ? O_KVC_P + (size_t)row * 256 : O_KVC_S + (size_t)(row - MP) * 256)
                                       : CASE == 2 ? (isp ? O_KVS_P + (size_t)row * 256 : O_KVS_S + (size_t)(row - MP) * 256)
                                       : (isp ? O_KVW_P + ((size_t)b * 512 + (t - (TP - 512))) * 256 : O_KVW_S + ((size_t)b * 512 + 508 + t) * 256);
                    const bool wout = live && (CASE != 3 || !isp || t >= TP - 512);
#pragma unroll
                    for (int bj = 0; bj < 2; ++bj)
#pragma unroll
                        for (int n = 0; n < 2; ++n) { const int j = bj * HALF + cw + n * 16; const f32x4 v = PV(bj, n);
                            if (wout) *(f32x4*)(out + obase + j) = v;
                            if (isp) { const int gg = (j >> 6) & 1, d = j & 63; u32x2 w; w.x = pk2(v[0], v[1]); w.y = pk2(v[2], v[3]);
                                if constexpr (CASE == 1) *(u32x2*)((bf16_t*)(ws + WS_ACP) + ((size_t)(bj * 8 + b * 2 + gg) * 256 + (t >> 4)) * 1024 + (t & 15) * 64 + d) = w;
                                else *(u32x2*)((bf16_t*)(ws + (CASE == 2 ? (bj ? WS_VS : WS_KS) : (bj ? WS_VW : WS_KW))) + ((size_t)(b * 2 + gg) * TP + t) * 64 + d) = w; } }
                } else if constexpr (CASE == 4) {
                    const bool wout = live && (isp ? t >= TP - 2 : t >= 2);
                    const size_t obase = isp ? O_CONV_P + ((size_t)b * 2 + (t - (TP - 2))) * 512 : O_CONV_S + ((size_t)b * 2 + (t - 2)) * 512;
#pragma unroll
                    for (int n = 0; n < 2; ++n) { const int j = (pn - 5) * HALF + cw + n * 16; const f32x4 v = PV(0, n) * PV(1, n);
                        u32x2 w; w.x = pk2(v[0], v[1]); w.y = pk2(v[2], v[3]); *(u32x2*)((bf16_t*)(ws + WS_PROD) + (size_t)row * 512 + j) = w;
                        if (wout) *(f32x4*)(out + obase + j) = v; }
                } else if constexpr (CASE == 5) {
#pragma unroll
                    for (int bj = 0; bj < 2; ++bj)
#pragma unroll
                        for (int n = 0; n < 2; ++n) { const int j = (pn - 9) * BM + bj * HALF + cw + n * 16; const f32x4 v = PV(bj, n);
                            u32x2 w; w.x = pk2(v[0], v[1]); w.y = pk2(v[2], v[3]); *(u32x2*)((bf16_t*)(ws + WS_CB) + (size_t)row * 512 + j) = w; }
                } else if constexpr (CASE == 6) {
#pragma unroll
                    for (int n = 0; n < 2; ++n) { const int j = (pn - 11) * HALF + cw + n * 16; const f32x4 a = PV(0, n), bb = PV(1, n);
                        float ra[4], gb[4];
#pragma unroll
                        for (int e = 0; e < 4; ++e) { const float sa = sigmoidf_(a[e]), sb = sigmoidf_(bb[e]); gb[e] = sb; ra[e] = sa / sb; }
                        u32x2 w; w.x = pk2(ra[0], ra[1]); w.y = pk2(ra[2], ra[3]); *(u32x2*)((bf16_t*)(ws + WS_RATIO) + (size_t)row * DM + j) = w;
                        u32x2 w2; w2.x = pk2(gb[0], gb[1]); w2.y = pk2(gb[2], gb[3]); *(u32x2*)((bf16_t*)(ws + WS_GB) + (size_t)row * DM + j) = w2; }
                } else {
                    if (wc == 0) {
#pragma unroll
                        for (int n = 0; n < 2; ++n) { const int j = n * 16 + 4 * fq; const f32x4 v = PV(0, n);
#pragma unroll
                            for (int e = 0; e < 4; ++e) if (j + e < 24) ((float*)(ws + WS_GATES))[(size_t)row * 24 + j + e] = sigmoidf_(v[e]); } }
                }
#undef PV
                asm volatile("" ::: "memory");
            }
    }
    __device__ __forceinline__ void operator()(const pg8::Acc& acc, const pg8::Unit& u, int wr, int wc, int fr, int fq) const {
        const int pn = u.pn;
        if (pn < 2) body<0>(acc, u, wr, wc, fr, fq);
        else if (pn == 2) body<1>(acc, u, wr, wc, fr, fq);
        else if (pn == 3) body<2>(acc, u, wr, wc, fr, fq);
        else if (pn == 4) body<3>(acc, u, wr, wc, fr, fq);
        else if (pn < 9) body<4>(acc, u, wr, wc, fr, fq);
        else if (pn < 11) body<5>(acc, u, wr, wc, fr, fq);
        else if (pn < 19) body<6>(acc, u, wr, wc, fr, fq);
        else body<7>(acc, u, wr, wc, fr, fq);
    }
};

struct EpiMerge {
    static constexpr bool PERM = true, HAS_MID = true;
    int mid_t; const bf16_t* RAT; const bf16_t* GB; bf16_t* MERGED;
    __device__ __forceinline__ void mid(pg8::Acc& acc, const pg8::Unit& u, int wr, int wc, int fr, int fq) const {
        using namespace pg8;
        asm volatile("" : "+v"(fr), "+v"(fq));
#pragma unroll
        for (int ai = 0; ai < 2; ++ai)
#pragma unroll
            for (int m = 0; m < 4; ++m) { const int row = u.pm * BM + ai * HALF + wr * 64 + m * 16 + fr;
#pragma unroll
                for (int bj = 0; bj < 2; ++bj) { const u32x4 r = *(const u32x4*)(RAT + (size_t)row * DM + u.pn * BM + bj * HALF + wc * 32 + 8 * fq);
                    acc[ai][bj][m][0] *= (f32x4){bflo(r.x), bfhi(r.x), bflo(r.y), bfhi(r.y)}; acc[ai][bj][m][1] *= (f32x4){bflo(r.z), bfhi(r.z), bflo(r.w), bfhi(r.w)}; }
                asm volatile("" ::: "memory"); }
    }
    __device__ __forceinline__ void operator()(const pg8::Acc& acc, const pg8::Unit& u, int wr, int wc, int fr, int fq) const {
        using namespace pg8;
#pragma unroll
        for (int ai = 0; ai < 2; ++ai)
#pragma unroll
            for (int m = 0; m < 4; ++m) { const int row = u.pm * BM + ai * HALF + wr * 64 + m * 16 + fr;
#pragma unroll
                for (int bj = 0; bj < 2; ++bj) { const size_t off = (size_t)row * DM + u.pn * BM + bj * HALF + wc * 32 + 8 * fq; const u32x4 r = *(const u32x4*)(GB + off);
                    const f32x4 v0 = acc[ai][bj][m][0] * (f32x4){bflo(r.x), bfhi(r.x), bflo(r.y), bfhi(r.y)}, v1 = acc[ai][bj][m][1] * (f32x4){bflo(r.z), bfhi(r.z), bflo(r.w), bfhi(r.w)};
                    u32x4 w; w.x = pk2(v0[0], v0[1]); w.y = pk2(v0[2], v0[3]); w.z = pk2(v1[0], v1[1]); w.w = pk2(v1[2], v1[3]); *(u32x4*)(MERGED + off) = w; }
                asm volatile("" ::: "memory"); }
    }
};

__device__ __forceinline__ float gelu_tanh(float x) { const float u = 0.7978845608028654f * (x + 0.044715f * x * x * x); const float e = fast_exp2(2.0f * LOG2E * u); return 0.5f * x * (2.0f - 2.0f * fast_rcp(1.0f + e)); }
template <bool SAMPLE> __device__ __forceinline__ void cmp_tail_item(const Ctx& X, int item, unsigned char* ws, const float* w_cmp2) {
    constexpr int NR = SAMPLE ? 512 : 256, NCH = NR / 64, NBG = SAMPLE ? 64 : 8, NVALID = NR - 1;
    const int c = item / (NBG * NCH), bg = (item / NCH) % NBG, n0 = (item % NCH) * 64;
    LAS float* w2s = (LAS float*)X.lds; LAS float* hid = (LAS float*)(X.lds + 32768);
    const float* w2 = w_cmp2 + (size_t)c * 128 * 64; const float* pet = (const float*)(ws + WS_PETERM) + c * 128;
    const bf16_t* P = (const bf16_t*)(ws + (SAMPLE ? WS_PCS : WS_PCP)) + (size_t)c * (NBG * NR) * 256;
    for (int i = X.tid; i < 128 * 64 / 4; i += NTHR) ((LAS f32x4*)w2s)[i] = ((const f32x4*)w2)[i];
    for (int idx = X.tid; idx < 64 * 128; idx += NTHR) { const int r = idx >> 7, e = idx & 127; const size_t base = (size_t)(bg * NR + n0 + r) * 256;
        const float v = bf2f(P[base + e]) + bf2f(P[base + 256 + 128 + e]) + pet[e]; hid[r * 129 + e] = gelu_tanh(v); }
    LDS_WAIT(); __syncthreads();
    const int r = X.tid >> 3, d0 = (X.tid & 7) * 8, n = n0 + r;
    float acc[8];
#pragma unroll
    for (int i = 0; i < 8; ++i) acc[i] = 0.f;
#pragma unroll 4
    for (int e = 0; e < 128; ++e) { const float h = hid[r * 129 + e]; const f32x4 wa = *(const LAS f32x4*)(w2s + e * 64 + d0), wb = *(const LAS f32x4*)(w2s + e * 64 + d0 + 4);
        acc[0] += h * wa[0]; acc[1] += h * wa[1]; acc[2] += h * wa[2]; acc[3] += h * wa[3]; acc[4] += h * wb[0]; acc[5] += h * wb[1]; acc[6] += h * wb[2]; acc[7] += h * wb[3]; }
    if constexpr (SAMPLE) {
        if (n < NVALID) { float* o = (float*)(ws + WS_KVCS) + (((size_t)bg * 512 + n) * 2 + c) * 64 + d0; *(f32x4*)o = (f32x4){acc[0], acc[1], acc[2], acc[3]}; *(f32x4*)(o + 4) = (f32x4){acc[4], acc[5], acc[6], acc[7]}; }
    } else {
        u32x4 w; if (n < NVALID) { w.x = pk2(acc[0], acc[1]); w.y = pk2(acc[2], acc[3]); w.z = pk2(acc[4], acc[5]); w.w = pk2(acc[6], acc[7]); } else w = (u32x4){0u, 0u, 0u, 0u};
        *(u32x4*)((bf16_t*)(ws + (c ? WS_VCP : WS_KCP)) + ((size_t)bg * 256 + n) * 64 + d0) = w;
    }
    __syncthreads();
}

namespace att {
typedef float f32x16 __attribute__((ext_vector_type(16)));
typedef short s16x4 __attribute__((ext_vector_type(4)));
typedef float f32x2_t __attribute__((ext_vector_type(2))); typedef __bf16 bf16x2_t __attribute__((ext_vector_type(2)));
constexpr int L_K = 0, L_V = 16384, L_WSF = 32768, L_BIAS = 36864, L_GATE = 38912, L_SEL = 41984, L_ANY = 42496, L_PSUM = 43008, L_SC = 108800, L_OST = 43008, PS_LD = 257, SC_LD = 65;
static_assert(L_SC + 64 * SC_LD * 4 <= RING_BYTES, "attention LDS map");
__constant__ unsigned char kBucket[128] = {0, 1, 2, 3, 4, 5, 6, 7, 8, 9, 10, 11, 12, 13, 14, 15, 16, 16, 16, 17, 17, 18, 18, 18, 19, 19, 19, 20, 20, 20, 20, 21, 21, 21, 21, 22, 22, 22, 22, 22, 23, 23, 23, 23, 23, 23, 24, 24, 24, 24, 24, 24, 25, 25, 25, 25, 25, 25, 25, 26, 26, 26, 26, 26, 26, 26, 26, 27, 27, 27, 27, 27, 27, 27, 27, 27, 27, 28, 28, 28, 28, 28, 28, 28, 28, 28, 28, 29, 29, 29, 29, 29, 29, 29, 29, 29, 29, 29, 29, 30, 30, 30, 30, 30, 30, 30, 30, 30, 30, 30, 30, 30, 30, 31, 31, 31, 31, 31, 31, 31, 31, 31, 31, 31, 31, 31, 31, 31};
__device__ __forceinline__ int crow(int r, int hi) { return (r & 3) + 8 * (r >> 2) + 4 * hi; }
__device__ __forceinline__ unsigned cvtpk_s(float lo, float hi) { f32x2_t v = {lo, hi}; bf16x2_t b = __builtin_convertvector(v, bf16x2_t); return __builtin_bit_cast(unsigned, b); }
#define ATT_SBAR() __builtin_amdgcn_sched_barrier(0)
__device__ __forceinline__ void qkt(f32x16& p0, f32x16& p1, const LAS unsigned char* Kslot, const bf16x8* qr, int r32, int hi) {
    const LAS unsigned char* kb = Kslot + hi * 1024 + r32 * 16;
    f32x16 z;
#pragma unroll
    for (int r = 0; r < 16; ++r) z[r] = 0.f;
    p0 = z; p1 = z;
#pragma unroll
    for (int d0 = 0; d0 < 4; ++d0) {
        const bf16x8 b0 = *(const LAS bf16x8*)(kb + d0 * 2048), b1 = *(const LAS bf16x8*)(kb + d0 * 2048 + 512);
        p0 = __builtin_amdgcn_mfma_f32_32x32x16_bf16(b0, qr[d0], p0, 0, 0, 0); p1 = __builtin_amdgcn_mfma_f32_32x32x16_bf16(b1, qr[d0], p1, 0, 0, 0); }
}
__device__ __forceinline__ float rowmax(const f32x16& p0, const f32x16& p1) {
    float a = fmaxf(p0[0], p1[0]);
#pragma unroll
    for (int r = 1; r < 16; ++r) a = fmaxf(a, fmaxf(p0[r], p1[r]));
    auto rr = __builtin_amdgcn_permlane32_swap(__float_as_uint(a), __float_as_uint(a), false, false);
    return fmaxf(__uint_as_float(rr[0]), __uint_as_float(rr[1]));
}
__device__ __forceinline__ float halfsum(float a) { auto rr = __builtin_amdgcn_permlane32_swap(__float_as_uint(a), __float_as_uint(a), false, false); return __uint_as_float(rr[0]) + __uint_as_float(rr[1]); }
__device__ __forceinline__ void pv(f32x16* o, int vb, bf16x8 pa0, bf16x8 pa1, bf16x8 pa2, bf16x8 pa3) {
#pragma unroll
    for (int d0 = 0; d0 < 2; ++d0) { s16x4 lo[4], hi[4];
#pragma unroll
        for (int ks = 0; ks < 4; ++ks) {
            asm volatile("ds_read_b64_tr_b16 %0,%1 offset:%c2" : "=&v"(lo[ks]) : "v"(vb), "i"(d0 * 4096 + ks * 1024) : "memory");
            asm volatile("ds_read_b64_tr_b16 %0,%1 offset:%c2" : "=&v"(hi[ks]) : "v"(vb), "i"(d0 * 4096 + ks * 1024 + 512) : "memory"); }
        asm volatile("s_waitcnt lgkmcnt(0)" ::: "memory"); ATT_SBAR();
#define ATT_PK(k) (bf16x8){lo[k][0], lo[k][1], lo[k][2], lo[k][3], hi[k][0], hi[k][1], hi[k][2], hi[k][3]}
        o[d0] = __builtin_amdgcn_mfma_f32_32x32x16_bf16(pa0, ATT_PK(0), o[d0], 0, 0, 0);
        o[d0] = __builtin_amdgcn_mfma_f32_32x32x16_bf16(pa1, ATT_PK(1), o[d0], 0, 0, 0);
        o[d0] = __builtin_amdgcn_mfma_f32_32x32x16_bf16(pa2, ATT_PK(2), o[d0], 0, 0, 0);
        o[d0] = __builtin_amdgcn_mfma_f32_32x32x16_bf16(pa3, ATT_PK(3), o[d0], 0, 0, 0);
#undef ATT_PK
    }
}
struct KVRegs { u32x4 k, v; };
__device__ __forceinline__ void stage_load(KVRegs& R, const bf16_t* Kg, const bf16_t* Vg, int tid) { const int off = (tid >> 3) * 64 + (tid & 7) * 8; R.k = *(const u32x4*)(Kg + off); R.v = *(const u32x4*)(Vg + off); }
__device__ __forceinline__ void stage_store(const KVRegs& R, LAS unsigned char* lds, int slot, int tid) { const int key = tid >> 3, ch = tid & 7;
    *(LAS u32x4*)(lds + L_K + slot * 8192 + ch * 1024 + key * 16) = R.k;
    *(LAS u32x4*)(lds + L_V + slot * 8192 + ((ch >> 2) * 4 + (key >> 4)) * 1024 + (key & 15) * 64 + (ch & 3) * 16) = R.v; }
struct SM { float m, l; f32x16 o[2]; };
__device__ __forceinline__ void sm_init(SM& s) { s.m = -1e30f; s.l = 0.f;
#pragma unroll
    for (int r = 0; r < 16; ++r) { s.o[0][r] = 0.f; s.o[1][r] = 0.f; } }
template <bool WITH_O> __device__ __forceinline__ void sm_update(SM& s, f32x16& p0, f32x16& p1, LAS float* wsf, int r32, int hi) {
    const float rm = rowmax(p0, p1), mnew = fmaxf(s.m, rm);
    if (__any(mnew > s.m)) {
        const float alpha = fast_exp2(s.m - mnew); s.l *= alpha;
        if constexpr (WITH_O) { if (hi == 0) wsf[r32] = alpha; LDS_WAIT();
#pragma unroll
            for (int r = 0; r < 16; ++r) { const float f = wsf[crow(r, hi)]; s.o[0][r] *= f; s.o[1][r] *= f; }
            LDS_WAIT(); }
        s.m = mnew;
    }
    float sum = 0.f;
#pragma unroll
    for (int r = 0; r < 16; ++r) { p0[r] = fast_exp2(p0[r] - s.m); p1[r] = fast_exp2(p1[r] - s.m); sum += p0[r] + p1[r]; }
    s.l += sum;
}
template <int MODE> __device__ __forceinline__ void mask_bias(f32x16& p0, f32x16& p1, int T, bool far, bool lsel, int qpos, int hi, const LAS float* bT, float b31) {
    const float NEG = -INFINITY;
    if (MODE != 0 && far) {
#pragma unroll
        for (int r = 0; r < 16; ++r) { p0[r] = lsel ? p0[r] + b31 : NEG; p1[r] = lsel ? p1[r] + b31 : NEG; }
    } else {
        int base = MODE == 0 ? qpos - 1024 * T - 64 * hi - 31 : qpos - 64 * T - 4 * hi;
        asm volatile("" : "+v"(base));
#pragma unroll
        for (int r = 0; r < 16; ++r) { const int kk = (r & 3) + 8 * (r >> 2); int d0, d1; bool v0, v1;
            if (MODE == 0) { d0 = base - 16 * kk; d1 = d0 - 512; v0 = d0 >= 0; v1 = d1 >= 0; }
            else { d0 = base - kk; d1 = d0 - 32; if (MODE == 1) { v0 = lsel && d0 >= 0; v1 = lsel && d1 >= 0; } else { v0 = d0 >= 0 && d0 < 512; v1 = d1 >= 0 && d1 < 512; } }
            const float b0 = bT[min(max(d0, 0), 127)], b1 = bT[min(max(d1, 0), 127)];
            p0[r] = v0 ? p0[r] + b0 : NEG; p1[r] = v1 ? p1[r] + b1 : NEG; }
    }
}
#define ATT_PACK(pw, P, B) pw = (u32x4){cvtpk_s(P[B], P[B + 1]), cvtpk_s(P[B + 2], P[B + 3]), cvtpk_s(P[B + 4], P[B + 5]), cvtpk_s(P[B + 6], P[B + 7])}
#define ATT_PV(S_, SLOT) do { u32x4 pw0, pw1, pw2, pw3; ATT_PACK(pw0, p0, 0); ATT_PACK(pw1, p0, 8); ATT_PACK(pw2, p1, 0); ATT_PACK(pw3, p1, 8); ATT_SBAR(); \
    pv((S_).o, vb0 + (SLOT) * 8192, __builtin_bit_cast(bf16x8, pw0), __builtin_bit_cast(bf16x8, pw1), __builtin_bit_cast(bf16x8, pw2), __builtin_bit_cast(bf16x8, pw3)); } while (0)
#define ATT_TILE_LOOP(NT, FIRST, NEXTEXPR, KB, VB, BODY) do { int tcur_ = (FIRST); stage_load(R, (KB) + (size_t)tcur_ * 4096, (VB) + (size_t)tcur_ * 4096, tid); stage_store(R, lds, 0, tid); LDS_WAIT(); __syncthreads(); \
    for (int i_ = 0; i_ < (NT); ++i_) { const bool more_ = i_ + 1 < (NT); int tnext_ = tcur_; \
        if (more_) { tnext_ = (NEXTEXPR); stage_load(R, (KB) + (size_t)tnext_ * 4096, (VB) + (size_t)tnext_ * 4096, tid); } \
        { const int T = tcur_; const int SLOT = i_ & 1; BODY } \
        if (more_) stage_store(R, lds, (i_ + 1) & 1, tid); \
        LDS_WAIT(); __syncthreads(); tcur_ = tnext_; } } while (0)
#define ATT_FINISH(S_, BR) do { const float lt_ = halfsum((S_).l); const float inv_ = lt_ > 0.f ? 1.0f / lt_ : 0.f; \
    if (hi == 0) wsf[64 + r32] = inv_ * gt[qloc * 12 + (BR) * 4 + hh]; LDS_WAIT(); \
    _Pragma("unroll") for (int r = 0; r < 16; ++r) { const float f = wsf[64 + crow(r, hi)]; oacc[0][r] += (S_).o[0][r] * f; oacc[1][r] += (S_).o[1][r] * f; } LDS_WAIT(); asm volatile("" : "+v"(oacc[0]), "+v"(oacc[1])); } while (0)

__device__ __forceinline__ void prompt_item(const Ctx& X, int bg, int qt, unsigned char* ws, const float* rel_bias) {
    LAS unsigned char* lds = X.lds; int tid = X.tid; asm volatile("" : "+v"(tid));
    const int lane = tid & 63, wid = __builtin_amdgcn_readfirstlane(tid >> 6), r32 = lane & 31, hi = lane >> 5;
    const int b = bg >> 1, g = bg & 1, hh = wid >> 1, qh = wid & 1, q0 = qt * 64, qloc = qh * 32 + r32, qpos = q0 + qloc;
    LAS float* biasT = (LAS float*)(lds + L_BIAS); LAS float* gt = (LAS float*)(lds + L_GATE); LAS float* psum = (LAS float*)(lds + L_PSUM); LAS float* sc = (LAS float*)(lds + L_SC);
    LAS float* wsf = (LAS float*)(lds + L_WSF) + wid * 128;
    const float* GATES = (const float*)(ws + WS_GATES);
    biasT[tid] = rel_bias[(int)kBucket[tid & 127] * 8 + g * 4 + (tid >> 7)] * LOG2E;
    for (int i = tid; i < 64 * 12; i += NTHR) { const int q = i / 12, e = i % 12; gt[i] = GATES[((size_t)b * TP + q0 + q) * 24 + (e >> 2) * 8 + g * 4 + (e & 3)]; }
    for (int i = tid; i < 64 * PS_LD; i += NTHR) psum[i] = 0.f;
    if (tid < 2) ((LAS unsigned*)(lds + L_ANY))[tid] = 0u;
    bf16x8 qr[4];
    { const bf16_t* Qp = (const bf16_t*)(ws + WS_Q) + ((size_t)b * TP + qpos) * 512 + (g * 4 + hh) * 64 + hi * 8;
#pragma unroll
      for (int d0 = 0; d0 < 4; ++d0) qr[d0] = *(const bf16x8*)(Qp + d0 * 16); }
    LDS_WAIT(); __syncthreads();
    const LAS float* bT = biasT + hh * 128; const float b31 = bT[127];
    const int vb0 = (int)(unsigned)(uintptr_t)(lds + L_V) + ((lane >> 4) & 1) * 32 + (lane & 3) * 8 + (4 * hi + ((lane & 15) >> 2)) * 64;
    f32x16 oacc[2];
#pragma unroll
    for (int r = 0; r < 16; ++r) { oacc[0][r] = 0.f; oacc[1][r] = 0.f; }
    KVRegs R; f32x16 p0, p1;
    { const bf16_t* KC = (const bf16_t*)(ws + WS_KCP) + (size_t)bg * 256 * 64; const bf16_t* VC = (const bf16_t*)(ws + WS_VCP) + (size_t)bg * 256 * 64;
      const int ncv = min(4 * qt + 3, 255), ntc = (ncv + 63) >> 6;
      SM s; sm_init(s);
      ATT_TILE_LOOP(ntc, 0, tcur_ + 1, KC, VC, {
          qkt(p0, p1, lds + L_K + SLOT * 8192, qr, r32, hi); mask_bias<0>(p0, p1, T, false, true, qpos, hi, bT, b31); sm_update<false>(s, p0, p1, wsf, r32, hi); });
      const float ltot = halfsum(s.l), invl = ltot > 0.f ? 1.0f / ltot : 0.f; s.l = 0.f;
      ATT_TILE_LOOP(ntc, 0, tcur_ + 1, KC, VC, {
          qkt(p0, p1, lds + L_K + SLOT * 8192, qr, r32, hi); mask_bias<0>(p0, p1, T, false, true, qpos, hi, bT, b31);
          float sum = 0.f;
          _Pragma("unroll") for (int r = 0; r < 16; ++r) { p0[r] = fast_exp2(p0[r] - s.m); p1[r] = fast_exp2(p1[r] - s.m); sum += p0[r] + p1[r]; }
          s.l += sum;
          for (int rr = 0; rr < 4; ++rr) { if (hh == rr) { LAS float* pr = psum + qloc * PS_LD + 64 * T;
              _Pragma("unroll") for (int r = 0; r < 16; ++r) { pr[crow(r, hi)] += p0[r] * invl; pr[32 + crow(r, hi)] += p1[r] * invl; } }
              LDS_WAIT(); __syncthreads(); }
          ATT_PV(s, SLOT); });
      ATT_FINISH(s, 0);
    }
    { const int q = tid >> 3, jg = tid & 7; float myv[8];
#pragma unroll
      for (int i = 0; i < 8; ++i) { const int j = jg * 8 + i; const LAS float* pr = psum + q * PS_LD + 4 * j;
          const float v = 2.0f * (pr[0] + pr[1] + pr[2]) + pr[3] + (j > 0 ? pr[-1] : 0.f);
          const bool valid = j <= qt, forced = (j == 0) || (j == qt) || (j == qt - 1);
          const float sv = valid ? v + (forced ? 1000.0f : 0.f) : -1e9f; myv[i] = sv; sc[q * SC_LD + j] = sv; }
      LDS_WAIT(); __syncthreads();
      int cnt[8];
#pragma unroll
      for (int i = 0; i < 8; ++i) cnt[i] = 0;
      for (int k = 0; k < 64; ++k) { const float v = sc[q * SC_LD + k];
#pragma unroll
          for (int i = 0; i < 8; ++i) cnt[i] += ((v > myv[i]) || (v == myv[i] && k < jg * 8 + i)) ? 1 : 0; }
      unsigned bits = 0u;
#pragma unroll
      for (int i = 0; i < 8; ++i) if (cnt[i] < 16 && jg * 8 + i <= qt) bits |= 1u << i;
      ((LAS unsigned char*)(lds + L_SEL))[q * 8 + jg] = (unsigned char)bits;
      atomicOr((unsigned*)((LAS unsigned*)(lds + L_ANY) + (jg >> 2)), bits << (8 * (jg & 3)));
      LDS_WAIT(); __syncthreads(); }
    { const unsigned lo_ = ((LAS unsigned*)(lds + L_SEL))[qloc * 2], hi_ = ((LAS unsigned*)(lds + L_SEL))[qloc * 2 + 1]; const unsigned long long selm = ((unsigned long long)hi_ << 32) | lo_;
      const unsigned long long anym = ((unsigned long long)((LAS unsigned*)(lds + L_ANY))[1] << 32) | ((LAS unsigned*)(lds + L_ANY))[0];
      unsigned long long rem = anym; const int nts = __builtin_popcountll(anym);
      const bf16_t* KS = (const bf16_t*)(ws + WS_KS) + (size_t)bg * TP * 64; const bf16_t* VS = (const bf16_t*)(ws + WS_VS) + (size_t)bg * TP * 64;
      SM s; sm_init(s);
      ATT_TILE_LOOP(nts, __builtin_ctzll(rem), (rem &= rem - 1, __builtin_ctzll(rem)), KS, VS, {
          qkt(p0, p1, lds + L_K + SLOT * 8192, qr, r32, hi); mask_bias<1>(p0, p1, T, T + 3 <= qt, ((selm >> T) & 1ull) != 0ull, qpos, hi, bT, b31);
          sm_update<true>(s, p0, p1, wsf, r32, hi); ATT_PV(s, SLOT); });
      ATT_FINISH(s, 1);
    }
    { const int jw0 = max(0, qt - 8), ntw = qt - jw0 + 1;
      const bf16_t* KW = (const bf16_t*)(ws + WS_KW) + (size_t)bg * TP * 64; const bf16_t* VW = (const bf16_t*)(ws + WS_VW) + (size_t)bg * TP * 64;
      SM s; sm_init(s);
      ATT_TILE_LOOP(ntw, jw0, tcur_ + 1, KW, VW, {
          qkt(p0, p1, lds + L_K + SLOT * 8192, qr, r32, hi); mask_bias<2>(p0, p1, T, (T + 3 <= qt) && (T + 8 > qt), true, qpos, hi, bT, b31);
          sm_update<true>(s, p0, p1, wsf, r32, hi); ATT_PV(s, SLOT); });
      ATT_FINISH(s, 2);
    }
    { LAS bf16_t* stg = (LAS bf16_t*)(lds + L_OST + wid * 4096);
#pragma unroll
      for (int r = 0; r < 16; ++r) { stg[crow(r, hi) * 64 + r32] = (bf16_t)f2bf(oacc[0][r]); stg[crow(r, hi) * 64 + 32 + r32] = (bf16_t)f2bf(oacc[1][r]); }
      LDS_WAIT();
      bf16_t* O = (bf16_t*)(ws + WS_ACAT) + ((size_t)b * TP + q0 + qh * 32) * DM + (g * 4 + hh) * 64;
#pragma unroll
      for (int i = 0; i < 4; ++i) { const int row = i * 8 + (lane >> 3), ch = lane & 7; const u32x4 v = *(const LAS u32x4*)(stg + row * 64 + ch * 8); *(u32x4*)(O + (size_t)row * DM + ch * 8) = v; }
    }
    LDS_WAIT(); __syncthreads();
}

constexpr int S_SC = 0, S_SCLD = 1040, S_PSUM = 16640  , S_SCORE = 18752  , S_SELIDX = 19328  , S_Q = 19456  , S_OH = 20480  , S_STAT = 22528  , S_GATE = 22592  , S_BIAS = 22656  ;
struct SampleCtx { int b, g, s, qpos; const float* cache_sel; const float* state_win; const int* pt; const float* out; const float* kvcs; };
template <int BR> __device__ __forceinline__ void skey(const SampleCtx& C, const LAS int* selidx, int k, const float*& Kp, int& dist, bool& valid) {
    if (BR == 0) { Kp = C.kvcs + (((size_t)(C.b * 2 + C.g) * 512 + k) * 2) * 64; dist = C.qpos - (16 * k + 31); valid = true; }
    else if (BR == 1) { const int j = selidx[k >> 6], r = k & 63;
        if (j < 128) { const int page = C.pt[C.b * NPAGE + (j >> 1)]; Kp = C.cache_sel + ((size_t)page * PAGE + (j & 1) * 64 + r) * 256 + C.g * 64; dist = C.qpos - (64 * j + r); valid = true; }
        else { const int rr = r < TS ? r : 0; Kp = C.out + O_KVS_S + ((size_t)C.b * TS + rr) * 256 + C.g * 64; dist = C.qpos - (PAST + r); valid = r <= C.s; } }
    else { Kp = (k < 512 ? C.state_win + ((size_t)C.b * 512 + k) * 256 : C.out + O_KVW_S + ((size_t)C.b * 512 + 508 + (k - 512)) * 256) + C.g * 64; dist = C.qpos - (PAST - 512 + k); valid = dist >= 0 && dist < 512; }
}
template <int BR> __device__ __forceinline__ void sample_branch(const Ctx& X, int tid, const SampleCtx& C, int nkeys, float& ofinal) {
    LAS unsigned char* lds = X.lds; const int lane = tid & 63, wid = __builtin_amdgcn_readfirstlane(tid >> 6);
    LAS float* scs = (LAS float*)(lds + S_SC); LAS float* qs = (LAS float*)(lds + S_Q); LAS float* oh = (LAS float*)(lds + S_OH); LAS float* stat = (LAS float*)(lds + S_STAT);
    LAS float* gts = (LAS float*)(lds + S_GATE); LAS float* bT = (LAS float*)(lds + S_BIAS); const LAS int* selidx = (const LAS int*)(lds + S_SELIDX);
    constexpr int VOFF = BR == 0 ? 64 : 128;
    { const int grp = tid >> 4, li = tid & 15; f32x4 q4[4];
#pragma unroll
      for (int h = 0; h < 4; ++h) q4[h] = *(const LAS f32x4*)(qs + h * 64 + li * 4);
      for (int k = grp; k < nkeys; k += 32) { const float* Kp; int dist; bool valid; skey<BR>(C, selidx, k, Kp, dist, valid);
          const f32x4 kx = *(const f32x4*)(Kp + li * 4); float pt4[4];
#pragma unroll
          for (int h = 0; h < 4; ++h) { float d = (kx[0] * q4[h][0] + kx[1] * q4[h][1]) + (kx[2] * q4[h][2] + kx[3] * q4[h][3]);
              d += __shfl_xor(d, 1); d += __shfl_xor(d, 2); d += __shfl_xor(d, 4); d += __shfl_xor(d, 8); pt4[h] = d; }
          if (li < 4) { const float d = li == 0 ? pt4[0] : li == 1 ? pt4[1] : li == 2 ? pt4[2] : pt4[3];
              scs[li * S_SCLD + k] = valid ? d + bT[li * 128 + min(max(dist, 0), 127)] : -INFINITY; } } }
    LDS_WAIT(); __syncthreads();
    if (wid < 4) { LAS float* sr = scs + wid * S_SCLD; float m = -INFINITY;
        for (int k = lane; k < nkeys; k += 64) m = fmaxf(m, sr[k]);
#pragma unroll
        for (int o = 1; o < 64; o <<= 1) m = fmaxf(m, __shfl_xor(m, o));
        if (m == -INFINITY) m = 0.f;
        float l = 0.f;
        for (int k = lane; k < nkeys; k += 64) { const float e = fast_exp2(sr[k] - m); sr[k] = e; l += e; }
#pragma unroll
        for (int o = 1; o < 64; o <<= 1) l += __shfl_xor(l, o);
        if (lane == 0) { stat[wid] = m; stat[4 + wid] = l; } }
    LDS_WAIT(); __syncthreads();
    { const int half = tid >> 8, h = (tid >> 6) & 3, d = tid & 63; float acc = 0.f; const LAS float* er = scs + h * S_SCLD;
#pragma unroll 4
      for (int k = half; k < nkeys; k += 2) { const float* Kp; int dist; bool valid; skey<BR>(C, selidx, k, Kp, dist, valid); acc += er[k] * Kp[VOFF + d]; }
      oh[(half * 4 + h) * 64 + d] = acc; }
    LDS_WAIT(); __syncthreads();
    if (tid < 256) { const int h = tid >> 6, d = tid & 63; const float l = stat[4 + h]; ofinal += (oh[h * 64 + d] + oh[(4 + h) * 64 + d]) * (l > 0.f ? 1.0f / l : 0.f) * gts[BR * 4 + h]; }
}
__device__ __forceinline__ void sample_item(const Ctx& X, int item, unsigned char* ws, const Args& A) {
    LAS unsigned char* lds = X.lds; int tid = X.tid; asm volatile("" : "+v"(tid));
    SampleCtx C; C.b = item >> 3; C.g = (item >> 2) & 1; C.s = item & 3; C.qpos = PAST + C.s; C.cache_sel = A.in[3]; C.state_win = A.in[4]; C.pt = (const int*)A.in[6]; C.out = A.out; C.kvcs = (const float*)(ws + WS_KVCS);
    const int mrow = MP + C.b * TS + C.s;
    LAS float* scs = (LAS float*)(lds + S_SC); LAS float* qs = (LAS float*)(lds + S_Q); LAS float* stat = (LAS float*)(lds + S_STAT); LAS float* gts = (LAS float*)(lds + S_GATE); LAS float* bT = (LAS float*)(lds + S_BIAS);
    LAS float* psum = (LAS float*)(lds + S_PSUM); LAS float* score = (LAS float*)(lds + S_SCORE); LAS int* selidx = (LAS int*)(lds + S_SELIDX);
    bT[tid] = A.in[24][(int)kBucket[tid & 127] * 8 + C.g * 4 + (tid >> 7)] * LOG2E;
    if (tid < 256) qs[tid] = bf2f(((const bf16_t*)(ws + WS_Q))[(size_t)mrow * 512 + C.g * 256 + tid]);
    if (tid < 12) gts[tid] = ((const float*)(ws + WS_GATES))[(size_t)mrow * 24 + (tid >> 2) * 8 + C.g * 4 + (tid & 3)];
    LDS_WAIT(); __syncthreads();
    float ofinal = 0.f;
    sample_branch<0>(X, tid, C, 511, ofinal);
    for (int n = tid; n < 520; n += NTHR) { float v = 0.f; if (n < 511) { v = scs[n] / stat[4] + scs[S_SCLD + n] / stat[5] + scs[2 * S_SCLD + n] / stat[6] + scs[3 * S_SCLD + n] / stat[7]; } psum[n] = v; }
    LDS_WAIT(); __syncthreads();
    if (tid < 129) { const int j = tid; const float v = 2.0f * (psum[4 * j] + psum[4 * j + 1] + psum[4 * j + 2]) + psum[4 * j + 3] + (j > 0 ? psum[4 * j - 1] : 0.f);
        score[j] = v + ((j == 0 || j == 128 || j == 127) ? 1000.0f : 0.f); }
    LDS_WAIT(); __syncthreads();
    if (tid < 129) { const float mv = score[tid]; int cnt = 0; for (int k = 0; k < 129; ++k) { const float v = score[k]; cnt += ((v > mv) || (v == mv && k < tid)) ? 1 : 0; } if (cnt < 16) selidx[cnt] = tid; }
    LDS_WAIT(); __syncthreads();
    sample_branch<1>(X, tid, C, 1024, ofinal);
    __syncthreads();
    sample_branch<2>(X, tid, C, 516, ofinal);
    if (tid < 256) ((bf16_t*)(ws + WS_ACAT))[(size_t)mrow * DM + C.g * 256 + tid] = (bf16_t)f2bf(ofinal);
    LDS_WAIT(); __syncthreads();
}
}

__global__ void __launch_bounds__(NTHR, 2) nsa_fwd(Args args) {
    extern __shared__ __attribute__((aligned(16))) unsigned char lds_raw[];
    Ctx X; X.lds = (LAS unsigned char*)lds_raw; X.tid = threadIdx.x; X.lane = X.tid & 63; X.wave = __builtin_amdgcn_readfirstlane(X.tid >> 6);
    X.G = gridDim.x; { const int bx = blockIdx.x; X.vcu = (X.G % 8 == 0) ? (bx % 8) * (X.G / 8) + bx / 8 : bx; }
    X.gw = X.vcu * NWAVES + X.wave; X.NGW = X.G * NWAVES;
    unsigned char* ws = args.ws; float* out = args.out;
    gu32* ctl = (gu32*)(ws + WS_CTL);
    volatile LAS unsigned* MISC = (volatile LAS unsigned*)(X.lds + MISC_OFF);
    for (int u = X.tid; u < (LDS_BYTES - LDSCTL_OFF) / 4; u += NTHR) ((LAS unsigned*)(X.lds + LDSCTL_OFF))[u] = 0u;
    __syncthreads();
    XcdBarrier bar; bar.bar = (unsigned*)(ctl + CW_BAR); bar.x = 0; bar.st = nullptr;
#if !MK_PER_PHASE
    bar = xcd_barrier_post((unsigned*)(ctl + CW_BAR), MISC + 8);
#define GRID_BAR() xcd_barrier(bar)
#else
#define GRID_BAR() do { } while (0)
#endif
    const int lo = args.ph_lo, hi = args.ph_hi;
#define IN(k) (lo <= (k) && (k) < hi)
#define BOTH(k) (IN(k) && IN((k) + 1))
    float* modv = (float*)(ws + WS_MOD);
    const float* x_p = args.in[0]; const float* x_s = args.in[1];

#if MK_PROBE
    if (IN(-1)) { f32x4* o4 = (f32x4*)(out + O_KVC_P); const size_t n4 = (O_TOTAL - O_KVC_P) / 4;
        for (size_t i = (size_t)X.gw * 64 + X.lane; i < n4; i += (size_t)X.NGW * 64) o4[i] = (f32x4){100.f, 100.f, 100.f, 100.f}; }
#endif
    if (MK_PH_ON(0) && IN(0)) {
        for (int it = X.vcu; it < NMOD / 64; it += X.G) ada_item(X, it, args.in[7], args.in[8], args.in[9], args.in[10], modv);
        __syncthreads();
        {
            LAS float* scr = (LAS float*)(X.lds + X.wave * 16384);
            int total = 0;
            for (int j = 0; j < NJOBS; ++j) total += tj_items(kJobs[j]);
            for (int it = X.gw; it < total; it += X.NGW) {
                int r = it, j = 0;
                for (; j < NJOBS - 1; ++j) { const int n = tj_items(kJobs[j]); if (r < n) break; r -= n; }
                const TJ J = kJobs[j];
                const int nblk = (J.ncols + 31) / 32, per = (J.K / 64) * nblk, rep = r / per, rr = r % per, kb = rr / nblk, nb = rr % nblk;
                const float* W = args.in[J.src] + (size_t)rep * J.srcoff_stride + J.col0 + rep * J.col_stride;
                bf16_t* WT = wdst(ws, J.dst) + (size_t)(J.drow0 + rep * J.drow_stride) * J.dpitch + J.dcol0;
                transpose_item(W, J.N, J.ncols, WT, J.dpitch, scr, kb, nb, X.lane);
            }
            { u32x4* z = (u32x4*)((bf16_t*)(ws + WS_WIN) + (size_t)INW * DM); const int nz = (INWP - INW) * DM * 2 / 16;
              for (int i = X.gw * 64 + X.lane; i < nz; i += X.NGW * 64) z[i] = (u32x4){0u, 0u, 0u, 0u}; }
        }
        for (int o = X.gw; o < 256; o += X.NGW) { const int c = o >> 7, e = o & 127; const float* pe = args.in[19] + c * 2048; const float* w1 = args.in[17] + (size_t)c * 2048 * 128 + e;
            float s = 0.f; for (int k = X.lane; k < 2048; k += 64) s += pe[k] * w1[(size_t)k * 128];
#pragma unroll
            for (int off = 1; off < 64; off <<= 1) s += __shfl_xor(s, off);
            if (X.lane == 0) ((float*)(ws + WS_PETERM))[o] = s; }
        { const f32x4* src = (const f32x4*)args.in[4]; f32x4* dst = (f32x4*)(out + O_KVW_S); const int per_b = 508 * 64;
          for (int i = X.gw * 64 + X.lane; i < NBS * per_b; i += X.NGW * 64) { const int b = i / per_b, r = i % per_b; dst[(size_t)b * 512 * 64 + r] = src[(size_t)b * 512 * 64 + 4 * 64 + r]; } }
        { const int* pt = (const int*)args.in[6]; const float* cache = args.in[2]; bf16_t* ACS = (bf16_t*)(ws + WS_ACS);
          for (int it = X.gw; it < NBS * 512; it += X.NGW) { const int b = it >> 9, n = it & 511; const int page = pt[b * NPAGE + (n >> 3)];
              const f32x4* src = (const f32x4*)(cache + ((size_t)page * PAGE + (n & 7) * 16) * 256) + X.lane;
              const int c = X.lane >> 5, g = (X.lane >> 4) & 1, d = (X.lane & 15) * 4;
              bf16_t* dst = ACS + ((size_t)c * 32768 + (size_t)(b * 2 + g) * 512 + n) * 1024 + d;
#pragma unroll 4
              for (int l = 0; l < 16; ++l) { const f32x4 v = src[l * 64]; u32x2 w; w.x = pk2(v[0], v[1]); w.y = pk2(v[2], v[3]); *(u32x2*)(dst + l * 64) = w; } } }
        if (BOTH(0)) GRID_BAR();
    }

    if (MK_PH_ON(1) && IN(1)) {
        { const float* g1 = args.in[11]; bf16_t* A1 = (bf16_t*)(ws + WS_A1);
          for (int m = X.gw; m < MPAD; m += X.NGW) {
              unsigned long long* o8 = (unsigned long long*)(A1 + (size_t)m * DM) + X.lane;
              if (m >= MTOT) {
#pragma unroll
                  for (int j = 0; j < 4; ++j) o8[64 * j] = 0ull;
                  continue; }
              const float* xr = m < MP ? x_p + (size_t)m * DM : x_s + (size_t)(m - MP) * DM; const int bi = bidx_of_row(m);
              const f32x4* x4 = (const f32x4*)xr + X.lane; f32x4 v[4]; float s = 0.f;
#pragma unroll
              for (int j = 0; j < 4; ++j) { v[j] = x4[64 * j]; s += (v[j][0] * v[j][0] + v[j][1] * v[j][1]) + (v[j][2] * v[j][2] + v[j][3] * v[j][3]); }
#pragma unroll
              for (int off = 1; off < 64; off <<= 1) s += __shfl_xor(s, off);
              const float rt = 1.0f / sqrtf(s * (1.0f / DM) + EPS);
              const f32x4* gg = (const f32x4*)g1 + X.lane; const f32x4* sh = (const f32x4*)modp(modv, bi, 0, 0) + X.lane; const f32x4* sc = (const f32x4*)modp(modv, bi, 0, 1) + X.lane;
#pragma unroll
              for (int j = 0; j < 4; ++j) { const f32x4 a = v[j] * rt * gg[64 * j] * (sc[64 * j] + 1.0f) + sh[64 * j];
                  o8[64 * j] = (unsigned long long)pk2(a[0], a[1]) | ((unsigned long long)pk2(a[2], a[3]) << 32); }
          } }
        for (int o = X.gw; o < INWP + NGU; o += X.NGW) {
            const bool second = o >= INWP; const int n = second ? o - INWP : o;
            const bf16_t* wrow = (const bf16_t*)(ws + (second ? WS_WGU2 : WS_WIN)) + (size_t)n * DM + X.lane * 16;
            const u32x4 w0 = *(const u32x4*)wrow, w1 = *(const u32x4*)(wrow + 8);
            float wf[16];
#pragma unroll
            for (int e = 0; e < 4; ++e) { wf[2 * e] = bflo(w0[e]); wf[2 * e + 1] = bfhi(w0[e]); wf[8 + 2 * e] = bflo(w1[e]); wf[8 + 2 * e + 1] = bfhi(w1[e]); }
            float* dst = (float*)(ws + (second ? WS_SW3 : WS_SW2)); const int ld = second ? NGU : INWP;
            for (int bi = 0; bi < NBIDX; ++bi) { const f32x4* sh = (const f32x4*)(modp(modv, bi, second ? 2 : 1, 0) + X.lane * 16); float s = 0.f;
#pragma unroll
                for (int q = 0; q < 4; ++q) { const f32x4 a = sh[q]; s += (a[0] * wf[4 * q] + a[1] * wf[4 * q + 1]) + (a[2] * wf[4 * q + 2] + a[3] * wf[4 * q + 3]); }
#pragma unroll
                for (int off = 1; off < 64; off <<= 1) s += __shfl_xor(s, off);
                if (X.lane == 0) dst[(size_t)bi * ld + n] = s; }
        }
        __syncthreads();
        for (int c = 0; c < 2; ++c) {
            pg8::Gemm g{(const bf16_t*)(ws + WS_ACS) + (size_t)c * 32768 * 1024, (const bf16_t*)(ws + WS_WC1) + (size_t)c * 256 * 1024, 32768, 256, DM};
            pg8::StaticOrder S; S.init(32768, 256, X.G, (int)((blockIdx.x + (c ? X.G - 128 : 0)) % X.G));
            pg8::EpiStoreBf16 E{(bf16_t*)(ws + WS_PCS) + (size_t)c * 32768 * 256, 256};
            pg8::gemm_phase(X.lds, g, S, E);
        }
        if (BOTH(1)) GRID_BAR();
    }

    if (MK_PH_ON(2) && IN(2)) {
        pg8::Gemm g{(const bf16_t*)(ws + WS_A1), (const bf16_t*)(ws + WS_WGU1), MPAD, NGU, DM}; pg8::StaticOrder S; S.init(MPAD, NGU, X.G, (int)blockIdx.x);
        pg8::EpiGU E{(bf16_t*)(ws + WS_ACT), nullptr, nullptr, 0};
        pg8::gemm_phase(X.lds, g, S, E);
        if (BOTH(2)) GRID_BAR();
    }
    if (MK_PH_ON(3) && IN(3)) {
        pg8::Gemm g{(const bf16_t*)(ws + WS_ACT), (const bf16_t*)(ws + WS_WD1), MPAD, DM, DFF}; pg8::StaticOrder S; S.init(MPAD, DM, X.G, (int)blockIdx.x);
        float* H1 = (float*)(ws + WS_H1);
        pg8::EpiRes E{x_p, x_s, H1, H1 + (size_t)MP * DM, modv, 0, 0.5f, (bf16_t*)(ws + WS_A2), args.in[11] + DM, 1, (float*)(ws + WS_SSQ2)};
        pg8::gemm_phase(X.lds, g, S, E);
        if (BOTH(3)) GRID_BAR();
    }
    if (MK_PH_ON(4) && IN(4)) {
        pg8::Gemm g{(const bf16_t*)(ws + WS_A2), (const bf16_t*)(ws + WS_WIN), MPAD, INWP, DM}; pg8::StaticOrder S; S.init(MPAD, INWP, X.G, (int)blockIdx.x);
        EpiIn E{(const float*)(ws + WS_SSQ2), (const float*)(ws + WS_SW2), out, ws};
        pg8::gemm_phase(X.lds, g, S, E);
        if (BOTH(4)) GRID_BAR();
    }
    if (MK_PH_ON(5) && IN(5)) {
        for (int c = 0; c < 2; ++c) {
            pg8::Gemm g{(const bf16_t*)(ws + WS_ACP) + (size_t)c * 2048 * 1024, (const bf16_t*)(ws + WS_WC1) + (size_t)c * 256 * 1024, 2048, 256, DM};
            pg8::StaticOrder S; S.init(2048, 256, X.G, (int)((blockIdx.x + (c ? X.G - 8 : 0)) % X.G));
            pg8::EpiStoreBf16 E{(bf16_t*)(ws + WS_PCP) + (size_t)c * 2048 * 256, 256};
            pg8::gemm_phase(X.lds, g, S, E);
        }
        __syncthreads();
        { const bf16_t* PROD = (const bf16_t*)(ws + WS_PROD); const bf16_t* CBb = (const bf16_t*)(ws + WS_CB); bf16_t* ACAT = (bf16_t*)(ws + WS_ACAT);
          const float* wcv = args.in[20]; const float* stc = args.in[5]; const int j = X.lane * 8;
          float w0[8], w1[8], w2[8];
#pragma unroll
          for (int e = 0; e < 8; ++e) { w0[e] = wcv[j + e]; w1[e] = wcv[512 + j + e]; w2[e] = wcv[1024 + j + e]; }
          for (int m = X.gw; m < MTOT; m += X.NGW) {
              const bool isp = m < MP; const int t = isp ? (m & (TP - 1)) : ((m - MP) & 3), bs = isp ? 0 : ((m - MP) >> 2);
              float a2[8], a1[8], a0[8], cbv[8];
              { const u32x4 v = *(const u32x4*)(PROD + (size_t)m * 512 + j); const u32x4 c4 = *(const u32x4*)(CBb + (size_t)m * 512 + j);
#pragma unroll
                for (int e = 0; e < 4; ++e) { a0[2 * e] = bflo(v[e]); a0[2 * e + 1] = bfhi(v[e]); cbv[2 * e] = bflo(c4[e]); cbv[2 * e + 1] = bfhi(c4[e]); } }
              if (t >= 1) { const u32x4 v = *(const u32x4*)(PROD + (size_t)(m - 1) * 512 + j);
#pragma unroll
                  for (int e = 0; e < 4; ++e) { a1[2 * e] = bflo(v[e]); a1[2 * e + 1] = bfhi(v[e]); } }
              else {
#pragma unroll
                  for (int e = 0; e < 8; ++e) a1[e] = isp ? 0.f : stc[((size_t)bs * 2 + 1) * 512 + j + e]; }
              if (t >= 2) { const u32x4 v = *(const u32x4*)(PROD + (size_t)(m - 2) * 512 + j);
#pragma unroll
                  for (int e = 0; e < 4; ++e) { a2[2 * e] = bflo(v[e]); a2[2 * e + 1] = bfhi(v[e]); } }
              else {
#pragma unroll
                  for (int e = 0; e < 8; ++e) a2[e] = isp ? 0.f : stc[((size_t)bs * 2 + t) * 512 + j + e]; }
              float y[8];
#pragma unroll
              for (int e = 0; e < 8; ++e) y[e] = cbv[e] * (w0[e] * a2[e] + w1[e] * a1[e] + w2[e] * a0[e]);
              u32x4 w; w.x = pk2(y[0], y[1]); w.y = pk2(y[2], y[3]); w.z = pk2(y[4], y[5]); w.w = pk2(y[6], y[7]);
              *(u32x4*)(ACAT + (size_t)m * DM + 512 + j) = w; } }
        for (int it = X.vcu; it < 2 * 64 * 8; it += X.G) cmp_tail_item<true>(X, it, ws, args.in[18]);
        if (BOTH(5)) GRID_BAR();
    }
    if (MK_PH_ON(6) && IN(6)) {
        for (int it = X.vcu; it < 2 * 8 * 4; it += X.G) cmp_tail_item<false>(X, it, ws, args.in[18]);
        if (BOTH(6)) GRID_BAR();
    }
    if (MK_PH_ON(7) && IN(7)) {
        for (int i = X.vcu; i < 512; i += X.G) { const int ii = i & 255; const int bg = ii >> 5, qt = (i < 256) ? (ii & 31) : 63 - (ii & 31); att::prompt_item(X, bg, qt, ws, args.in[24]); }
        for (int i = X.vcu; i < 256; i += X.G) att::sample_item(X, i, ws, args);
        if (BOTH(7)) GRID_BAR();
    }
    if (MK_PH_ON(8) && IN(8)) {
        pg8::Gemm g{(const bf16_t*)(ws + WS_ACAT), (const bf16_t*)(ws + WS_WM), MPAD, DM, DM}; pg8::StaticOrder S; S.init(MPAD, DM, X.G, (int)blockIdx.x);
        EpiMerge E{8, (const bf16_t*)(ws + WS_RATIO), (const bf16_t*)(ws + WS_GB), (bf16_t*)(ws + WS_MERGED)};
        pg8::gemm_phase(X.lds, g, S, E);
        if (BOTH(8)) GRID_BAR();
    }
    if (MK_PH_ON(9) && IN(9)) {
        pg8::Gemm g{(const bf16_t*)(ws + WS_MERGED), (const bf16_t*)(ws + WS_WO), MPAD, DM, DM}; pg8::StaticOrder S; S.init(MPAD, DM, X.G, (int)blockIdx.x);
        float* H1 = (float*)(ws + WS_H1);
        pg8::EpiRes E{H1, H1 + (size_t)MP * DM, H1, H1 + (size_t)MP * DM, modv, 1, 1.0f, (bf16_t*)(ws + WS_A3), args.in[11] + 2 * DM, 2, (float*)(ws + WS_SSQ3)};
        pg8::gemm_phase(X.lds, g, S, E);
        if (BOTH(9)) GRID_BAR();
    }
    if (MK_PH_ON(10) && IN(10)) {
        pg8::Gemm g{(const bf16_t*)(ws + WS_A3), (const bf16_t*)(ws + WS_WGU2), MPAD, NGU, DM}; pg8::StaticOrder S; S.init(MPAD, NGU, X.G, (int)blockIdx.x);
        pg8::EpiGU E{(bf16_t*)(ws + WS_ACT), (const float*)(ws + WS_SSQ3), (const float*)(ws + WS_SW3), NGU};
        pg8::gemm_phase(X.lds, g, S, E);
        if (BOTH(10)) GRID_BAR();
    }
    if (MK_PH_ON(11) && IN(11)) {
        pg8::Gemm g{(const bf16_t*)(ws + WS_ACT), (const bf16_t*)(ws + WS_WD2), MPAD, DM, DFF}; pg8::StaticOrder S; S.init(MPAD, DM, X.G, (int)blockIdx.x);
        float* H1 = (float*)(ws + WS_H1);
        pg8::EpiRes E{H1, H1 + (size_t)MP * DM, out + O_Y, out + O_Y + (size_t)MP * DM, modv, 2, 0.5f, nullptr, nullptr, 0, nullptr};
        pg8::gemm_phase(X.lds, g, S, E);
        if (BOTH(11)) GRID_BAR();
    }
    if (MK_PH_ON(12) && IN(12)) {
        const f32x4* gf = (const f32x4*)args.in[25] + X.lane;
        for (int m = X.gw; m < MTOT; m += X.NGW) { f32x4* y4 = (f32x4*)(out + O_Y + (size_t)m * DM) + X.lane; f32x4 v[4]; float s = 0.f;
#pragma unroll
            for (int j = 0; j < 4; ++j) { v[j] = y4[64 * j]; s += (v[j][0] * v[j][0] + v[j][1] * v[j][1]) + (v[j][2] * v[j][2] + v[j][3] * v[j][3]); }
#pragma unroll
            for (int off = 1; off < 64; off <<= 1) s += __shfl_xor(s, off);
            const float rt = 1.0f / sqrtf(s * (1.0f / DM) + EPS);
#pragma unroll
            for (int j = 0; j < 4; ++j) y4[64 * j] = v[j] * rt * gf[64 * j]; }
    }
#if MK_PROBE
    if (IN(13)) { f32x4* o4 = (f32x4*)(out + O_KVC_P); const size_t n4 = (O_TOTAL - O_KVC_P) / 4;
        for (size_t i = (size_t)X.gw * 64 + X.lane; i < n4; i += (size_t)X.NGW * 64) o4[i] = o4[i] * 3.0f; }
#endif
#undef IN
#undef BOTH
}

extern "C" void kernel_launch(void* const* d_in, const int* in_sizes, int n_in, void* d_out, int out_size, void* d_ws, size_t ws_size, hipStream_t stream) {
    static int grid = 0;
    if (grid == 0) {
        if (n_in != 26 || out_size != (int)O_TOTAL || ws_size < WS_END) { fprintf(stderr, "kernel_launch: unexpected shapes n_in %d out %d ws %zu\n", n_in, out_size, ws_size); grid = -1; return; }
        int dev = 0, cus = 0;
        if (hipGetDevice(&dev) != hipSuccess || hipDeviceGetAttribute(&cus, hipDeviceAttributeMultiprocessorCount, dev) != hipSuccess) { grid = -1; return; }
        if (hipFuncSetAttribute((const void*)nsa_fwd, hipFuncAttributeMaxDynamicSharedMemorySize, LDS_BYTES) != hipSuccess) { fprintf(stderr, "kernel_launch: hipFuncSetAttribute failed\n"); grid = -1; return; }
        int per_cu = 0;
        if (hipOccupancyMaxActiveBlocksPerMultiprocessor(&per_cu, (const void*)nsa_fwd, NTHR, LDS_BYTES) != hipSuccess || per_cu < 1) fprintf(stderr, "kernel_launch: occupancy query says %d\n", per_cu);
        (void)hipGetLastError();
        grid = cus;
    }
    if (grid < 0) return;
    (void)hipMemsetAsync((char*)d_ws + WS_CTL, 0, CTL_ZERO_BYTES, stream);
    Args a{};
    for (int i = 0; i < 26; ++i) a.in[i] = (const float*)d_in[i];
    a.out = (float*)d_out; a.ws = (unsigned char*)d_ws;
    constexpr int NPH = MK_LAST_PHASE + 1 + (MK_PROBE ? 1 : 0);
#if MK_PER_PHASE
    for (int p = (MK_PROBE ? -1 : 0); p < NPH; ++p) { a.ph_lo = p; a.ph_hi = p + 1; a.li = 0; hipLaunchKernelGGL(nsa_fwd, dim3(grid), dim3(NTHR), LDS_BYTES, stream, a); }
#else
    a.ph_lo = 0; a.ph_hi = NPH; a.li = 0; hipLaunchKernelGGL(nsa_fwd, dim3(grid), dim3(NTHR), LDS_BYTES, stream, a);
#endif
}
```

```cpp
#include <hip/hip_runtime.h>
#include <hip/hip_bf16.h>
#include <cstdio>
#include <cstdint>
#include <cmath>

#ifndef MK_PER_PHASE
#define MK_PER_PHASE 0
#endif
#ifndef MK_PH_MASK
#define MK_PH_MASK 0xffffffffu
#endif
#define MK_PH_ON(k) ((MK_PH_MASK >> (k)) & 1u)
#ifndef MK_PROBE
#define MK_PROBE 0
#endif
#ifndef MK_DUP
#define MK_DUP (-1)
#endif
#define MK_NREP(k) ((k) == MK_DUP ? 2 : 1)
#ifndef MK_LAST_PHASE
#define MK_LAST_PHASE 12
#endif

constexpr int DM = 1024, NBP = 4, TP = 4096, MP = NBP * TP, NBS = 32, TS = 4, MS = NBS * TS, MTOT = MP + MS, MPAD = 16640;
constexpr int HD = 64, NH = 8, HKV = 2, GRP = 4, DFF = 2816, NGU = 2 * DFF, INW = 4888, INWP = 5120, DCONV = 512;
constexpr int PAST = 8192, NPAGE = 64, PAGE = 128, NPHYS = 2560;
constexpr int NBIDX = NBP + NBS;
constexpr int NMOD = 9 * DM;
constexpr float EPS = 1e-6f;
constexpr float LOG2E = 1.4426950408889634f;
constexpr float QSCALE = 0.125f * LOG2E;

constexpr size_t O_Y = 0;
constexpr size_t O_KVC_P = (size_t)MTOT * DM;
constexpr size_t O_KVS_P = O_KVC_P + (size_t)MP * 256;
constexpr size_t O_KVW_P = O_KVS_P + (size_t)MP * 256;
constexpr size_t O_CONV_P = O_KVW_P + (size_t)NBP * 512 * 256;
constexpr size_t O_KVC_S = O_CONV_P + (size_t)NBP * 2 * 512;
constexpr size_t O_KVS_S = O_KVC_S + (size_t)MS * 256;
constexpr size_t O_KVW_S = O_KVS_S + (size_t)MS * 256;
constexpr size_t O_CONV_S = O_KVW_S + (size_t)NBS * 512 * 256;
constexpr size_t O_TOTAL = O_CONV_S + (size_t)NBS * 2 * 512;
static_assert(O_TOTAL == 30117888, "output size");

constexpr size_t MiB = 1u << 20;
constexpr size_t WS_CTL = 0, CTL_ZERO_BYTES = 1 * MiB;
constexpr size_t WS_MOD = 1 * MiB;
constexpr size_t WS_PETERM = 3 * MiB;
constexpr size_t WS_SW2 = 4 * MiB;
constexpr size_t WS_SW3 = 5 * MiB;
constexpr size_t WS_SSQ2 = 6 * MiB, WS_SSQ3 = 8 * MiB;
constexpr size_t WS_GATES = 10 * MiB;
constexpr size_t WS_WGU1 = 16 * MiB;
constexpr size_t WS_WD1 = 28 * MiB;
constexpr size_t WS_WIN = 34 * MiB;
constexpr size_t WS_WM = 46 * MiB;
constexpr size_t WS_WO = 48 * MiB;
constexpr size_t WS_WGU2 = 50 * MiB;
constexpr size_t WS_WD2 = 62 * MiB;
constexpr size_t WS_WC1 = 68 * MiB;
constexpr size_t WS_A1 = 72 * MiB;
constexpr size_t WS_A2 = 106 * MiB;
constexpr size_t WS_A3 = 140 * MiB;
constexpr size_t WS_ACT = 174 * MiB;
constexpr size_t WS_H1 = 266 * MiB;
constexpr size_t WS_Q = 332 * MiB;
constexpr size_t WS_KS = 350 * MiB, WS_VS = 354 * MiB, WS_KW = 358 * MiB, WS_VW = 362 * MiB;
constexpr size_t WS_ACP = 366 * MiB;
constexpr size_t WS_PCP = 376 * MiB;
constexpr size_t WS_KCP = 380 * MiB, WS_VCP = 381 * MiB;
constexpr size_t WS_KVCS = 382 * MiB;
constexpr size_t WS_PROD = 400 * MiB;
constexpr size_t WS_CB = 418 * MiB;
constexpr size_t WS_RATIO = 436 * MiB;
constexpr size_t WS_GB = 470 * MiB;
constexpr size_t WS_ACAT = 504 * MiB;
constexpr size_t WS_MERGED = 538 * MiB;
constexpr size_t WS_PCS = 572 * MiB;
constexpr size_t WS_ACS = 608 * MiB;
constexpr size_t WS_END = 740 * MiB;

constexpr int CW_TMO = 0, CW_CODE = 1, CW_BAR = 4096;

#define GAS __attribute__((address_space(1)))
#define LAS __attribute__((address_space(3)))
typedef unsigned short bf16_t;
typedef short bf16x8 __attribute__((ext_vector_type(8)));
typedef float f32x4 __attribute__((ext_vector_type(4)));
typedef float f32x2 __attribute__((ext_vector_type(2)));
typedef unsigned u32x4 __attribute__((ext_vector_type(4)));
typedef unsigned u32x2 __attribute__((ext_vector_type(2)));
typedef GAS unsigned gu32;

__device__ __forceinline__ unsigned f2bf(float f) { unsigned u = __builtin_bit_cast(unsigned, f); return (u + 0x7fffu + ((u >> 16) & 1u)) >> 16; }
__device__ __forceinline__ unsigned pk2(float lo, float hi) { return f2bf(lo) | (f2bf(hi) << 16); }
__device__ __forceinline__ float bf2f(unsigned short b) { return __builtin_bit_cast(float, (unsigned)b << 16); }
__device__ __forceinline__ float bflo(unsigned w) { return __builtin_bit_cast(float, w << 16); }
__device__ __forceinline__ float bfhi(unsigned w) { return __builtin_bit_cast(float, w & 0xffff0000u); }
__device__ __forceinline__ float fast_exp2(float x) { return __builtin_amdgcn_exp2f(x); }
__device__ __forceinline__ float fast_rcp(float x) { return __builtin_amdgcn_rcpf(x); }
__device__ __forceinline__ float sigmoidf_(float x) { return fast_rcp(1.0f + fast_exp2(-x * LOG2E)); }
__device__ __forceinline__ float siluf_(float x) { return x * sigmoidf_(x); }
__device__ __forceinline__ int bidx_of_row(int row) { int b = row < MP ? (row >> 12) : NBP + ((row - MP) >> 2); return b < NBIDX ? b : NBIDX - 1; }
__device__ __forceinline__ const float* modp(const float* modv, int bidx, int sub, int kind) { return modv + ((size_t)(bidx * 3 + sub) * 3 + kind) * DM; }

namespace pg8 {
constexpr int BM = 256, BK = 64, HALF = 128, HTB = HALF * BK * 2, STAGE_BYTES = 8 * HTB, NXCD = 8, WGM = 8;
__host__ __device__ __forceinline__ int lds_byte(int r, int c) { const int st = (r >> 4) * 2 + (c >> 5), rr = r & 15, cc = c & 31, ob = rr * 64 + cc * 2; return st * 1024 + (ob ^ (((ob >> 9) & 1) << 5)); }
__host__ __device__ __forceinline__ void stage_rc(int b, int& R, int& C) { const int st = b / 1024, sb = b % 1024, swz = sb ^ (((sb >> 9) & 1) << 5); R = (st >> 1) * 16 + swz / 64; C = (st & 1) * 32 + (swz % 64) / 2; }
__host__ __device__ __forceinline__ int perm32(int rho) { const int n = rho >> 4, i = rho & 15; return 8 * (i >> 2) + 4 * n + (i & 3); }
struct Unit { int pm, pn; };
struct Gemm { const bf16_t* A; const bf16_t* Bt; int M, N, K; };
struct StaticOrder {
    int nM, nN, nwg, G, c;
    __host__ __device__ void init(int M, int N, int G_, int c_) { nM = M / BM; nN = N / BM; nwg = nM * nN; G = G_; c = c_; }
    __host__ __device__ bool next(int i, Unit& u) const {
        const long L = (long)i * G + c; if (L >= nwg) return false;
        int wgid = (int)L; { const int q = nwg / NXCD, r = nwg % NXCD, xcd = wgid % NXCD, off = wgid / NXCD; wgid = (xcd < r ? xcd * (q + 1) : r * (q + 1) + (xcd - r) * q) + off; }
        const int nig = WGM * nN, gid = wgid / nig, fm = gid * WGM, gsz = (nM - fm) < WGM ? (nM - fm) : WGM;
        u.pm = fm + ((wgid % nig) % gsz); u.pn = (wgid % nig) / gsz; return true;
    }
    __device__ __forceinline__ void a_ready(const Unit&) const {}
    __device__ __forceinline__ void done(const Unit&) const {}
};
template <class Epi, class Sched>
__device__ __forceinline__ void gemm_phase(LAS unsigned char* lds, const Gemm g, const Sched& S, const Epi& E) {
    const int tid = threadIdx.x, wid = __builtin_amdgcn_readfirstlane(tid >> 6), lane = tid & 63, wr = wid >> 2, wc = wid & 3, fr = lane & 15, fq = lane >> 4;
    const int K = g.K, nt = K / BK;
    unsigned voffA[2], voffB[2];
#pragma unroll
    for (int i = 0; i < 2; ++i) { int R, C; stage_rc(tid * 16 + i * 8192, R, C); const int Rb = Epi::PERM ? ((R & ~31) + perm32(R & 31)) : R;
        voffA[i] = (unsigned)(R * K + C) * 2u; voffB[i] = (unsigned)(Rb * K + C) * 2u; }
    const size_t kstep = (size_t)(BK * 2);
    const size_t hstep = (size_t)HALF * K * 2;
    const size_t tstep = 2 * hstep;
    const unsigned ldsw = (unsigned)wid * 1024u;
    const int aoff = lds_byte(wr * 64 + fr, fq * 8), boff = lds_byte(wc * 32 + fr, fq * 8);
#define PG8_SA(b, h) (((b) * 2 + (h)) * HTB)
#define PG8_SB(b, h) ((4 + (b) * 2 + (h)) * HTB)
#define PG8_STAGE(bufoff, gbase, voff) do { _Pragma("unroll") for (int _i = 0; _i < 2; ++_i) \
        __builtin_amdgcn_global_load_lds((const unsigned*)((const char*)(gbase) + (voff)[_i]), (LAS unsigned*)(lds + (bufoff) + ldsw + _i * 8192), 16, 0, 0); } while (0)
#define PG8_LDA(dst, b, h) do { _Pragma("unroll") for (int m = 0; m < 4; ++m) _Pragma("unroll") for (int k = 0; k < 2; ++k) dst[m][k] = *(const LAS bf16x8*)(lds + PG8_SA(b, h) + aoff + m * 2048 + k * 1024); } while (0)
#define PG8_LDB(dst, b, h) do { _Pragma("unroll") for (int n = 0; n < 2; ++n) _Pragma("unroll") for (int k = 0; k < 2; ++k) dst[n][k] = *(const LAS bf16x8*)(lds + PG8_SB(b, h) + boff + n * 2048 + k * 1024); } while (0)
#define PG8_MMA(ai, bj, At, Bt) do { __builtin_amdgcn_s_setprio(1); _Pragma("unroll") for (int m = 0; m < 4; ++m) _Pragma("unroll") for (int n = 0; n < 2; ++n) _Pragma("unroll") for (int k = 0; k < 2; ++k) \
        acc[ai][bj][m][n] = __builtin_amdgcn_mfma_f32_16x16x32_bf16(Bt[n][k], At[m][k], acc[ai][bj][m][n], 0, 0, 0); __builtin_amdgcn_s_setprio(0); } while (0)
#define PG8_WAIT_V(n) asm volatile("s_waitcnt vmcnt(" #n ")" ::: "memory")
#define PG8_WAIT_L(n) asm volatile("s_waitcnt lgkmcnt(" #n ")" ::: "memory")
#define PG8_BAR __builtin_amdgcn_s_barrier()
#define PG8_SCHED __builtin_amdgcn_sched_barrier(0)
    Unit cur, nxt; int ui = 0;
    if (!S.next(0, cur)) return;
    f32x4 acc[2][2][4][2];
#pragma unroll
    for (int a = 0; a < 2; ++a)
#pragma unroll
        for (int b = 0; b < 2; ++b)
#pragma unroll
            for (int m = 0; m < 4; ++m)
#pragma unroll
                for (int n = 0; n < 2; ++n) acc[a][b][m][n] = (f32x4){0.f, 0.f, 0.f, 0.f};
    bf16x8 At[4][2], B0[2][2], B1[2][2];
    const char* cA = (const char*)g.A + (size_t)cur.pm * tstep; const char* cB = (const char*)g.Bt + (size_t)cur.pn * tstep;
    S.a_ready(cur);
    PG8_STAGE(PG8_SB(0, 0), cB, voffB); PG8_STAGE(PG8_SB(0, 1), cB + hstep, voffB); PG8_STAGE(PG8_SA(0, 0), cA, voffA); PG8_STAGE(PG8_SA(0, 1), cA + hstep, voffA);
    if (wr == 1) PG8_BAR;
    PG8_WAIT_V(2); PG8_BAR;
    PG8_STAGE(PG8_SB(1, 0), cB + kstep, voffB); PG8_STAGE(PG8_SA(1, 0), cA + kstep, voffA); PG8_STAGE(PG8_SB(1, 1), cB + hstep + kstep, voffB);
    PG8_WAIT_V(6); PG8_BAR;
    for (;;) {
        const bool has_next = S.next(ui + 1, nxt);
        const char* nA = has_next ? (const char*)g.A + (size_t)nxt.pm * tstep : cA; const char* nB = has_next ? (const char*)g.Bt + (size_t)nxt.pn * tstep : cB;
        for (int t = 0; t < nt; t += 2) {
            const bool last = (t == nt - 2);
            const char* a1 = cA + (size_t)(t + 1) * kstep;
            const char* a2 = last ? nA : cA + (size_t)(t + 2) * kstep; const char* b2 = last ? nB : cB + (size_t)(t + 2) * kstep;
            const char* a3 = a2 + kstep; const char* b3 = b2 + kstep;
            if (last && has_next) S.a_ready(nxt);
            if constexpr (Epi::HAS_MID) { if (t == E.mid_t) E.mid(acc, cur, wr, wc, fr, fq); }
            PG8_LDB(B0, 0, 0); PG8_LDB(B1, 0, 1); PG8_SCHED; PG8_LDA(At, 0, 0); PG8_STAGE(PG8_SA(1, 1), a1 + hstep, voffA);
            PG8_WAIT_V(8); PG8_WAIT_L(0); PG8_BAR; PG8_MMA(0, 0, At, B0); PG8_MMA(0, 1, At, B1); PG8_BAR; PG8_SCHED;
            PG8_LDA(At, 0, 1); PG8_STAGE(PG8_SB(0, 0), b2, voffB); PG8_STAGE(PG8_SB(0, 1), b2 + hstep, voffB); PG8_STAGE(PG8_SA(0, 0), a2, voffA);
            PG8_WAIT_V(8); PG8_WAIT_L(0); PG8_BAR; PG8_MMA(1, 0, At, B0); PG8_MMA(1, 1, At, B1); PG8_BAR; PG8_SCHED;
            PG8_LDB(B0, 1, 0); PG8_LDB(B1, 1, 1); PG8_SCHED; PG8_LDA(At, 1, 0); PG8_STAGE(PG8_SA(0, 1), a2 + hstep, voffA);
            PG8_WAIT_V(8); PG8_WAIT_L(0); PG8_BAR; PG8_MMA(0, 0, At, B0); PG8_MMA(0, 1, At, B1); PG8_BAR; PG8_SCHED;
            PG8_LDA(At, 1, 1); PG8_STAGE(PG8_SB(1, 0), b3, voffB); PG8_STAGE(PG8_SB(1, 1), b3 + hstep, voffB); PG8_STAGE(PG8_SA(1, 0), a3, voffA);
            PG8_WAIT_V(8); PG8_WAIT_L(0); PG8_BAR; PG8_MMA(1, 0, At, B0); PG8_MMA(1, 1, At, B1); PG8_BAR; PG8_SCHED;
        }
        if (wr == 0) PG8_BAR;
        E(acc, cur, wr, wc, fr, fq); S.done(cur);
        if (!has_next) break;
#pragma unroll
        for (int a = 0; a < 2; ++a)
#pragma unroll
            for (int b = 0; b < 2; ++b)
#pragma unroll
                for (int m = 0; m < 4; ++m)
#pragma unroll
                    for (int n = 0; n < 2; ++n) acc[a][b][m][n] = (f32x4){0.f, 0.f, 0.f, 0.f};
        cur = nxt; cA = nA; cB = nB; ++ui;
        if (wr == 1) PG8_BAR;
    }
    PG8_WAIT_V(0);
    PG8_BAR;
#undef PG8_SA
#undef PG8_SB
#undef PG8_STAGE
#undef PG8_LDA
#undef PG8_LDB
#undef PG8_MMA
#undef PG8_WAIT_V
#undef PG8_WAIT_L
#undef PG8_BAR
#undef PG8_SCHED
}
typedef f32x4 Acc[2][2][4][2];

struct EpiGU {
    static constexpr bool PERM = true, HAS_MID = false;
    bf16_t* ACT; const float* ssq; const float* shiftW; int ldsw;
    __device__ __forceinline__ void operator()(const Acc& acc, const Unit& u, int wr, int wc, int fr, int fq) const {
        const int cl = wc * 32 + 8 * fq;
#pragma unroll
        for (int ai = 0; ai < 2; ++ai)
#pragma unroll
            for (int m = 0; m < 4; ++m) {
                const int row = u.pm * BM + ai * HALF + wr * 64 + m * 16 + fr;
                float rt = 1.f; f32x4 sg[2], sv[2]; sg[0] = sg[1] = sv[0] = sv[1] = (f32x4){0.f, 0.f, 0.f, 0.f};
                if (ssq) {
                    const f32x4* sp = (const f32x4*)(ssq + (size_t)row * 16); const f32x4 s0 = sp[0], s1 = sp[1], s2 = sp[2], s3 = sp[3];
                    const float s = ((s0[0] + s0[1]) + (s0[2] + s0[3])) + ((s1[0] + s1[1]) + (s1[2] + s1[3])) + ((s2[0] + s2[1]) + (s2[2] + s2[3])) + ((s3[0] + s3[1]) + (s3[2] + s3[3]));
                    rt = 1.0f / sqrtf(s * (1.0f / DM) + EPS);
                    const float* sw = shiftW + (size_t)bidx_of_row(row) * ldsw + u.pn * BM + cl;
                    sg[0] = *(const f32x4*)(sw); sg[1] = *(const f32x4*)(sw + 4); sv[0] = *(const f32x4*)(sw + HALF); sv[1] = *(const f32x4*)(sw + HALF + 4);
                }
                u32x4 w;
#pragma unroll
                for (int n = 0; n < 2; ++n) {
                    const f32x4 gv = acc[ai][0][m][n] * rt + sg[n], vv = acc[ai][1][m][n] * rt + sv[n];
                    const float a0 = siluf_(gv[0]) * vv[0], a1 = siluf_(gv[1]) * vv[1], a2 = siluf_(gv[2]) * vv[2], a3 = siluf_(gv[3]) * vv[3];
                    w[2 * n] = pk2(a0, a1); w[2 * n + 1] = pk2(a2, a3);
                }
                *(u32x4*)(ACT + (size_t)row * DFF + u.pn * HALF + cl) = w;
            }
    }
};
struct EpiRes {
    static constexpr bool PERM = false, HAS_MID = false;
    const float* res_p; const float* res_s;
    float* out_p; float* out_s;
    const float* modv; int gsub; float gfac;
    bf16_t* Aout; const float* gnorm; int ssub;
    float* ssq;
    __device__ __forceinline__ void operator()(const Acc& acc, const Unit& u, int wr, int wc, int fr, int fq) const {
#pragma unroll
        for (int ai = 0; ai < 2; ++ai)
#pragma unroll
            for (int m = 0; m < 4; ++m) {
                const int row = u.pm * BM + ai * HALF + wr * 64 + m * 16 + fr;
                const bool live = row < MTOT;
                const int bi = bidx_of_row(row);
                const float* rp = row < MP ? res_p + (size_t)row * DM : res_s + (size_t)(live ? row - MP : 0) * DM;
                float* op = row < MP ? out_p + (size_t)row * DM : out_s + (size_t)(live ? row - MP : 0) * DM;
                const float* gp = modp(modv, bi, gsub, 2); const float* scp = modp(modv, bi, ssub, 1);
                float sq = 0.f;
#pragma unroll
                for (int bj = 0; bj < 2; ++bj)
#pragma unroll
                    for (int n = 0; n < 2; ++n) {
                        const int c = u.pn * BM + bj * HALF + wc * 32 + n * 16 + 4 * fq;
                        const f32x4 r4 = *(const f32x4*)(rp + c), g4 = *(const f32x4*)(gp + c);
                        const f32x4 h = r4 + (g4 * gfac) * acc[ai][bj][m][n];
                        if (live) *(f32x4*)(op + c) = h;
                        sq += (h[0] * h[0] + h[1] * h[1]) + (h[2] * h[2] + h[3] * h[3]);
                        if (Aout) { const f32x4 gn = *(const f32x4*)(gnorm + c), sc = *(const f32x4*)(scp + c); const f32x4 a = h * gn * (sc + 1.0f);
                            u32x2 w; w.x = pk2(a[0], a[1]); w.y = pk2(a[2], a[3]); if (live) *(u32x2*)(Aout + (size_t)row * DM + c) = w; }
                    }
                if (ssq) { sq += __shfl_xor(sq, 16); sq += __shfl_xor(sq, 32); if (fq == 0) ssq[(size_t)row * 16 + u.pn * 4 + wc] = sq; }
            }
    }
};
struct EpiStoreBf16 {
    static constexpr bool PERM = true, HAS_MID = false;
    bf16_t* O; int ldc;
    __device__ __forceinline__ void operator()(const Acc& acc, const Unit& u, int wr, int wc, int fr, int fq) const {
#pragma unroll
        for (int ai = 0; ai < 2; ++ai)
#pragma unroll
            for (int m = 0; m < 4; ++m) { const int row = u.pm * BM + ai * HALF + wr * 64 + m * 16 + fr;
#pragma unroll
                for (int bj = 0; bj < 2; ++bj) { const f32x4 v0 = acc[ai][bj][m][0], v1 = acc[ai][bj][m][1]; u32x4 w; w.x = pk2(v0[0], v0[1]); w.y = pk2(v0[2], v0[3]); w.z = pk2(v1[0], v1[1]); w.w = pk2(v1[2], v1[3]);
                    *(u32x4*)(O + (size_t)row * ldc + u.pn * BM + bj * HALF + wc * 32 + 8 * fq) = w; } }
    }
};
}

#define XB_TMO      128
#define XB_XCNT(j)  (256  + 64 * (j))
#define XB_XSUB(j)  (1280 + 64 * (j))
#define XB_XGEN(j)  (2304 + 64 * (j))
#define XB_TOP      3328
#define XB_TOPGEN   3392
#define XCD_BAR_WORDS 3456
#define XB_SPIN_CAP (1u << 18)
__device__ __forceinline__ unsigned xb_ld(unsigned* p)              { return __hip_atomic_load(p, __ATOMIC_RELAXED, __HIP_MEMORY_SCOPE_AGENT); }
__device__ __forceinline__ unsigned xb_add(unsigned* p, unsigned v) { return __hip_atomic_fetch_add(p, v, __ATOMIC_RELAXED, __HIP_MEMORY_SCOPE_AGENT); }
__device__ __forceinline__ unsigned xb_xcc_id() { return (unsigned)__builtin_amdgcn_s_getreg((3 << 11) | 20) & 0xFu; }
#define XB_SPIN(cond, bar) do { unsigned _sp = 0; while (cond) { __builtin_amdgcn_s_sleep(1); \
    if ((++_sp & 255u) == 0u) { if (xb_ld(&(bar)[XB_TMO])) break; if (_sp > XB_SPIN_CAP) { atomicAdd(&(bar)[XB_TMO], 1u); break; } } } } while (0)
struct XcdBarrier { unsigned* bar; unsigned x; volatile LAS unsigned* st; };
__device__ __forceinline__ XcdBarrier xcd_barrier_post(unsigned* bar, volatile LAS unsigned* st) {
    XcdBarrier b; b.bar = bar; b.x = xb_xcc_id(); b.st = st;
    if (threadIdx.x == 0) (void)xb_add(&bar[XB_XCNT(b.x)], 1u);
    return b;
}
__device__ __forceinline__ void xcd_barrier_complete(unsigned* bar, unsigned x, unsigned& nloc, unsigned& nx) {
    const unsigned G = gridDim.x * gridDim.y * gridDim.z;
    unsigned sum, cnt, mine, sp = 0u;
    for (;;) {
        sum = 0u; cnt = 0u; mine = 0u;
#pragma unroll
        for (unsigned j = 0; j < 16; ++j) { const unsigned c = xb_ld(&bar[XB_XCNT(j)]); sum += c; cnt += (c > 0u) ? 1u : 0u; mine = (j == x) ? c : mine; }
        if (sum == G) break;
        __builtin_amdgcn_s_sleep(1);
        if ((++sp & 255u) == 0u) { if (xb_ld(&bar[XB_TMO])) break; if (sp > XB_SPIN_CAP) { atomicAdd(&bar[XB_TMO], 1u); break; } }
    }
    nloc = mine > 0u ? mine : 1u; nx = cnt > 0u ? cnt : 1u;
}
__device__ __forceinline__ void xcd_barrier(const XcdBarrier& b) {
    asm volatile("s_waitcnt vmcnt(0)" ::: "memory");
    __syncthreads();
    if (threadIdx.x == 0) {
        unsigned* bar = b.bar;
        __builtin_amdgcn_s_waitcnt(0);
        unsigned nloc = b.st[0], nx = b.st[1];
        if (nloc == 0u) { xcd_barrier_complete(bar, b.x, nloc, nx); b.st[0] = nloc; b.st[1] = nx; }
        const unsigned old = xb_add(&bar[XB_XSUB(b.x)], 1u);
        const unsigned gen = old / nloc;
        if (old + 1u == (gen + 1u) * nloc) {
            __builtin_amdgcn_fence(__ATOMIC_RELEASE, "agent");
            asm volatile("s_waitcnt vmcnt(0)" ::: "memory");
            const unsigned og = xb_add(&bar[XB_TOP], 1u);
            const unsigned tg = og / nx;
            if (og + 1u == (tg + 1u) * nx) xb_add(&bar[XB_TOPGEN], 1u);
            else XB_SPIN(xb_ld(&bar[XB_TOPGEN]) == tg, bar);
            __builtin_amdgcn_fence(__ATOMIC_ACQUIRE, "agent");
            xb_add(&bar[XB_XGEN(b.x)], 1u);
            asm volatile("s_waitcnt vmcnt(0)" ::: "memory");
        } else {
            XB_SPIN(xb_ld(&bar[XB_XGEN(b.x)]) == gen, bar);
            __builtin_amdgcn_fence(__ATOMIC_ACQUIRE, "agent");
            asm volatile("s_waitcnt vmcnt(0)" ::: "memory");
        }
    }
    __syncthreads();
}

constexpr int NWAVES = 8, NTHR = 512;
constexpr int RING_BYTES = 131072, LDSCTL_OFF = RING_BYTES, MISC_OFF = LDSCTL_OFF + 320, LDS_BYTES = 147456;
#define LDS_WAIT() asm volatile("s_waitcnt lgkmcnt(0)" ::: "memory")

struct Args {
    const float* in[26]; float* out; unsigned char* ws; int ph_lo, ph_hi, li, pad;
};
struct Ctx {
    LAS unsigned char* lds; int tid, lane, wave, vcu, G, gw, NGW;
};

__device__ __forceinline__ void ada_item(const Ctx& X, int it, const float* cp, const float* cs, const float* w_ada, const float* b_ada, float* modv) {
    const int j0 = it * 64, w = X.wave, lane = X.lane, kr = lane >> 4, c4 = lane & 15;
    LAS float* sl = (LAS float*)X.lds + w * (18 * 128);
    LAS float* part = (LAS float*)(X.lds + 73728);
    for (int rh = 0; rh < 2; ++rh) {
        for (int idx = lane; idx < 18 * 128; idx += 64) { const int r = rh * 18 + idx / 128, kk = idx % 128, k = w * 128 + kk;
            const float cv = r < NBP ? cp[r * DM + k] : cs[(r - NBP) * DM + k]; sl[idx] = cv / (1.0f + __expf(-cv)); }
        LDS_WAIT(); __syncthreads();
        f32x4 acc[18];
#pragma unroll
        for (int r = 0; r < 18; ++r) acc[r] = (f32x4){0.f, 0.f, 0.f, 0.f};
        const float* wp = w_ada + (size_t)(w * 128 + kr) * NMOD + j0 + 4 * c4;
#pragma unroll 8
        for (int i = 0; i < 32; ++i) { const f32x4 wv = *(const f32x4*)(wp + (size_t)(4 * i) * NMOD);
#pragma unroll
            for (int r = 0; r < 18; ++r) acc[r] += wv * sl[r * 128 + 4 * i + kr]; }
#pragma unroll
        for (int r = 0; r < 18; ++r) {
#pragma unroll
            for (int e = 0; e < 4; ++e) { float v = acc[r][e]; v += __shfl_xor(v, 16); v += __shfl_xor(v, 32); acc[r][e] = v; }
            if (kr == 0) *(LAS f32x4*)(part + (w * 18 + r) * 64 + 4 * c4) = acc[r]; }
        LDS_WAIT(); __syncthreads();
        for (int o = X.tid; o < 18 * 64; o += NTHR) { const int r = o / 64, j = o % 64; float sum = b_ada[j0 + j];
#pragma unroll
            for (int ww = 0; ww < 8; ++ww) sum += part[(ww * 18 + r) * 64 + j];
            modv[(size_t)(rh * 18 + r) * NMOD + j0 + j] = sum; }
        __syncthreads();
    }
}
struct TJ { int src, srcoff_stride, N, K, col0, col_stride, ncols, dst, dpitch, drow0, drow_stride, dcol0, rep; };
__constant__ TJ kJobs[] = {
    {12, 0, NGU, DM, 0,    128, 128, 0, DM, 0,   256, 0, 22},
    {12, 0, NGU, DM, DFF,  128, 128, 0, DM, 128, 256, 0, 22},
    {13, 0, DM, DFF, 0, 0, DM, 1, DFF, 0, 0, 0, 1},
    {16, 0, INW, DM, 0,    0, 1280, 2, DM, 0, 0, 0, 1},
    {16, 0, INW, DM, 1304, 128, 128, 2, DM, 1280, 256, 0, 4},
    {16, 0, INW, DM, 2328, 128, 128, 2, DM, 1408, 256, 0, 4},
    {16, 0, INW, DM, 1816, 0, 512, 2, DM, 2304, 0, 0, 1},
    {16, 0, INW, DM, 2840, 128, 128, 2, DM, 2816, 256, 0, 8},
    {16, 0, INW, DM, 3864, 128, 128, 2, DM, 2944, 256, 0, 8},
    {16, 0, INW, DM, 1280, 0, 24, 2, DM, 4864, 0, 0, 1},
    {21, 0, DM, 512, 0, 0, DM, 3, DM, 0, 0, 0, 1},
    {22, 0, DM, 512, 0, 0, DM, 3, DM, 0, 0, 512, 1},
    {23, 0, DM, DM, 0, 0, DM, 4, DM, 0, 0, 0, 1},
    {14, 0, NGU, DM, 0,    128, 128, 5, DM, 0,   256, 0, 22},
    {14, 0, NGU, DM, DFF,  128, 128, 5, DM, 128, 256, 0, 22},
    {15, 0, DM, DFF, 0, 0, DM, 6, DFF, 0, 0, 0, 1},
    {17, 1024 * 128, 128, DM, 0, 0, 128, 7, DM, 0, 128, 0, 4},
};
constexpr int NJOBS = sizeof(kJobs) / sizeof(TJ);
__device__ __forceinline__ int tj_items(const TJ& j) { return j.rep * (j.K / 64) * ((j.ncols + 63) / 64); }
__device__ __forceinline__ void transpose_item(const float* W, int N, int ncols, bf16_t* WT, int dpitch, LAS float* scr, int kb, int nb, int lane) {
    const int k0 = 64 * kb, n0 = 64 * nb, kr = lane >> 4, c4 = lane & 15; const bool okc = (n0 + 4 * c4) < ncols;
    f32x4 v[16];
#pragma unroll
    for (int i = 0; i < 16; ++i) v[i] = okc ? *(const f32x4*)(W + (size_t)(k0 + 4 * i + kr) * N + n0 + 4 * c4) : (f32x4){0.f, 0.f, 0.f, 0.f};
#pragma unroll
    for (int i = 0; i < 16; ++i) { const int k = 4 * i + kr; *(LAS f32x4*)(scr + k * 64 + ((4 * c4 + 4 * (k >> 3)) & 63)) = v[i]; }
    LDS_WAIT(); asm volatile("" ::: "memory");
    const int c = lane & 7, nl = lane >> 3;
#pragma unroll
    for (int j = 0; j < 8; ++j) { const int n = nl + 8 * j; const LAS float* sp = scr + (8 * c) * 64 + ((n + 4 * c) & 63);
        u32x4 o; o.x = pk2(sp[0 * 64], sp[1 * 64]); o.y = pk2(sp[2 * 64], sp[3 * 64]); o.z = pk2(sp[4 * 64], sp[5 * 64]); o.w = pk2(sp[6 * 64], sp[7 * 64]);
        if (n0 + n < ncols) *(u32x4*)(WT + (size_t)(n0 + n) * dpitch + k0 + 8 * c) = o; }
    LDS_WAIT(); asm volatile("" ::: "memory");
}
__device__ __forceinline__ bf16_t* wdst(unsigned char* ws, int id) {
    const size_t off = id == 0 ? WS_WGU1 : id == 1 ? WS_WD1 : id == 2 ? WS_WIN : id == 3 ? WS_WM : id == 4 ? WS_WO : id == 5 ? WS_WGU2 : id == 6 ? WS_WD2 : WS_WC1;
    return (bf16_t*)(ws + off);
}

struct EpiIn {
    static constexpr bool PERM = false, HAS_MID = false;
    const float* ssq; const float* shiftW; float* out; unsigned char* ws;
    template <int CASE> __device__ __forceinline__ void body(const pg8::Acc& acc, const pg8::Unit& u, int wr, int wc, int fr, int fq) const {
        using namespace pg8;
        const int pn = u.pn, cw = wc * 32 + 4 * fq;
#pragma unroll
        for (int ai = 0; ai < 2; ++ai)
#pragma unroll
            for (int m = 0; m < 4; ++m) {
                const int row = u.pm * BM + ai * HALF + wr * 64 + m * 16 + fr;
                const bool live = row < MTOT, isp = row < MP;
                const f32x4* sp = (const f32x4*)(ssq + (size_t)row * 16); const f32x4 s0 = sp[0], s1 = sp[1], s2 = sp[2], s3 = sp[3];
                const float ssum = ((s0[0] + s0[1]) + (s0[2] + s0[3])) + ((s1[0] + s1[1]) + (s1[2] + s1[3])) + ((s2[0] + s2[1]) + (s2[2] + s2[3])) + ((s3[0] + s3[1]) + (s3[2] + s3[3]));
                const float rt = 1.0f / sqrtf(ssum * (1.0f / DM) + EPS);
                const float* sw = shiftW + (size_t)bidx_of_row(row) * INWP + pn * BM + cw;
                const int b = isp ? (row >> 12) : ((row - MP) >> 2), t = isp ? (row & (TP - 1)) : ((row - MP) & 3);
#define PV(bj, n) (acc[ai][bj][m][n] * rt + *(const f32x4*)(sw + (bj) * HALF + (n) * 16))
                if constexpr (CASE == 0) {
                    bf16_t* Q = (bf16_t*)(ws + WS_Q) + (size_t)row * 512 + pn * BM + cw;
#pragma unroll
                    for (int bj = 0; bj < 2; ++bj)
#pragma unroll
                        for (int n = 0; n < 2; ++n) { const f32x4 v = PV(bj, n) * QSCALE; u32x2 w; w.x = pk2(v[0], v[1]); w.y = pk2(v[2], v[3]); *(u32x2*)(Q + bj * HALF + n * 16) = w; }
                } else if constexpr (CASE >= 1 && CASE <= 3) {
                    const size_t obase = CASE == 1 ? (isp ? O_KVC_P + (size_t)row * 256 : O_KVC_S + (size_t)(row - MP) * 256)
                                       : CASE == 2 ? (isp ? O_KVS_P + (size_t)row * 256 : O_KVS_S + (size_t)(row - MP) * 256)
                                       : (isp ? O_KVW_P + ((size_t)b * 512 + (t - (TP - 512))) * 256 : O_KVW_S + ((size_t)b * 512 + 508 + t) * 256);
                    const bool wout = live && (CASE != 3 || !isp || t >= TP - 512);
#pragma unroll
                    for (int bj = 0; bj < 2; ++bj)
#pragma unroll
                        for (int n = 0; n < 2; ++n) { const int j = bj * HALF + cw + n * 16; const f32x4 v = PV(bj, n);
                            if (wout) *(f32x4*)(out + obase + j) = v;
                            if (isp) { const int gg = (j >> 6) & 1, d = j & 63; u32x2 w; w.x = pk2(v[0], v[1]); w.y = pk2(v[2], v[3]);
                                if constexpr (CASE == 1) *(u32x2*)((bf16_t*)(ws + WS_ACP) + ((size_t)(bj * 8 + b * 2 + gg) * 256 + (t >> 4)) * 1024 + (t & 15) * 64 + d) = w;
                                else *(u32x2*)((bf16_t*)(ws + (CASE == 2 ? (bj ? WS_VS : WS_KS) : (bj ? WS_VW : WS_KW))) + ((size_t)(b * 2 + gg) * TP + t) * 64 + d) = w; } }
                } else if constexpr (CASE == 4) {
                    const bool wout = live && (isp ? t >= TP - 2 : t >= 2);
                    const size_t obase = isp ? O_CONV_P + ((size_t)b * 2 + (t - (TP - 2))) * 512 : O_CONV_S + ((size_t)b * 2 + (t - 2)) * 512;
#pragma unroll
                    for (int n = 0; n < 2; ++n) { const int j = (pn - 5) * HALF + cw + n * 16; const f32x4 v = PV(0, n) * PV(1, n);
                        u32x2 w; w.x = pk2(v[0], v[1]); w.y = pk2(v[2], v[3]); *(u32x2*)((bf16_t*)(ws + WS_PROD) + (size_t)row * 512 + j) = w;
                        if (wout) *(f32x4*)(out + obase + j) = v; }
                } else if constexpr (CASE == 5) {
#pragma unroll
                    for (int bj = 0; bj < 2; ++bj)
#pragma unroll
                        for (int n = 0; n < 2; ++n) { const int j = (pn - 9) * BM + bj * HALF + cw + n * 16; const f32x4 v = PV(bj, n);
                            u32x2 w; w.x = pk2(v[0], v[1]); w.y = pk2(v[2], v[3]); *(u32x2*)((bf16_t*)(ws + WS_CB) + (size_t)row * 512 + j) = w; }
                } else if constexpr (CASE == 6) {
#pragma unroll
                    for (int n = 0; n < 2; ++n) { const int j = (pn - 11) * HALF + cw + n * 16; const f32x4 a = PV(0, n), bb = PV(1, n);
                        float ra[4], gb[4];
#pragma unroll
                        for (int e = 0; e < 4; ++e) { const float sa = sigmoidf_(a[e]), sb = sigmoidf_(bb[e]); gb[e] = sb; ra[e] = sa / sb; }
                        u32x2 w; w.x = pk2(ra[0], ra[1]); w.y = pk2(ra[2], ra[3]); *(u32x2*)((bf16_t*)(ws + WS_RATIO) + (size_t)row * DM + j) = w;
                        u32x2 w2; w2.x = pk2(gb[0], gb[1]); w2.y = pk2(gb[2], gb[3]); *(u32x2*)((bf16_t*)(ws + WS_GB) + (size_t)row * DM + j) = w2; }
                } else {
                    if (wc == 0) {
#pragma unroll
                        for (int n = 0; n < 2; ++n) { const int j = n * 16 + 4 * fq; const f32x4 v = PV(0, n);
#pragma unroll
                            for (int e = 0; e < 4; ++e) if (j + e < 24) ((float*)(ws + WS_GATES))[(size_t)row * 24 + j + e] = sigmoidf_(v[e]); } }
                }
#undef PV
                asm volatile("" ::: "memory");
            }
    }
    __device__ __forceinline__ void operator()(const pg8::Acc& acc, const pg8::Unit& u, int wr, int wc, int fr, int fq) const {
        const int pn = u.pn;
        if (pn < 2) body<0>(acc, u, wr, wc, fr, fq);
        else if (pn == 2) body<1>(acc, u, wr, wc, fr, fq);
        else if (pn == 3) body<2>(acc, u, wr, wc, fr, fq);
        else if (pn == 4) body<3>(acc, u, wr, wc, fr, fq);
        else if (pn < 9) body<4>(acc, u, wr, wc, fr, fq);
        else if (pn < 11) body<5>(acc, u, wr, wc, fr, fq);
        else if (pn < 19) body<6>(acc, u, wr, wc, fr, fq);
        else body<7>(acc, u, wr, wc, fr, fq);
    }
};

struct EpiMerge {
    static constexpr bool PERM = true, HAS_MID = true;
    int mid_t; const bf16_t* RAT; const bf16_t* GB; bf16_t* MERGED;
    __device__ __forceinline__ void mid(pg8::Acc& acc, const pg8::Unit& u, int wr, int wc, int fr, int fq) const {
        using namespace pg8;
        asm volatile("" : "+v"(fr), "+v"(fq));
#pragma unroll
        for (int ai = 0; ai < 2; ++ai)
#pragma unroll
            for (int m = 0; m < 4; ++m) { const int row = u.pm * BM + ai * HALF + wr * 64 + m * 16 + fr;
#pragma unroll
                for (int bj = 0; bj < 2; ++bj) { const u32x4 r = *(const u32x4*)(RAT + (size_t)row * DM + u.pn * BM + bj * HALF + wc * 32 + 8 * fq);
                    acc[ai][bj][m][0] *= (f32x4){bflo(r.x), bfhi(r.x), bflo(r.y), bfhi(r.y)}; acc[ai][bj][m][1] *= (f32x4){bflo(r.z), bfhi(r.z), bflo(r.w), bfhi(r.w)}; }
                asm volatile("" ::: "memory"); }
    }
    __device__ __forceinline__ void operator()(const pg8::Acc& acc, const pg8::Unit& u, int wr, int wc, int fr, int fq) const {
        using namespace pg8;
#pragma unroll
        for (int ai = 0; ai < 2; ++ai)
#pragma unroll
            for (int m = 0; m < 4; ++m) { const int row = u.pm * BM + ai * HALF + wr * 64 + m * 16 + fr;
#pragma unroll
                for (int bj = 0; bj < 2; ++bj) { const size_t off = (size_t)row * DM + u.pn * BM + bj * HALF + wc * 32 + 8 * fq; const u32x4 r = *(const u32x4*)(GB + off);
                    const f32x4 v0 = acc[ai][bj][m][0] * (f32x4){bflo(r.x), bfhi(r.x), bflo(r.y), bfhi(r.y)}, v1 = acc[ai][bj][m][1] * (f32x4){bflo(r.z), bfhi(r.z), bflo(r.w), bfhi(r.w)};
                    u32x4 w; w.x = pk2(v0[0], v0[1]); w.y = pk2(v0[2], v0[3]); w.z = pk2(v1[0], v1[1]); w.w = pk2(v1[2], v1[3]); *(u32x4*)(MERGED + off) = w; }
                asm volatile("" ::: "memory"); }
    }
};

__device__ __forceinline__ float gelu_tanh(float x) { const float u = 0.7978845608028654f * (x + 0.044715f * x * x * x); const float e = fast_exp2(2.0f * LOG2E * u); return 0.5f * x * (2.0f - 2.0f * fast_rcp(1.0f + e)); }
template <bool SAMPLE> __device__ __forceinline__ void cmp_tail_item(const Ctx& X, int item, unsigned char* ws, const float* w_cmp2) {
    constexpr int NR = SAMPLE ? 512 : 256, NCH = NR / 64, NBG = SAMPLE ? 64 : 8, NVALID = NR - 1;
    const int c = item / (NBG * NCH), bg = (item / NCH) % NBG, n0 = (item % NCH) * 64;
    LAS float* w2s = (LAS float*)X.lds; LAS float* hid = (LAS float*)(X.lds + 32768);
    const float* w2 = w_cmp2 + (size_t)c * 128 * 64; const float* pet = (const float*)(ws + WS_PETERM) + c * 128;
    const bf16_t* P = (const bf16_t*)(ws + (SAMPLE ? WS_PCS : WS_PCP)) + (size_t)c * (NBG * NR) * 256;
    for (int i = X.tid; i < 128 * 64 / 4; i += NTHR) ((LAS f32x4*)w2s)[i] = ((const f32x4*)w2)[i];
    for (int idx = X.tid; idx < 64 * 128; idx += NTHR) { const int r = idx >> 7, e = idx & 127; const size_t base = (size_t)(bg * NR + n0 + r) * 256;
        const float v = bf2f(P[base + e]) + bf2f(P[base + 256 + 128 + e]) + pet[e]; hid[r * 129 + e] = gelu_tanh(v); }
    LDS_WAIT(); __syncthreads();
    const int r = X.tid >> 3, d0 = (X.tid & 7) * 8, n = n0 + r;
    float acc[8];
#pragma unroll
    for (int i = 0; i < 8; ++i) acc[i] = 0.f;
#pragma unroll 4
    for (int e = 0; e < 128; ++e) { const float h = hid[r * 129 + e]; const f32x4 wa = *(const LAS f32x4*)(w2s + e * 64 + d0), wb = *(const LAS f32x4*)(w2s + e * 64 + d0 + 4);
        acc[0] += h * wa[0]; acc[1] += h * wa[1]; acc[2] += h * wa[2]; acc[3] += h * wa[3]; acc[4] += h * wb[0]; acc[5] += h * wb[1]; acc[6] += h * wb[2]; acc[7] += h * wb[3]; }
    if constexpr (SAMPLE) {
        if (n < NVALID) { float* o = (float*)(ws + WS_KVCS) + (((size_t)bg * 512 + n) * 2 + c) * 64 + d0; *(f32x4*)o = (f32x4){acc[0], acc[1], acc[2], acc[3]}; *(f32x4*)(o + 4) = (f32x4){acc[4], acc[5], acc[6], acc[7]}; }
    } else {
        u32x4 w; if (n < NVALID) { w.x = pk2(acc[0], acc[1]); w.y = pk2(acc[2], acc[3]); w.z = pk2(acc[4], acc[5]); w.w = pk2(acc[6], acc[7]); } else w = (u32x4){0u, 0u, 0u, 0u};
        *(u32x4*)((bf16_t*)(ws + (c ? WS_VCP : WS_KCP)) + ((size_t)bg * 256 + n) * 64 + d0) = w;
    }
    __syncthreads();
}

namespace att {
typedef float f32x16 __attribute__((ext_vector_type(16)));
typedef short s16x4 __attribute__((ext_vector_type(4)));
typedef float f32x2_t __attribute__((ext_vector_type(2))); typedef __bf16 bf16x2_t __attribute__((ext_vector_type(2)));
constexpr int L_K = 0, L_V = 16384, L_WSF = 32768, L_BIAS = 36864, L_GATE = 38912, L_SEL = 41984, L_ANY = 42496, L_PSUM = 43008, L_SC = 108800, L_OST = 43008, PS_LD = 257, SC_LD = 65;
static_assert(L_SC + 64 * SC_LD * 4 <= RING_BYTES, "attention LDS map");
__constant__ unsigned char kBucket[128] = {0, 1, 2, 3, 4, 5, 6, 7, 8, 9, 10, 11, 12, 13, 14, 15, 16, 16, 16, 17, 17, 18, 18, 18, 19, 19, 19, 20, 20, 20, 20, 21, 21, 21, 21, 22, 22, 22, 22, 22, 23, 23, 23, 23, 23, 23, 24, 24, 24, 24, 24, 24, 25, 25, 25, 25, 25, 25, 25, 26, 26, 26, 26, 26, 26, 26, 26, 27, 27, 27, 27, 27, 27, 27, 27, 27, 27, 28, 28, 28, 28, 28, 28, 28, 28, 28, 28, 29, 29, 29, 29, 29, 29, 29, 29, 29, 29, 29, 29, 30, 30, 30, 30, 30, 30, 30, 30, 30, 30, 30, 30, 30, 30, 31, 31, 31, 31, 31, 31, 31, 31, 31, 31, 31, 31, 31, 31, 31};
__device__ __forceinline__ int crow(int r, int hi) { return (r & 3) + 8 * (r >> 2) + 4 * hi; }
__device__ __forceinline__ unsigned cvtpk_s(float lo, float hi) { f32x2_t v = {lo, hi}; bf16x2_t b = __builtin_convertvector(v, bf16x2_t); return __builtin_bit_cast(unsigned, b); }
#define ATT_SBAR() __builtin_amdgcn_sched_barrier(0)
__device__ __forceinline__ void qkt(f32x16& p0, f32x16& p1, const LAS unsigned char* Kslot, const bf16x8* qr, int r32, int hi) {
    const LAS unsigned char* kb = Kslot + hi * 1024 + r32 * 16;
    f32x16 z;
#pragma unroll
    for (int r = 0; r < 16; ++r) z[r] = 0.f;
    p0 = z; p1 = z;
#pragma unroll
    for (int d0 = 0; d0 < 4; ++d0) {
        const bf16x8 b0 = *(const LAS bf16x8*)(kb + d0 * 2048), b1 = *(const LAS bf16x8*)(kb + d0 * 2048 + 512);
        p0 = __builtin_amdgcn_mfma_f32_32x32x16_bf16(b0, qr[d0], p0, 0, 0, 0); p1 = __builtin_amdgcn_mfma_f32_32x32x16_bf16(b1, qr[d0], p1, 0, 0, 0); }
}
__device__ __forceinline__ float rowmax(const f32x16& p0, const f32x16& p1) {
    float a = fmaxf(p0[0], p1[0]);
#pragma unroll
    for (int r = 1; r < 16; ++r) a = fmaxf(a, fmaxf(p0[r], p1[r]));
    auto rr = __builtin_amdgcn_permlane32_swap(__float_as_uint(a), __float_as_uint(a), false, false);
    return fmaxf(__uint_as_float(rr[0]), __uint_as_float(rr[1]));
}
__device__ __forceinline__ float halfsum(float a) { auto rr = __builtin_amdgcn_permlane32_swap(__float_as_uint(a), __float_as_uint(a), false, false); return __uint_as_float(rr[0]) + __uint_as_float(rr[1]); }
__device__ __forceinline__ void pv(f32x16* o, int vb, bf16x8 pa0, bf16x8 pa1, bf16x8 pa2, bf16x8 pa3) {
#pragma unroll
    for (int d0 = 0; d0 < 2; ++d0) { s16x4 lo[4], hi[4];
#pragma unroll
        for (int ks = 0; ks < 4; ++ks) {
            asm volatile("ds_read_b64_tr_b16 %0,%1 offset:%c2" : "=&v"(lo[ks]) : "v"(vb), "i"(d0 * 4096 + ks * 1024) : "memory");
            asm volatile("ds_read_b64_tr_b16 %0,%1 offset:%c2" : "=&v"(hi[ks]) : "v"(vb), "i"(d0 * 4096 + ks * 1024 + 512) : "memory"); }
        asm volatile("s_waitcnt lgkmcnt(0)" ::: "memory"); ATT_SBAR();
#define ATT_PK(k) (bf16x8){lo[k][0], lo[k][1], lo[k][2], lo[k][3], hi[k][0], hi[k][1], hi[k][2], hi[k][3]}
        o[d0] = __builtin_amdgcn_mfma_f32_32x32x16_bf16(pa0, ATT_PK(0), o[d0], 0, 0, 0);
        o[d0] = __builtin_amdgcn_mfma_f32_32x32x16_bf16(pa1, ATT_PK(1), o[d0], 0, 0, 0);
        o[d0] = __builtin_amdgcn_mfma_f32_32x32x16_bf16(pa2, ATT_PK(2), o[d0], 0, 0, 0);
        o[d0] = __builtin_amdgcn_mfma_f32_32x32x16_bf16(pa3, ATT_PK(3), o[d0], 0, 0, 0);
#undef ATT_PK
    }
}
struct KVRegs { u32x4 k, v; };
__device__ __forceinline__ void stage_load(KVRegs& R, const bf16_t* Kg, const bf16_t* Vg, int tid) { const int off = (tid >> 3) * 64 + (tid & 7) * 8; R.k = *(const u32x4*)(Kg + off); R.v = *(const u32x4*)(Vg + off); }
__device__ __forceinline__ void stage_store(const KVRegs& R, LAS unsigned char* lds, int slot, int tid) { const int key = tid >> 3, ch = tid & 7;
    *(LAS u32x4*)(lds + L_K + slot * 8192 + ch * 1024 + key * 16) = R.k;
    *(LAS u32x4*)(lds + L_V + slot * 8192 + ((ch >> 2) * 4 + (key >> 4)) * 1024 + (key & 15) * 64 + (ch & 3) * 16) = R.v; }
struct SM { float m, l; f32x16 o[2]; };
__device__ __forceinline__ void sm_init(SM& s) { s.m = -1e30f; s.l = 0.f;
#pragma unroll
    for (int r = 0; r < 16; ++r) { s.o[0][r] = 0.f; s.o[1][r] = 0.f; } }
template <bool WITH_O> __device__ __forceinline__ void sm_update(SM& s, f32x16& p0, f32x16& p1, LAS float* wsf, int r32, int hi) {
    const float rm = rowmax(p0, p1), mnew = fmaxf(s.m, rm);
    if (__any(mnew > s.m)) {
        const float alpha = fast_exp2(s.m - mnew); s.l *= alpha;
        if constexpr (WITH_O) { if (hi == 0) wsf[r32] = alpha; LDS_WAIT();
#pragma unroll
            for (int r = 0; r < 16; ++r) { const float f = wsf[crow(r, hi)]; s.o[0][r] *= f; s.o[1][r] *= f; }
            LDS_WAIT(); }
        s.m = mnew;
    }
    float sum = 0.f;
#pragma unroll
    for (int r = 0; r < 16; ++r) { p0[r] = fast_exp2(p0[r] - s.m); p1[r] = fast_exp2(p1[r] - s.m); sum += p0[r] + p1[r]; }
    s.l += sum;
}
template <int MODE> __device__ __forceinline__ void mask_bias(f32x16& p0, f32x16& p1, int T, bool far, bool lsel, int qpos, int hi, const LAS float* bT, float b31) {
    const float NEG = -INFINITY;
    if (MODE != 0 && far) {
#pragma unroll
        for (int r = 0; r < 16; ++r) { p0[r] = lsel ? p0[r] + b31 : NEG; p1[r] = lsel ? p1[r] + b31 : NEG; }
    } else {
        int base = MODE == 0 ? qpos - 1024 * T - 64 * hi - 31 : qpos - 64 * T - 4 * hi;
        asm volatile("" : "+v"(base));
#pragma unroll
        for (int r = 0; r < 16; ++r) { const int kk = (r & 3) + 8 * (r >> 2); int d0, d1; bool v0, v1;
            if (MODE == 0) { d0 = base - 16 * kk; d1 = d0 - 512; v0 = d0 >= 0; v1 = d1 >= 0; }
            else { d0 = base - kk; d1 = d0 - 32; if (MODE == 1) { v0 = lsel && d0 >= 0; v1 = lsel && d1 >= 0; } else { v0 = d0 >= 0 && d0 < 512; v1 = d1 >= 0 && d1 < 512; } }
            const float b0 = bT[min(max(d0, 0), 127)], b1 = bT[min(max(d1, 0), 127)];
            p0[r] = v0 ? p0[r] + b0 : NEG; p1[r] = v1 ? p1[r] + b1 : NEG; }
    }
}
#define ATT_PACK(pw, P, B) pw = (u32x4){cvtpk_s(P[B], P[B + 1]), cvtpk_s(P[B + 2], P[B + 3]), cvtpk_s(P[B + 4], P[B + 5]), cvtpk_s(P[B + 6], P[B + 7])}
#define ATT_PV(S_, SLOT) do { u32x4 pw0, pw1, pw2, pw3; ATT_PACK(pw0, p0, 0); ATT_PACK(pw1, p0, 8); ATT_PACK(pw2, p1, 0); ATT_PACK(pw3, p1, 8); ATT_SBAR(); \
    pv((S_).o, vb0 + (SLOT) * 8192, __builtin_bit_cast(bf16x8, pw0), __builtin_bit_cast(bf16x8, pw1), __builtin_bit_cast(bf16x8, pw2), __builtin_bit_cast(bf16x8, pw3)); } while (0)
#define ATT_TILE_LOOP(NT, FIRST, NEXTEXPR, KB, VB, BODY) do { int tcur_ = (FIRST); stage_load(R, (KB) + (size_t)tcur_ * 4096, (VB) + (size_t)tcur_ * 4096, tid); stage_store(R, lds, 0, tid); LDS_WAIT(); __syncthreads(); \
    for (int i_ = 0; i_ < (NT); ++i_) { const bool more_ = i_ + 1 < (NT); int tnext_ = tcur_; \
        if (more_) { tnext_ = (NEXTEXPR); stage_load(R, (KB) + (size_t)tnext_ * 4096, (VB) + (size_t)tnext_ * 4096, tid); } \
        { const int T = tcur_; const int SLOT = i_ & 1; BODY } \
        if (more_) stage_store(R, lds, (i_ + 1) & 1, tid); \
        LDS_WAIT(); __syncthreads(); tcur_ = tnext_; } } while (0)
#define ATT_FINISH(S_, BR) do { const float lt_ = halfsum((S_).l); const float inv_ = lt_ > 0.f ? 1.0f / lt_ : 0.f; \
    if (hi == 0) wsf[64 + r32] = inv_ * gt[qloc * 12 + (BR) * 4 + hh]; LDS_WAIT(); \
    _Pragma("unroll") for (int r = 0; r < 16; ++r) { const float f = wsf[64 + crow(r, hi)]; oacc[0][r] += (S_).o[0][r] * f; oacc[1][r] += (S_).o[1][r] * f; } LDS_WAIT(); asm volatile("" : "+v"(oacc[0]), "+v"(oacc[1])); } while (0)

__device__ __forceinline__ void prompt_item(const Ctx& X, int bg, int qt, unsigned char* ws, const float* rel_bias) {
    LAS unsigned char* lds = X.lds; int tid = X.tid; asm volatile("" : "+v"(tid));
    const int lane = tid & 63, wid = __builtin_amdgcn_readfirstlane(tid >> 6), r32 = lane & 31, hi = lane >> 5;
    const int b = bg >> 1, g = bg & 1, hh = wid >> 1, qh = wid & 1, q0 = qt * 64, qloc = qh * 32 + r32, qpos = q0 + qloc;
    LAS float* biasT = (LAS float*)(lds + L_BIAS); LAS float* gt = (LAS float*)(lds + L_GATE); LAS float* psum = (LAS float*)(lds + L_PSUM); LAS float* sc = (LAS float*)(lds + L_SC);
    LAS float* wsf = (LAS float*)(lds + L_WSF) + wid * 128;
    const float* GATES = (const float*)(ws + WS_GATES);
    biasT[tid] = rel_bias[(int)kBucket[tid & 127] * 8 + g * 4 + (tid >> 7)] * LOG2E;
    for (int i = tid; i < 64 * 12; i += NTHR) { const int q = i / 12, e = i % 12; gt[i] = GATES[((size_t)b * TP + q0 + q) * 24 + (e >> 2) * 8 + g * 4 + (e & 3)]; }
    for (int i = tid; i < 64 * PS_LD; i += NTHR) psum[i] = 0.f;
    if (tid < 2) ((LAS unsigned*)(lds + L_ANY))[tid] = 0u;
    bf16x8 qr[4];
    { const bf16_t* Qp = (const bf16_t*)(ws + WS_Q) + ((size_t)b * TP + qpos) * 512 + (g * 4 + hh) * 64 + hi * 8;
#pragma unroll
      for (int d0 = 0; d0 < 4; ++d0) qr[d0] = *(const bf16x8*)(Qp + d0 * 16); }
    LDS_WAIT(); __syncthreads();
    const LAS float* bT = biasT + hh * 128; const float b31 = bT[127];
    const int vb0 = (int)(unsigned)(uintptr_t)(lds + L_V) + ((lane >> 4) & 1) * 32 + (lane & 3) * 8 + (4 * hi + ((lane & 15) >> 2)) * 64;
    f32x16 oacc[2];
#pragma unroll
    for (int r = 0; r < 16; ++r) { oacc[0][r] = 0.f; oacc[1][r] = 0.f; }
    KVRegs R; f32x16 p0, p1;
    { const bf16_t* KC = (const bf16_t*)(ws + WS_KCP) + (size_t)bg * 256 * 64; const bf16_t* VC = (const bf16_t*)(ws + WS_VCP) + (size_t)bg * 256 * 64;
      const int ncv = min(4 * qt + 3, 255), ntc = (ncv + 63) >> 6;
      SM s; sm_init(s);
      ATT_TILE_LOOP(ntc, 0, tcur_ + 1, KC, VC, {
          qkt(p0, p1, lds + L_K + SLOT * 8192, qr, r32, hi); mask_bias<0>(p0, p1, T, false, true, qpos, hi, bT, b31); sm_update<false>(s, p0, p1, wsf, r32, hi); });
      const float ltot = halfsum(s.l), invl = ltot > 0.f ? 1.0f / ltot : 0.f; s.l = 0.f;
      ATT_TILE_LOOP(ntc, 0, tcur_ + 1, KC, VC, {
          qkt(p0, p1, lds + L_K + SLOT * 8192, qr, r32, hi); mask_bias<0>(p0, p1, T, false, true, qpos, hi, bT, b31);
          float sum = 0.f;
          _Pragma("unroll") for (int r = 0; r < 16; ++r) { p0[r] = fast_exp2(p0[r] - s.m); p1[r] = fast_exp2(p1[r] - s.m); sum += p0[r] + p1[r]; }
          s.l += sum;
          for (int rr = 0; rr < 4; ++rr) { if (hh == rr) { LAS float* pr = psum + qloc * PS_LD + 64 * T;
              _Pragma("unroll") for (int r = 0; r < 16; ++r) { pr[crow(r, hi)] += p0[r] * invl; pr[32 + crow(r, hi)] += p1[r] * invl; } }
              LDS_WAIT(); __syncthreads(); }
          ATT_PV(s, SLOT); });
      ATT_FINISH(s, 0);
    }
    { const int q = tid >> 3, jg = tid & 7; float myv[8];
#pragma unroll
      for (int i = 0; i < 8; ++i) { const int j = jg * 8 + i; const LAS float* pr = psum + q * PS_LD + 4 * j;
          const float v = 2.0f * (pr[0] + pr[1] + pr[2]) + pr[3] + (j > 0 ? pr[-1] : 0.f);
          const bool valid = j <= qt, forced = (j == 0) || (j == qt) || (j == qt - 1);
          const float sv = valid ? v + (forced ? 1000.0f : 0.f) : -1e9f; myv[i] = sv; sc[q * SC_LD + j] = sv; }
      LDS_WAIT(); __syncthreads();
      int cnt[8];
#pragma unroll
      for (int i = 0; i < 8; ++i) cnt[i] = 0;
      for (int k = 0; k < 64; ++k) { const float v = sc[q * SC_LD + k];
#pragma unroll
          for (int i = 0; i < 8; ++i) cnt[i] += ((v > myv[i]) || (v == myv[i] && k < jg * 8 + i)) ? 1 : 0; }
      unsigned bits = 0u;
#pragma unroll
      for (int i = 0; i < 8; ++i) if (cnt[i] < 16 && jg * 8 + i <= qt) bits |= 1u << i;
      ((LAS unsigned char*)(lds + L_SEL))[q * 8 + jg] = (unsigned char)bits;
      atomicOr((unsigned*)((LAS unsigned*)(lds + L_ANY) + (jg >> 2)), bits << (8 * (jg & 3)));
      LDS_WAIT(); __syncthreads(); }
    { const unsigned lo_ = ((LAS unsigned*)(lds + L_SEL))[qloc * 2], hi_ = ((LAS unsigned*)(lds + L_SEL))[qloc * 2 + 1]; const unsigned long long selm = ((unsigned long long)hi_ << 32) | lo_;
      const unsigned long long anym = ((unsigned long long)((LAS unsigned*)(lds + L_ANY))[1] << 32) | ((LAS unsigned*)(lds + L_ANY))[0];
      unsigned long long rem = anym; const int nts = __builtin_popcountll(anym);
      const bf16_t* KS = (const bf16_t*)(ws + WS_KS) + (size_t)bg * TP * 64; const bf16_t* VS = (const bf16_t*)(ws + WS_VS) + (size_t)bg * TP * 64;
      SM s; sm_init(s);
      ATT_TILE_LOOP(nts, __builtin_ctzll(rem), (rem &= rem - 1, __builtin_ctzll(rem)), KS, VS, {
          qkt(p0, p1, lds + L_K + SLOT * 8192, qr, r32, hi); mask_bias<1>(p0, p1, T, T + 3 <= qt, ((selm >> T) & 1ull) != 0ull, qpos, hi, bT, b31);
          sm_update<true>(s, p0, p1, wsf, r32, hi); ATT_PV(s, SLOT); });
      ATT_FINISH(s, 1);
    }
    { const int jw0 = max(0, qt - 8), ntw = qt - jw0 + 1;
      const bf16_t* KW = (const bf16_t*)(ws + WS_KW) + (size_t)bg * TP * 64; const bf16_t* VW = (const bf16_t*)(ws + WS_VW) + (size_t)bg * TP * 64;
      SM s; sm_init(s);
      ATT_TILE_LOOP(ntw, jw0, tcur_ + 1, KW, VW, {
          qkt(p0, p1, lds + L_K + SLOT * 8192, qr, r32, hi); mask_bias<2>(p0, p1, T, (T + 3 <= qt) && (T + 8 > qt), true, qpos, hi, bT, b31);
          sm_update<true>(s, p0, p1, wsf, r32, hi); ATT_PV(s, SLOT); });
      ATT_FINISH(s, 2);
    }
    { LAS bf16_t* stg = (LAS bf16_t*)(lds + L_OST + wid * 4096);
#pragma unroll
      for (int r = 0; r < 16; ++r) { stg[crow(r, hi) * 64 + r32] = (bf16_t)f2bf(oacc[0][r]); stg[crow(r, hi) * 64 + 32 + r32] = (bf16_t)f2bf(oacc[1][r]); }
      LDS_WAIT();
      bf16_t* O = (bf16_t*)(ws + WS_ACAT) + ((size_t)b * TP + q0 + qh * 32) * DM + (g * 4 + hh) * 64;
#pragma unroll
      for (int i = 0; i < 4; ++i) { const int row = i * 8 + (lane >> 3), ch = lane & 7; const u32x4 v = *(const LAS u32x4*)(stg + row * 64 + ch * 8); *(u32x4*)(O + (size_t)row * DM + ch * 8) = v; }
    }
    LDS_WAIT(); __syncthreads();
}

constexpr int S_SC = 0, S_SCLD = 1040, S_PSUM = 16640  , S_SCORE = 18752  , S_SELIDX = 19328  , S_Q = 19456  , S_OH = 20480  , S_STAT = 22528  , S_GATE = 22592  , S_BIAS = 22656  ;
struct SampleCtx { int b, g, s, qpos; const float* cache_sel; const float* state_win; const int* pt; const float* out; const float* kvcs; };
template <int BR> __device__ __forceinline__ void skey(const SampleCtx& C, const LAS int* selidx, int k, const float*& Kp, int& dist, bool& valid) {
    if (BR == 0) { Kp = C.kvcs + (((size_t)(C.b * 2 + C.g) * 512 + k) * 2) * 64; dist = C.qpos - (16 * k + 31); valid = true; }
    else if (BR == 1) { const int j = selidx[k >> 6], r = k & 63;
        if (j < 128) { const int page = C.pt[C.b * NPAGE + (j >> 1)]; Kp = C.cache_sel + ((size_t)page * PAGE + (j & 1) * 64 + r) * 256 + C.g * 64; dist = C.qpos - (64 * j + r); valid = true; }
        else { const int rr = r < TS ? r : 0; Kp = C.out + O_KVS_S + ((size_t)C.b * TS + rr) * 256 + C.g * 64; dist = C.qpos - (PAST + r); valid = r <= C.s; } }
    else { Kp = (k < 512 ? C.state_win + ((size_t)C.b * 512 + k) * 256 : C.out + O_KVW_S + ((size_t)C.b * 512 + 508 + (k - 512)) * 256) + C.g * 64; dist = C.qpos - (PAST - 512 + k); valid = dist >= 0 && dist < 512; }
}
constexpr int S_KP = 24704  , S_META = 33024  , S_RED = 37184  ;
template <int BR> __device__ __forceinline__ void sample_branch(const Ctx& X, int tid, const SampleCtx& C, int nkeys, float& ofinal) {
    LAS unsigned char* lds = X.lds; const int lane = tid & 63, wid = __builtin_amdgcn_readfirstlane(tid >> 6);
    LAS float* scs = (LAS float*)(lds + S_SC); LAS float* qs = (LAS float*)(lds + S_Q); LAS float* stat = (LAS float*)(lds + S_STAT);
    LAS float* gts = (LAS float*)(lds + S_GATE); LAS float* bT = (LAS float*)(lds + S_BIAS); const LAS int* selidx = (const LAS int*)(lds + S_SELIDX);
    typedef const float* cfp; LAS cfp* kp = (LAS cfp*)(lds + S_KP); LAS int* meta = (LAS int*)(lds + S_META); LAS float* red = (LAS float*)(lds + S_RED);
    constexpr int VOFF = BR == 0 ? 64 : 128;
    for (int k = tid; k < nkeys; k += NTHR) { const float* Kp; int dist; bool valid; skey<BR>(C, selidx, k, Kp, dist, valid); kp[k] = Kp; meta[k] = valid ? min(max(dist, 0), 127) : -1; }
    LDS_WAIT(); __syncthreads();
    const int grp = tid >> 4, li = tid & 15, nit = (nkeys + 31) >> 5;
    { f32x4 q4[4];
#pragma unroll
      for (int h = 0; h < 4; ++h) q4[h] = *(const LAS f32x4*)(qs + h * 64 + li * 4);
      for (int i0 = 0; i0 < nit; i0 += 8) { f32x4 kx[8];
#pragma unroll
          for (int u = 0; u < 8; ++u) { const int k = grp + 32 * (i0 + u); kx[u] = k < nkeys ? *(const f32x4*)(kp[k] + li * 4) : (f32x4){0.f, 0.f, 0.f, 0.f}; }
#pragma unroll
          for (int u = 0; u < 8; ++u) { const int k = grp + 32 * (i0 + u); float pt4[4];
#pragma unroll
              for (int h = 0; h < 4; ++h) { float d = (kx[u][0] * q4[h][0] + kx[u][1] * q4[h][1]) + (kx[u][2] * q4[h][2] + kx[u][3] * q4[h][3]);
                  d += __shfl_xor(d, 1); d += __shfl_xor(d, 2); d += __shfl_xor(d, 4); d += __shfl_xor(d, 8); pt4[h] = d; }
              if (li < 4 && k < nkeys) { const float d = li == 0 ? pt4[0] : li == 1 ? pt4[1] : li == 2 ? pt4[2] : pt4[3]; const int mt = meta[k];
                  scs[li * S_SCLD + k] = mt >= 0 ? d + bT[li * 128 + mt] : -INFINITY; } } } }
    LDS_WAIT(); __syncthreads();
    if (wid < 4) { LAS float* sr = scs + wid * S_SCLD; float m = -INFINITY;
        for (int k = lane; k < nkeys; k += 64) m = fmaxf(m, sr[k]);
#pragma unroll
        for (int o = 1; o < 64; o <<= 1) m = fmaxf(m, __shfl_xor(m, o));
        if (m == -INFINITY) m = 0.f;
        float l = 0.f;
        for (int k = lane; k < nkeys; k += 64) { const float e = fast_exp2(sr[k] - m); sr[k] = e; l += e; }
#pragma unroll
        for (int o = 1; o < 64; o <<= 1) l += __shfl_xor(l, o);
        if (lane == 0) { stat[wid] = m; stat[4 + wid] = l; } }
    LDS_WAIT(); __syncthreads();
    { f32x4 acc[4];
#pragma unroll
      for (int h = 0; h < 4; ++h) acc[h] = (f32x4){0.f, 0.f, 0.f, 0.f};
      for (int i0 = 0; i0 < nit; i0 += 8) { f32x4 vx[8];
#pragma unroll
          for (int u = 0; u < 8; ++u) { const int k = grp + 32 * (i0 + u); vx[u] = k < nkeys ? *(const f32x4*)(kp[k] + VOFF + li * 4) : (f32x4){0.f, 0.f, 0.f, 0.f}; }
#pragma unroll
          for (int u = 0; u < 8; ++u) { const int k = grp + 32 * (i0 + u); if (k < nkeys) {
#pragma unroll
              for (int h = 0; h < 4; ++h) acc[h] += vx[u] * scs[h * S_SCLD + k]; } } }
#pragma unroll
      for (int h = 0; h < 4; ++h) *(LAS f32x4*)(red + (grp * 4 + h) * 64 + li * 4) = acc[h]; }
    LDS_WAIT(); __syncthreads();
    if (tid < 256) { const int h = tid >> 6, d = tid & 63; float o = 0.f;
#pragma unroll 8
        for (int gq = 0; gq < 32; ++gq) o += red[(gq * 4 + h) * 64 + d];
        const float l = stat[4 + h]; ofinal += o * (l > 0.f ? 1.0f / l : 0.f) * gts[BR * 4 + h]; }
}
__device__ __forceinline__ void sample_item(const Ctx& X, int item, unsigned char* ws, const Args& A) {
    LAS unsigned char* lds = X.lds; int tid = X.tid; asm volatile("" : "+v"(tid));
    SampleCtx C; C.b = item >> 3; C.g = (item >> 2) & 1; C.s = item & 3; C.qpos = PAST + C.s; C.cache_sel = A.in[3]; C.state_win = A.in[4]; C.pt = (const int*)A.in[6]; C.out = A.out; C.kvcs = (const float*)(ws + WS_KVCS);
    const int mrow = MP + C.b * TS + C.s;
    LAS float* scs = (LAS float*)(lds + S_SC); LAS float* qs = (LAS float*)(lds + S_Q); LAS float* stat = (LAS float*)(lds + S_STAT); LAS float* gts = (LAS float*)(lds + S_GATE); LAS float* bT = (LAS float*)(lds + S_BIAS);
    LAS float* psum = (LAS float*)(lds + S_PSUM); LAS float* score = (LAS float*)(lds + S_SCORE); LAS int* selidx = (LAS int*)(lds + S_SELIDX);
    bT[tid] = A.in[24][(int)kBucket[tid & 127] * 8 + C.g * 4 + (tid >> 7)] * LOG2E;
    if (tid < 256) qs[tid] = bf2f(((const bf16_t*)(ws + WS_Q))[(size_t)mrow * 512 + C.g * 256 + tid]);
    if (tid < 12) gts[tid] = ((const float*)(ws + WS_GATES))[(size_t)mrow * 24 + (tid >> 2) * 8 + C.g * 4 + (tid & 3)];
    LDS_WAIT(); __syncthreads();
    float ofinal = 0.f;
    sample_branch<0>(X, tid, C, 511, ofinal);
    for (int n = tid; n < 520; n += NTHR) { float v = 0.f; if (n < 511) { v = scs[n] / stat[4] + scs[S_SCLD + n] / stat[5] + scs[2 * S_SCLD + n] / stat[6] + scs[3 * S_SCLD + n] / stat[7]; } psum[n] = v; }
    LDS_WAIT(); __syncthreads();
    if (tid < 129) { const int j = tid; const float v = 2.0f * (psum[4 * j] + psum[4 * j + 1] + psum[4 * j + 2]) + psum[4 * j + 3] + (j > 0 ? psum[4 * j - 1] : 0.f);
        score[j] = v + ((j == 0 || j == 128 || j == 127) ? 1000.0f : 0.f); }
    LDS_WAIT(); __syncthreads();
    if (tid < 129) { const float mv = score[tid]; int cnt = 0; for (int k = 0; k < 129; ++k) { const float v = score[k]; cnt += ((v > mv) || (v == mv && k < tid)) ? 1 : 0; } if (cnt < 16) selidx[cnt] = tid; }
    LDS_WAIT(); __syncthreads();
    sample_branch<1>(X, tid, C, 1024, ofinal);
    __syncthreads();
    sample_branch<2>(X, tid, C, 516, ofinal);
    if (tid < 256) ((bf16_t*)(ws + WS_ACAT))[(size_t)mrow * DM + C.g * 256 + tid] = (bf16_t)f2bf(ofinal);
    LDS_WAIT(); __syncthreads();
}
}

__global__ void __launch_bounds__(NTHR, 2) nsa_fwd(Args args) {
    extern __shared__ __attribute__((aligned(16))) unsigned char lds_raw[];
    Ctx X; X.lds = (LAS unsigned char*)lds_raw; X.tid = threadIdx.x; X.lane = X.tid & 63; X.wave = __builtin_amdgcn_readfirstlane(X.tid >> 6);
    X.G = gridDim.x; { const int bx = blockIdx.x; X.vcu = (X.G % 8 == 0) ? (bx % 8) * (X.G / 8) + bx / 8 : bx; }
    X.gw = X.vcu * NWAVES + X.wave; X.NGW = X.G * NWAVES;
    unsigned char* ws = args.ws; float* out = args.out;
    gu32* ctl = (gu32*)(ws + WS_CTL);
    volatile LAS unsigned* MISC = (volatile LAS unsigned*)(X.lds + MISC_OFF);
    for (int u = X.tid; u < (LDS_BYTES - LDSCTL_OFF) / 4; u += NTHR) ((LAS unsigned*)(X.lds + LDSCTL_OFF))[u] = 0u;
    __syncthreads();
    XcdBarrier bar; bar.bar = (unsigned*)(ctl + CW_BAR); bar.x = 0; bar.st = nullptr;
#if !MK_PER_PHASE
    bar = xcd_barrier_post((unsigned*)(ctl + CW_BAR), MISC + 8);
#define GRID_BAR() xcd_barrier(bar)
#else
#define GRID_BAR() do { } while (0)
#endif
    const int lo = args.ph_lo, hi = args.ph_hi;
#define IN(k) (lo <= (k) && (k) < hi)
#define BOTH(k) (IN(k) && IN((k) + 1))
    float* modv = (float*)(ws + WS_MOD);
    const float* x_p = args.in[0]; const float* x_s = args.in[1];

#if MK_PROBE
    if (IN(-1)) { f32x4* o4 = (f32x4*)(out + O_KVC_P); const size_t n4 = (O_TOTAL - O_KVC_P) / 4;
        for (size_t i = (size_t)X.gw * 64 + X.lane; i < n4; i += (size_t)X.NGW * 64) o4[i] = (f32x4){100.f, 100.f, 100.f, 100.f}; }
#endif
    if (MK_PH_ON(0) && IN(0)) for (int rep_ = 0; rep_ < MK_NREP(0); ++rep_) { if (rep_) GRID_BAR();
        for (int rp = 0; rp < MK_NREP(20); ++rp)
        for (int it = X.vcu; it < NMOD / 64; it += X.G) ada_item(X, it, args.in[7], args.in[8], args.in[9], args.in[10], modv);
        __syncthreads();
        {
            LAS float* scr = (LAS float*)(X.lds + X.wave * 16384);
            int total = 0;
            for (int j = 0; j < NJOBS; ++j) total += tj_items(kJobs[j]);
            for (int it = X.gw; it < total * MK_NREP(21); it += X.NGW) {
                int r = it % total, j = 0;
                for (; j < NJOBS - 1; ++j) { const int n = tj_items(kJobs[j]); if (r < n) break; r -= n; }
                const TJ J = kJobs[j];
                const int nblk = (J.ncols + 63) / 64, per = (J.K / 64) * nblk, rep = r / per, rr = r % per, kb = rr / nblk, nb = rr % nblk;
                const float* W = args.in[J.src] + (size_t)rep * J.srcoff_stride + J.col0 + rep * J.col_stride;
                bf16_t* WT = wdst(ws, J.dst) + (size_t)(J.drow0 + rep * J.drow_stride) * J.dpitch + J.dcol0;
                transpose_item(W, J.N, J.ncols, WT, J.dpitch, scr, kb, nb, X.lane);
            }
            { u32x4* z = (u32x4*)((bf16_t*)(ws + WS_WIN) + (size_t)INW * DM); const int nz = (INWP - INW) * DM * 2 / 16;
              for (int i = X.gw * 64 + X.lane; i < nz; i += X.NGW * 64) z[i] = (u32x4){0u, 0u, 0u, 0u}; }
        }
        for (int o = X.gw; o < 256; o += X.NGW) { const int c = o >> 7, e = o & 127; const float* pe = args.in[19] + c * 2048; const float* w1 = args.in[17] + (size_t)c * 2048 * 128 + e;
            float s = 0.f; for (int k = X.lane; k < 2048; k += 64) s += pe[k] * w1[(size_t)k * 128];
#pragma unroll
            for (int off = 1; off < 64; off <<= 1) s += __shfl_xor(s, off);
            if (X.lane == 0) ((float*)(ws + WS_PETERM))[o] = s; }
        { const f32x4* src = (const f32x4*)args.in[4]; f32x4* dst = (f32x4*)(out + O_KVW_S); const int per_b = 508 * 64;
          for (int i = X.gw * 64 + X.lane; i < NBS * per_b; i += X.NGW * 64) { const int b = i / per_b, r = i % per_b; dst[(size_t)b * 512 * 64 + r] = src[(size_t)b * 512 * 64 + 4 * 64 + r]; } }
        { const int* pt = (const int*)args.in[6]; const float* cache = args.in[2]; bf16_t* ACS = (bf16_t*)(ws + WS_ACS);
          for (int it0 = X.gw; it0 < NBS * 512 * MK_NREP(22); it0 += X.NGW) { const int it = it0 & (NBS * 512 - 1); const int b = it >> 9, n = it & 511; const int page = pt[b * NPAGE + (n >> 3)];
              const f32x4* src = (const f32x4*)(cache + ((size_t)page * PAGE + (n & 7) * 16) * 256) + X.lane;
              const int c = X.lane >> 5, g = (X.lane >> 4) & 1, d = (X.lane & 15) * 4;
              bf16_t* dst = ACS + ((size_t)c * 32768 + (size_t)(b * 2 + g) * 512 + n) * 1024 + d;
              f32x4 v[16];
#pragma unroll
              for (int l = 0; l < 16; ++l) v[l] = src[l * 64];
#pragma unroll
              for (int l = 0; l < 16; ++l) { u32x2 w; w.x = pk2(v[l][0], v[l][1]); w.y = pk2(v[l][2], v[l][3]); *(u32x2*)(dst + l * 64) = w; } } }
        if (BOTH(0)) GRID_BAR();
    }

    if (MK_PH_ON(1) && IN(1)) for (int rep_ = 0; rep_ < MK_NREP(1); ++rep_) { if (rep_) GRID_BAR();
        { const float* g1 = args.in[11]; bf16_t* A1 = (bf16_t*)(ws + WS_A1);
          for (int m = X.gw; m < MPAD; m += X.NGW) {
              unsigned long long* o8 = (unsigned long long*)(A1 + (size_t)m * DM) + X.lane;
              if (m >= MTOT) {
#pragma unroll
                  for (int j = 0; j < 4; ++j) o8[64 * j] = 0ull;
                  continue; }
              const float* xr = m < MP ? x_p + (size_t)m * DM : x_s + (size_t)(m - MP) * DM; const int bi = bidx_of_row(m);
              const f32x4* x4 = (const f32x4*)xr + X.lane; f32x4 v[4]; float s = 0.f;
#pragma unroll
              for (int j = 0; j < 4; ++j) { v[j] = x4[64 * j]; s += (v[j][0] * v[j][0] + v[j][1] * v[j][1]) + (v[j][2] * v[j][2] + v[j][3] * v[j][3]); }
#pragma unroll
              for (int off = 1; off < 64; off <<= 1) s += __shfl_xor(s, off);
              const float rt = 1.0f / sqrtf(s * (1.0f / DM) + EPS);
              const f32x4* gg = (const f32x4*)g1 + X.lane; const f32x4* sh = (const f32x4*)modp(modv, bi, 0, 0) + X.lane; const f32x4* sc = (const f32x4*)modp(modv, bi, 0, 1) + X.lane;
#pragma unroll
              for (int j = 0; j < 4; ++j) { const f32x4 a = v[j] * rt * gg[64 * j] * (sc[64 * j] + 1.0f) + sh[64 * j];
                  o8[64 * j] = (unsigned long long)pk2(a[0], a[1]) | ((unsigned long long)pk2(a[2], a[3]) << 32); }
          } }
        for (int second = 0; second < 2; ++second) {
            constexpr int SP = 1024 + 8;
            LAS bf16_t* shl = (LAS bf16_t*)X.lds;
            __syncthreads();
            for (int i = X.tid; i < 48 * 256; i += NTHR) { const int bi = i >> 8, k4 = (i & 255) * 4; const f32x4 a = *(const f32x4*)(modp(modv, bi < NBIDX ? bi : NBIDX - 1, second ? 2 : 1, 0) + k4);
                u32x2 w; w.x = pk2(a[0], a[1]); w.y = pk2(a[2], a[3]); *(LAS u32x2*)(shl + bi * SP + k4) = w; }
            LDS_WAIT(); __syncthreads();
            const int nrows = second ? NGU : INWP; const bf16_t* Wt = (const bf16_t*)(ws + (second ? WS_WGU2 : WS_WIN)); float* dst = (float*)(ws + (second ? WS_SW3 : WS_SW2));
            const int fr = X.lane & 15, fq = X.lane >> 4;
            for (int it = X.gw; it < nrows / 16; it += X.NGW) { const int n0 = it * 16; f32x4 acc[3];
#pragma unroll
                for (int bt = 0; bt < 3; ++bt) acc[bt] = (f32x4){0.f, 0.f, 0.f, 0.f};
                const bf16_t* wr = Wt + (size_t)(n0 + fr) * DM + 8 * fq;
#pragma unroll 8
                for (int ks = 0; ks < 32; ++ks) { const bf16x8 af = *(const bf16x8*)(wr + 32 * ks);
#pragma unroll
                    for (int bt = 0; bt < 3; ++bt) { const bf16x8 bfr = *(const LAS bf16x8*)(shl + (16 * bt + fr) * SP + 32 * ks + 8 * fq); acc[bt] = __builtin_amdgcn_mfma_f32_16x16x32_bf16(af, bfr, acc[bt], 0, 0, 0); } }
#pragma unroll
                for (int bt = 0; bt < 3; ++bt) { const int bi = 16 * bt + fr; if (bi < NBIDX) *(f32x4*)(dst + (size_t)bi * nrows + n0 + 4 * fq) = acc[bt]; } }
        }
        __syncthreads();
        for (int c = 0; c < 2; ++c) {
            pg8::Gemm g{(const bf16_t*)(ws + WS_ACS) + (size_t)c * 32768 * 1024, (const bf16_t*)(ws + WS_WC1) + (size_t)c * 256 * 1024, 32768, 256, DM};
            pg8::StaticOrder S; S.init(32768, 256, X.G, (int)((blockIdx.x + (c ? X.G - 128 : 0)) % X.G));
            pg8::EpiStoreBf16 E{(bf16_t*)(ws + WS_PCS) + (size_t)c * 32768 * 256, 256};
            pg8::gemm_phase(X.lds, g, S, E);
        }
        if (BOTH(1)) GRID_BAR();
    }

    if (MK_PH_ON(2) && IN(2)) for (int rep_ = 0; rep_ < MK_NREP(2); ++rep_) { if (rep_) GRID_BAR();
        pg8::Gemm g{(const bf16_t*)(ws + WS_A1), (const bf16_t*)(ws + WS_WGU1), MPAD, NGU, DM}; pg8::StaticOrder S; S.init(MPAD, NGU, X.G, (int)blockIdx.x);
        pg8::EpiGU E{(bf16_t*)(ws + WS_ACT), nullptr, nullptr, 0};
        pg8::gemm_phase(X.lds, g, S, E);
        if (BOTH(2)) GRID_BAR();
    }
    if (MK_PH_ON(3) && IN(3)) for (int rep_ = 0; rep_ < MK_NREP(3); ++rep_) { if (rep_) GRID_BAR();
        pg8::Gemm g{(const bf16_t*)(ws + WS_ACT), (const bf16_t*)(ws + WS_WD1), MPAD, DM, DFF}; pg8::StaticOrder S; S.init(MPAD, DM, X.G, (int)blockIdx.x);
        float* H1 = (float*)(ws + WS_H1);
        pg8::EpiRes E{x_p, x_s, H1, H1 + (size_t)MP * DM, modv, 0, 0.5f, (bf16_t*)(ws + WS_A2), args.in[11] + DM, 1, (float*)(ws + WS_SSQ2)};
        pg8::gemm_phase(X.lds, g, S, E);
        if (BOTH(3)) GRID_BAR();
    }
    if (MK_PH_ON(4) && IN(4)) for (int rep_ = 0; rep_ < MK_NREP(4); ++rep_) { if (rep_) GRID_BAR();
        pg8::Gemm g{(const bf16_t*)(ws + WS_A2), (const bf16_t*)(ws + WS_WIN), MPAD, INWP, DM}; pg8::StaticOrder S; S.init(MPAD, INWP, X.G, (int)blockIdx.x);
        EpiIn E{(const float*)(ws + WS_SSQ2), (const float*)(ws + WS_SW2), out, ws};
        pg8::gemm_phase(X.lds, g, S, E);
        if (BOTH(4)) GRID_BAR();
    }
    if (MK_PH_ON(5) && IN(5)) for (int rep_ = 0; rep_ < MK_NREP(5); ++rep_) { if (rep_) GRID_BAR();
        for (int c = 0; c < 2; ++c) {
            pg8::Gemm g{(const bf16_t*)(ws + WS_ACP) + (size_t)c * 2048 * 1024, (const bf16_t*)(ws + WS_WC1) + (size_t)c * 256 * 1024, 2048, 256, DM};
            pg8::StaticOrder S; S.init(2048, 256, X.G, (int)((blockIdx.x + (c ? X.G - 8 : 0)) % X.G));
            pg8::EpiStoreBf16 E{(bf16_t*)(ws + WS_PCP) + (size_t)c * 2048 * 256, 256};
            pg8::gemm_phase(X.lds, g, S, E);
        }
        __syncthreads();
        { const bf16_t* PROD = (const bf16_t*)(ws + WS_PROD); const bf16_t* CBb = (const bf16_t*)(ws + WS_CB); bf16_t* ACAT = (bf16_t*)(ws + WS_ACAT);
          const float* wcv = args.in[20]; const float* stc = args.in[5]; const int j = X.lane * 8;
          float w0[8], w1[8], w2[8];
#pragma unroll
          for (int e = 0; e < 8; ++e) { w0[e] = wcv[j + e]; w1[e] = wcv[512 + j + e]; w2[e] = wcv[1024 + j + e]; }
          for (int m = X.gw; m < MTOT; m += X.NGW) {
              const bool isp = m < MP; const int t = isp ? (m & (TP - 1)) : ((m - MP) & 3), bs = isp ? 0 : ((m - MP) >> 2);
              float a2[8], a1[8], a0[8], cbv[8];
              { const u32x4 v = *(const u32x4*)(PROD + (size_t)m * 512 + j); const u32x4 c4 = *(const u32x4*)(CBb + (size_t)m * 512 + j);
#pragma unroll
                for (int e = 0; e < 4; ++e) { a0[2 * e] = bflo(v[e]); a0[2 * e + 1] = bfhi(v[e]); cbv[2 * e] = bflo(c4[e]); cbv[2 * e + 1] = bfhi(c4[e]); } }
              if (t >= 1) { const u32x4 v = *(const u32x4*)(PROD + (size_t)(m - 1) * 512 + j);
#pragma unroll
                  for (int e = 0; e < 4; ++e) { a1[2 * e] = bflo(v[e]); a1[2 * e + 1] = bfhi(v[e]); } }
              else {
#pragma unroll
                  for (int e = 0; e < 8; ++e) a1[e] = isp ? 0.f : stc[((size_t)bs * 2 + 1) * 512 + j + e]; }
              if (t >= 2) { const u32x4 v = *(const u32x4*)(PROD + (size_t)(m - 2) * 512 + j);
#pragma unroll
                  for (int e = 0; e < 4; ++e) { a2[2 * e] = bflo(v[e]); a2[2 * e + 1] = bfhi(v[e]); } }
              else {
#pragma unroll
                  for (int e = 0; e < 8; ++e) a2[e] = isp ? 0.f : stc[((size_t)bs * 2 + t) * 512 + j + e]; }
              float y[8];
#pragma unroll
              for (int e = 0; e < 8; ++e) y[e] = cbv[e] * (w0[e] * a2[e] + w1[e] * a1[e] + w2[e] * a0[e]);
              u32x4 w; w.x = pk2(y[0], y[1]); w.y = pk2(y[2], y[3]); w.z = pk2(y[4], y[5]); w.w = pk2(y[6], y[7]);
              *(u32x4*)(ACAT + (size_t)m * DM + 512 + j) = w; } }
        for (int it = X.vcu; it < 2 * 64 * 8; it += X.G) cmp_tail_item<true>(X, it, ws, args.in[18]);
        if (BOTH(5)) GRID_BAR();
    }
    if (MK_PH_ON(6) && IN(6)) for (int rep_ = 0; rep_ < MK_NREP(6); ++rep_) { if (rep_) GRID_BAR();
        for (int it = X.vcu; it < 2 * 8 * 4; it += X.G) cmp_tail_item<false>(X, it, ws, args.in[18]);
        if (BOTH(6)) GRID_BAR();
    }
    if (MK_PH_ON(7) && IN(7)) {
        for (int i = X.vcu; i < 512 * MK_NREP(7); i += X.G) { const int ii = i & 255; const int bg = ii >> 5, qt = ((i & 256) == 0) ? (ii & 31) : 63 - (ii & 31); att::prompt_item(X, bg, qt, ws, args.in[24]); }
        for (int i = X.vcu; i < 256 * MK_NREP(7); i += X.G) att::sample_item(X, i & 255, ws, args);
        if (BOTH(7)) GRID_BAR();
    }
    if (MK_PH_ON(8) && IN(8)) for (int rep_ = 0; rep_ < MK_NREP(8); ++rep_) { if (rep_) GRID_BAR();
        pg8::Gemm g{(const bf16_t*)(ws + WS_ACAT), (const bf16_t*)(ws + WS_WM), MPAD, DM, DM}; pg8::StaticOrder S; S.init(MPAD, DM, X.G, (int)blockIdx.x);
        EpiMerge E{8, (const bf16_t*)(ws + WS_RATIO), (const bf16_t*)(ws + WS_GB), (bf16_t*)(ws + WS_MERGED)};
        pg8::gemm_phase(X.lds, g, S, E);
        if (BOTH(8)) GRID_BAR();
    }
    if (MK_PH_ON(9) && IN(9)) for (int rep_ = 0; rep_ < MK_NREP(9); ++rep_) { if (rep_) GRID_BAR();
        pg8::Gemm g{(const bf16_t*)(ws + WS_MERGED), (const bf16_t*)(ws + WS_WO), MPAD, DM, DM}; pg8::StaticOrder S; S.init(MPAD, DM, X.G, (int)blockIdx.x);
        float* H1 = (float*)(ws + WS_H1);
        pg8::EpiRes E{H1, H1 + (size_t)MP * DM, H1, H1 + (size_t)MP * DM, modv, 1, 1.0f, (bf16_t*)(ws + WS_A3), args.in[11] + 2 * DM, 2, (float*)(ws + WS_SSQ3)};
        pg8::gemm_phase(X.lds, g, S, E);
        if (BOTH(9)) GRID_BAR();
    }
    if (MK_PH_ON(10) && IN(10)) for (int rep_ = 0; rep_ < MK_NREP(10); ++rep_) { if (rep_) GRID_BAR();
        pg8::Gemm g{(const bf16_t*)(ws + WS_A3), (const bf16_t*)(ws + WS_WGU2), MPAD, NGU, DM}; pg8::StaticOrder S; S.init(MPAD, NGU, X.G, (int)blockIdx.x);
        pg8::EpiGU E{(bf16_t*)(ws + WS_ACT), (const float*)(ws + WS_SSQ3), (const float*)(ws + WS_SW3), NGU};
        pg8::gemm_phase(X.lds, g, S, E);
        if (BOTH(10)) GRID_BAR();
    }
    if (MK_PH_ON(11) && IN(11)) for (int rep_ = 0; rep_ < MK_NREP(11); ++rep_) { if (rep_) GRID_BAR();
        pg8::Gemm g{(const bf16_t*)(ws + WS_ACT), (const bf16_t*)(ws + WS_WD2), MPAD, DM, DFF}; pg8::StaticOrder S; S.init(MPAD, DM, X.G, (int)blockIdx.x);
        float* H1 = (float*)(ws + WS_H1);
        pg8::EpiRes E{H1, H1 + (size_t)MP * DM, out + O_Y, out + O_Y + (size_t)MP * DM, modv, 2, 0.5f, nullptr, nullptr, 0, nullptr};
        pg8::gemm_phase(X.lds, g, S, E);
        if (BOTH(11)) GRID_BAR();
    }
    if (MK_PH_ON(12) && IN(12)) for (int rep_ = 0; rep_ < MK_NREP(12); ++rep_) { if (rep_) GRID_BAR();
        const f32x4* gf = (const f32x4*)args.in[25] + X.lane;
        for (int m = X.gw; m < MTOT; m += X.NGW) { f32x4* y4 = (f32x4*)(out + O_Y + (size_t)m * DM) + X.lane; f32x4 v[4]; float s = 0.f;
#pragma unroll
            for (int j = 0; j < 4; ++j) { v[j] = y4[64 * j]; s += (v[j][0] * v[j][0] + v[j][1] * v[j][1]) + (v[j][2] * v[j][2] + v[j][3] * v[j][3]); }
#pragma unroll
            for (int off = 1; off < 64; off <<= 1) s += __shfl_xor(s, off);
            const float rt = 1.0f / sqrtf(s * (1.0f / DM) + EPS);
#pragma unroll
            for (int j = 0; j < 4; ++j) y4[64 * j] = v[j] * rt * gf[64 * j]; }
    }
#if MK_PROBE
    if (IN(13)) { f32x4* o4 = (f32x4*)(out + O_KVC_P); const size_t n4 = (O_TOTAL - O_KVC_P) / 4;
        for (size_t i = (size_t)X.gw * 64 + X.lane; i < n4; i += (size_t)X.NGW * 64) o4[i] = o4[i] * 3.0f; }
#endif
#undef IN
#undef BOTH
}

extern "C" void kernel_launch(void* const* d_in, const int* in_sizes, int n_in, void* d_out, int out_size, void* d_ws, size_t ws_size, hipStream_t stream) {
    static int grid = 0;
    if (grid == 0) {
        if (n_in != 26 || out_size != (int)O_TOTAL || ws_size < WS_END) { fprintf(stderr, "kernel_launch: unexpected shapes n_in %d out %d ws %zu\n", n_in, out_size, ws_size); grid = -1; return; }
        int dev = 0, cus = 0;
        if (hipGetDevice(&dev) != hipSuccess || hipDeviceGetAttribute(&cus, hipDeviceAttributeMultiprocessorCount, dev) != hipSuccess) { grid = -1; return; }
        if (hipFuncSetAttribute((const void*)nsa_fwd, hipFuncAttributeMaxDynamicSharedMemorySize, LDS_BYTES) != hipSuccess) { fprintf(stderr, "kernel_launch: hipFuncSetAttribute failed\n"); grid = -1; return; }
        int per_cu = 0;
        if (hipOccupancyMaxActiveBlocksPerMultiprocessor(&per_cu, (const void*)nsa_fwd, NTHR, LDS_BYTES) != hipSuccess || per_cu < 1) fprintf(stderr, "kernel_launch: occupancy query says %d\n", per_cu);
        (void)hipGetLastError();
        grid = cus;
    }
    if (grid < 0) return;
    (void)hipMemsetAsync((char*)d_ws + WS_CTL, 0, CTL_ZERO_BYTES, stream);
    Args a{};
    for (int i = 0; i < 26; ++i) a.in[i] = (const float*)d_in[i];
    a.out = (float*)d_out; a.ws = (unsigned char*)d_ws;
    constexpr int NPH = MK_LAST_PHASE + 1 + (MK_PROBE ? 1 : 0);
#if MK_PER_PHASE
    for (int p = (MK_PROBE ? -1 : 0); p < NPH; ++p) { a.ph_lo = p; a.ph_hi = p + 1; a.li = 0; hipLaunchKernelGGL(nsa_fwd, dim3(grid), dim3(NTHR), LDS_BYTES, stream, a); }
#else
    a.ph_lo = 0; a.ph_hi = NPH; a.li = 0; hipLaunchKernelGGL(nsa_fwd, dim3(grid), dim3(NTHR), LDS_BYTES, stream, a);
#endif
}
```

```cpp
#include <hip/hip_runtime.h>
#include <hip/hip_bf16.h>
#include <cstdio>
#include <cstdint>
#include <cmath>

#ifndef MK_PER_PHASE
#define MK_PER_PHASE 0
#endif
#ifndef MK_PH_MASK
#define MK_PH_MASK 0xffffffffu
#endif
#define MK_PH_ON(k) ((MK_PH_MASK >> (k)) & 1u)
#ifndef MK_PROBE
#define MK_PROBE 0
#endif
#ifndef MK_DUP
#define MK_DUP (-1)
#endif
#define MK_NREP(k) ((k) == MK_DUP ? 2 : 1)
#ifndef MK_LAST_PHASE
#define MK_LAST_PHASE 12
#endif

constexpr int DM = 1024, NBP = 4, TP = 4096, MP = NBP * TP, NBS = 32, TS = 4, MS = NBS * TS, MTOT = MP + MS, MPAD = 16640;
constexpr int HD = 64, NH = 8, HKV = 2, GRP = 4, DFF = 2816, NGU = 2 * DFF, INW = 4888, INWP = 5120, DCONV = 512;
constexpr int PAST = 8192, NPAGE = 64, PAGE = 128, NPHYS = 2560;
constexpr int NBIDX = NBP + NBS;
constexpr int NMOD = 9 * DM;
constexpr float EPS = 1e-6f;
constexpr float LOG2E = 1.4426950408889634f;
constexpr float QSCALE = 0.125f * LOG2E;

constexpr size_t O_Y = 0;
constexpr size_t O_KVC_P = (size_t)MTOT * DM;
constexpr size_t O_KVS_P = O_KVC_P + (size_t)MP * 256;
constexpr size_t O_KVW_P = O_KVS_P + (size_t)MP * 256;
constexpr size_t O_CONV_P = O_KVW_P + (size_t)NBP * 512 * 256;
constexpr size_t O_KVC_S = O_CONV_P + (size_t)NBP * 2 * 512;
constexpr size_t O_KVS_S = O_KVC_S + (size_t)MS * 256;
constexpr size_t O_KVW_S = O_KVS_S + (size_t)MS * 256;
constexpr size_t O_CONV_S = O_KVW_S + (size_t)NBS * 512 * 256;
constexpr size_t O_TOTAL = O_CONV_S + (size_t)NBS * 2 * 512;
static_assert(O_TOTAL == 30117888, "output size");

constexpr size_t MiB = 1u << 20;
constexpr size_t WS_CTL = 0, CTL_ZERO_BYTES = 1 * MiB;
constexpr size_t WS_MOD = 1 * MiB;
constexpr size_t WS_PETERM = 3 * MiB;
constexpr size_t WS_SW2 = 4 * MiB;
constexpr size_t WS_SW3 = 5 * MiB;
constexpr size_t WS_SSQ2 = 6 * MiB, WS_SSQ3 = 8 * MiB;
constexpr size_t WS_SSQS2 = 7 * MiB + 512 * 1024, WS_SSQS3 = 9 * MiB + 512 * 1024;
constexpr size_t WS_GATES = 10 * MiB;
constexpr size_t WS_WGU1 = 16 * MiB;
constexpr size_t WS_WD1 = 28 * MiB;
constexpr size_t WS_WIN = 34 * MiB;
constexpr size_t WS_WM = 46 * MiB;
constexpr size_t WS_WO = 48 * MiB;
constexpr size_t WS_WGU2 = 50 * MiB;
constexpr size_t WS_WD2 = 62 * MiB;
constexpr size_t WS_WC1 = 68 * MiB;
constexpr size_t WS_A1 = 72 * MiB;
constexpr size_t WS_A2 = 106 * MiB;
constexpr size_t WS_A3 = 140 * MiB;
constexpr size_t WS_ACT = 174 * MiB;
constexpr size_t WS_H1 = 266 * MiB;
constexpr size_t WS_Q = 332 * MiB;
constexpr size_t WS_KS = 350 * MiB, WS_VS = 354 * MiB, WS_KW = 358 * MiB, WS_VW = 362 * MiB;
constexpr size_t WS_ACP = 366 * MiB;
constexpr size_t WS_PCP = 376 * MiB;
constexpr size_t WS_KCP = 380 * MiB, WS_VCP = 381 * MiB;
constexpr size_t WS_KVCS = 382 * MiB;
constexpr size_t WS_PROD = 400 * MiB;
constexpr size_t WS_CB = 418 * MiB;
constexpr size_t WS_RATIO = 436 * MiB;
constexpr size_t WS_GB = 470 * MiB;
constexpr size_t WS_ACAT = 504 * MiB;
constexpr size_t WS_MERGED = 538 * MiB;
constexpr size_t WS_PCS = 572 * MiB;
constexpr size_t WS_ACS = 608 * MiB;
constexpr size_t WS_END = 740 * MiB;

constexpr int CW_TMO = 0, CW_CODE = 1, CW_BAR = 4096;

#define GAS __attribute__((address_space(1)))
#define LAS __attribute__((address_space(3)))
typedef unsigned short bf16_t;
typedef short bf16x8 __attribute__((ext_vector_type(8)));
typedef float f32x4 __attribute__((ext_vector_type(4)));
typedef float f32x2 __attribute__((ext_vector_type(2)));
typedef unsigned u32x4 __attribute__((ext_vector_type(4)));
typedef unsigned u32x2 __attribute__((ext_vector_type(2)));
typedef GAS unsigned gu32;

__device__ __forceinline__ unsigned f2bf(float f) { unsigned u = __builtin_bit_cast(unsigned, f); return (u + 0x7fffu + ((u >> 16) & 1u)) >> 16; }
__device__ __forceinline__ unsigned pk2(float lo, float hi) { return f2bf(lo) | (f2bf(hi) << 16); }
__device__ __forceinline__ float bf2f(unsigned short b) { return __builtin_bit_cast(float, (unsigned)b << 16); }
__device__ __forceinline__ float bflo(unsigned w) { return __builtin_bit_cast(float, w << 16); }
__device__ __forceinline__ float bfhi(unsigned w) { return __builtin_bit_cast(float, w & 0xffff0000u); }
__device__ __forceinline__ float fast_exp2(float x) { return __builtin_amdgcn_exp2f(x); }
__device__ __forceinline__ float fast_rcp(float x) { return __builtin_amdgcn_rcpf(x); }
__device__ __forceinline__ float sigmoidf_(float x) { return fast_rcp(1.0f + fast_exp2(-x * LOG2E)); }
__device__ __forceinline__ float siluf_(float x) { return x * sigmoidf_(x); }
__device__ __forceinline__ int bidx_of_row(int row) { int b = row < MP ? (row >> 12) : NBP + ((row - MP) >> 2); return b < NBIDX ? b : NBIDX - 1; }
__device__ __forceinline__ const float* modp(const float* modv, int bidx, int sub, int kind) { return modv + ((size_t)(bidx * 3 + sub) * 3 + kind) * DM; }

namespace pg8 {
constexpr int BM = 256, BK = 64, HALF = 128, HTB = HALF * BK * 2, STAGE_BYTES = 8 * HTB, NXCD = 8, WGM = 8;
__host__ __device__ __forceinline__ int lds_byte(int r, int c) { const int st = (r >> 4) * 2 + (c >> 5), rr = r & 15, cc = c & 31, ob = rr * 64 + cc * 2; return st * 1024 + (ob ^ (((ob >> 9) & 1) << 5)); }
__host__ __device__ __forceinline__ void stage_rc(int b, int& R, int& C) { const int st = b / 1024, sb = b % 1024, swz = sb ^ (((sb >> 9) & 1) << 5); R = (st >> 1) * 16 + swz / 64; C = (st & 1) * 32 + (swz % 64) / 2; }
__host__ __device__ __forceinline__ int perm32(int rho) { const int n = rho >> 4, i = rho & 15; return 8 * (i >> 2) + 4 * n + (i & 3); }
struct Unit { int pm, pn; };
struct Gemm { const bf16_t* A; const bf16_t* Bt; int M, N, K; };
struct StaticOrder {
    int nM, nN, nwg, G, c;
    __host__ __device__ void init(int M, int N, int G_, int c_) { nM = M / BM; nN = N / BM; nwg = nM * nN; G = G_; c = c_; }
    __host__ __device__ bool next(int i, Unit& u) const {
        const long L = (long)i * G + c; if (L >= nwg) return false;
        int wgid = (int)L; { const int q = nwg / NXCD, r = nwg % NXCD, xcd = wgid % NXCD, off = wgid / NXCD; wgid = (xcd < r ? xcd * (q + 1) : r * (q + 1) + (xcd - r) * q) + off; }
        const int nig = WGM * nN, gid = wgid / nig, fm = gid * WGM, gsz = (nM - fm) < WGM ? (nM - fm) : WGM;
        u.pm = fm + ((wgid % nig) % gsz); u.pn = (wgid % nig) / gsz; return true;
    }
    __device__ __forceinline__ void a_ready(const Unit&) const {}
    __device__ __forceinline__ void done(const Unit&) const {}
};
template <class Epi, class Sched>
__device__ __forceinline__ void gemm_phase(LAS unsigned char* lds, const Gemm g, const Sched& S, const Epi& E) {
    const int tid = threadIdx.x, wid = __builtin_amdgcn_readfirstlane(tid >> 6), lane = tid & 63, wr = wid >> 2, wc = wid & 3, fr = lane & 15, fq = lane >> 4;
    const int K = g.K, nt = K / BK;
    unsigned voffA[2], voffB[2];
#pragma unroll
    for (int i = 0; i < 2; ++i) { int R, C; stage_rc(tid * 16 + i * 8192, R, C); const int Rb = Epi::PERM ? ((R & ~31) + perm32(R & 31)) : R;
        voffA[i] = (unsigned)(R * K + C) * 2u; voffB[i] = (unsigned)(Rb * K + C) * 2u; }
    const size_t kstep = (size_t)(BK * 2);
    const size_t hstep = (size_t)HALF * K * 2;
    const size_t tstep = 2 * hstep;
    const unsigned ldsw = (unsigned)wid * 1024u;
    const int aoff = lds_byte(wr * 64 + fr, fq * 8), boff = lds_byte(wc * 32 + fr, fq * 8);
#define PG8_SA(b, h) (((b) * 2 + (h)) * HTB)
#define PG8_SB(b, h) ((4 + (b) * 2 + (h)) * HTB)
#define PG8_STAGE(bufoff, gbase, voff) do { _Pragma("unroll") for (int _i = 0; _i < 2; ++_i) \
        __builtin_amdgcn_global_load_lds((const unsigned*)((const char*)(gbase) + (voff)[_i]), (LAS unsigned*)(lds + (bufoff) + ldsw + _i * 8192), 16, 0, 0); } while (0)
#define PG8_LDA(dst, b, h) do { _Pragma("unroll") for (int m = 0; m < 4; ++m) _Pragma("unroll") for (int k = 0; k < 2; ++k) dst[m][k] = *(const LAS bf16x8*)(lds + PG8_SA(b, h) + aoff + m * 2048 + k * 1024); } while (0)
#define PG8_LDB(dst, b, h) do { _Pragma("unroll") for (int n = 0; n < 2; ++n) _Pragma("unroll") for (int k = 0; k < 2; ++k) dst[n][k] = *(const LAS bf16x8*)(lds + PG8_SB(b, h) + boff + n * 2048 + k * 1024); } while (0)
#define PG8_MMA(ai, bj, At, Bt) do { __builtin_amdgcn_s_setprio(1); _Pragma("unroll") for (int m = 0; m < 4; ++m) _Pragma("unroll") for (int n = 0; n < 2; ++n) _Pragma("unroll") for (int k = 0; k < 2; ++k) \
        acc[ai][bj][m][n] = __builtin_amdgcn_mfma_f32_16x16x32_bf16(Bt[n][k], At[m][k], acc[ai][bj][m][n], 0, 0, 0); __builtin_amdgcn_s_setprio(0); } while (0)
#define PG8_WAIT_V(n) asm volatile("s_waitcnt vmcnt(" #n ")" ::: "memory")
#define PG8_WAIT_L(n) asm volatile("s_waitcnt lgkmcnt(" #n ")" ::: "memory")
#define PG8_BAR __builtin_amdgcn_s_barrier()
#define PG8_SCHED __builtin_amdgcn_sched_barrier(0)
    Unit cur, nxt; int ui = 0;
    if (!S.next(0, cur)) return;
    f32x4 acc[2][2][4][2];
#pragma unroll
    for (int a = 0; a < 2; ++a)
#pragma unroll
        for (int b = 0; b < 2; ++b)
#pragma unroll
            for (int m = 0; m < 4; ++m)
#pragma unroll
                for (int n = 0; n < 2; ++n) acc[a][b][m][n] = (f32x4){0.f, 0.f, 0.f, 0.f};
    bf16x8 At[4][2], B0[2][2], B1[2][2];
    const char* cA = (const char*)g.A + (size_t)cur.pm * tstep; const char* cB = (const char*)g.Bt + (size_t)cur.pn * tstep;
    S.a_ready(cur);
    PG8_STAGE(PG8_SB(0, 0), cB, voffB); PG8_STAGE(PG8_SB(0, 1), cB + hstep, voffB); PG8_STAGE(PG8_SA(0, 0), cA, voffA); PG8_STAGE(PG8_SA(0, 1), cA + hstep, voffA);
    if (wr == 1) PG8_BAR;
    PG8_WAIT_V(2); PG8_BAR;
    PG8_STAGE(PG8_SB(1, 0), cB + kstep, voffB); PG8_STAGE(PG8_SA(1, 0), cA + kstep, voffA); PG8_STAGE(PG8_SB(1, 1), cB + hstep + kstep, voffB);
    PG8_WAIT_V(6); PG8_BAR;
    for (;;) {
        const bool has_next = S.next(ui + 1, nxt);
        const char* nA = has_next ? (const char*)g.A + (size_t)nxt.pm * tstep : cA; const char* nB = has_next ? (const char*)g.Bt + (size_t)nxt.pn * tstep : cB;
        for (int t = 0; t < nt; t += 2) {
            const bool last = (t == nt - 2);
            const char* a1 = cA + (size_t)(t + 1) * kstep;
            const char* a2 = last ? nA : cA + (size_t)(t + 2) * kstep; const char* b2 = last ? nB : cB + (size_t)(t + 2) * kstep;
            const char* a3 = a2 + kstep; const char* b3 = b2 + kstep;
            if (last && has_next) S.a_ready(nxt);
            if constexpr (Epi::HAS_MID) { if (t == E.mid_t) E.mid(acc, cur, wr, wc, fr, fq); }
            PG8_LDB(B0, 0, 0); PG8_LDB(B1, 0, 1); PG8_SCHED; PG8_LDA(At, 0, 0); PG8_STAGE(PG8_SA(1, 1), a1 + hstep, voffA);
            PG8_WAIT_V(8); PG8_WAIT_L(0); PG8_BAR; PG8_MMA(0, 0, At, B0); PG8_MMA(0, 1, At, B1); PG8_BAR; PG8_SCHED;
            PG8_LDA(At, 0, 1); PG8_STAGE(PG8_SB(0, 0), b2, voffB); PG8_STAGE(PG8_SB(0, 1), b2 + hstep, voffB); PG8_STAGE(PG8_SA(0, 0), a2, voffA);
            PG8_WAIT_V(8); PG8_WAIT_L(0); PG8_BAR; PG8_MMA(1, 0, At, B0); PG8_MMA(1, 1, At, B1); PG8_BAR; PG8_SCHED;
            PG8_LDB(B0, 1, 0); PG8_LDB(B1, 1, 1); PG8_SCHED; PG8_LDA(At, 1, 0); PG8_STAGE(PG8_SA(0, 1), a2 + hstep, voffA);
            PG8_WAIT_V(8); PG8_WAIT_L(0); PG8_BAR; PG8_MMA(0, 0, At, B0); PG8_MMA(0, 1, At, B1); PG8_BAR; PG8_SCHED;
            PG8_LDA(At, 1, 1); PG8_STAGE(PG8_SB(1, 0), b3, voffB); PG8_STAGE(PG8_SB(1, 1), b3 + hstep, voffB); PG8_STAGE(PG8_SA(1, 0), a3, voffA);
            PG8_WAIT_V(8); PG8_WAIT_L(0); PG8_BAR; PG8_MMA(1, 0, At, B0); PG8_MMA(1, 1, At, B1); PG8_BAR; PG8_SCHED;
        }
        if (wr == 0) PG8_BAR;
        E(acc, cur, wr, wc, fr, fq); S.done(cur);
        if (!has_next) break;
#pragma unroll
        for (int a = 0; a < 2; ++a)
#pragma unroll
            for (int b = 0; b < 2; ++b)
#pragma unroll
                for (int m = 0; m < 4; ++m)
#pragma unroll
                    for (int n = 0; n < 2; ++n) acc[a][b][m][n] = (f32x4){0.f, 0.f, 0.f, 0.f};
        cur = nxt; cA = nA; cB = nB; ++ui;
        if (wr == 1) PG8_BAR;
    }
    PG8_WAIT_V(0);
    PG8_BAR;
#undef PG8_SA
#undef PG8_SB
#undef PG8_STAGE
#undef PG8_LDA
#undef PG8_LDB
#undef PG8_MMA
#undef PG8_WAIT_V
#undef PG8_WAIT_L
#undef PG8_BAR
#undef PG8_SCHED
}
__device__ __forceinline__ float row_rt(const float* ssq, const float* ssqs, int row) {
    float s;
    if (row < MP) { const f32x4* sp = (const f32x4*)(ssq + (size_t)row * 16); const f32x4 s0 = sp[0], s1 = sp[1], s2 = sp[2], s3 = sp[3];
        s = ((s0[0] + s0[1]) + (s0[2] + s0[3])) + ((s1[0] + s1[1]) + (s1[2] + s1[3])) + ((s2[0] + s2[1]) + (s2[2] + s2[3])) + ((s3[0] + s3[1]) + (s3[2] + s3[3])); }
    else { const f32x4* sp = (const f32x4*)(ssqs + (size_t)(row - MP) * 32); s = 0.f;
#pragma unroll
        for (int i = 0; i < 8; ++i) { const f32x4 v = sp[i]; s += (v[0] + v[1]) + (v[2] + v[3]); } }
    return 1.0f / sqrtf(s * (1.0f / DM) + EPS);
}
typedef f32x4 Acc[2][2][4][2];

struct EpiGU {
    static constexpr bool PERM = true, HAS_MID = false;
    bf16_t* ACT; const float* ssq; const float* shiftW; int ldsw; const float* ssqs;
    __device__ __forceinline__ void operator()(const Acc& acc, const Unit& u, int wr, int wc, int fr, int fq) const {
        const int cl = wc * 32 + 8 * fq;
#pragma unroll
        for (int ai = 0; ai < 2; ++ai)
#pragma unroll
            for (int m = 0; m < 4; ++m) {
                const int row = u.pm * BM + ai * HALF + wr * 64 + m * 16 + fr;
                float rt = 1.f; f32x4 sg[2], sv[2]; sg[0] = sg[1] = sv[0] = sv[1] = (f32x4){0.f, 0.f, 0.f, 0.f};
                if (ssq) {
                    rt = row_rt(ssq, ssqs, row);
                    const float* sw = shiftW + (size_t)bidx_of_row(row) * ldsw + u.pn * BM + cl;
                    sg[0] = *(const f32x4*)(sw); sg[1] = *(const f32x4*)(sw + 4); sv[0] = *(const f32x4*)(sw + HALF); sv[1] = *(const f32x4*)(sw + HALF + 4);
                }
                u32x4 w;
#pragma unroll
                for (int n = 0; n < 2; ++n) {
                    const f32x4 gv = acc[ai][0][m][n] * rt + sg[n], vv = acc[ai][1][m][n] * rt + sv[n];
                    const float a0 = siluf_(gv[0]) * vv[0], a1 = siluf_(gv[1]) * vv[1], a2 = siluf_(gv[2]) * vv[2], a3 = siluf_(gv[3]) * vv[3];
                    w[2 * n] = pk2(a0, a1); w[2 * n + 1] = pk2(a2, a3);
                }
                *(u32x4*)(ACT + (size_t)row * DFF + u.pn * HALF + cl) = w;
            }
    }
};
template <bool HAS_A> struct EpiRes {
    static constexpr bool PERM = false, HAS_MID = false;
    const float* res_p; const float* res_s;
    float* out_p; float* out_s;
    const float* modv; int gsub;
    bf16_t* Aout; const float* gnorm; int ssub;
    float* ssq;
    float* ssqs;
    float gfac;
    template <int NQ> __device__ __forceinline__ float rowq(int row, int pn, int cb, const f32x4 q00, const f32x4 q01, const f32x4 q10, const f32x4 q11) const {
        const bool live = row < MTOT;
        const int bi = bidx_of_row(row);
        const float* rp = row < MP ? res_p + (size_t)row * DM : res_s + (size_t)(live ? row - MP : 0) * DM;
        float* op = row < MP ? out_p + (size_t)row * DM : out_s + (size_t)(live ? row - MP : 0) * DM;
        const float* gp = modp(modv, bi, gsub, 2); const float* scp = modp(modv, bi, ssub, 1);
        const float gf = gfac; bf16_t* const ao = Aout; const float* const gnp = gnorm;
        float sq = 0.f;
#pragma unroll
        for (int bj = 0; bj < 2; ++bj)
#pragma unroll
            for (int n = 0; n < NQ; ++n) {
                const int c = pn * BM + bj * HALF + cb + n * 16;
                const f32x4 r4 = *(const f32x4*)(rp + c), g4 = *(const f32x4*)(gp + c);
                const f32x4 qv = bj == 0 ? (n == 0 ? q00 : q01) : (n == 0 ? q10 : q11);
                const f32x4 h = r4 + (g4 * gf) * qv;
                if (live) *(f32x4*)(op + c) = h;
                sq += (h[0] * h[0] + h[1] * h[1]) + (h[2] * h[2] + h[3] * h[3]);
                if constexpr (HAS_A) { const f32x4 gn = *(const f32x4*)(gnp + c), sc = *(const f32x4*)(scp + c); const f32x4 a = h * gn * (sc + 1.0f);
                    u32x2 w; w.x = pk2(a[0], a[1]); w.y = pk2(a[2], a[3]); if (live) *(u32x2*)(ao + (size_t)row * DM + c) = w; }
            }
        return sq;
    }
    __device__ __forceinline__ void operator()(const Acc& acc, const Unit& u, int wr, int wc, int fr, int fq) const {
#pragma unroll
        for (int ai = 0; ai < 2; ++ai)
#pragma unroll
            for (int m = 0; m < 4; ++m) {
                const int row = u.pm * BM + ai * HALF + wr * 64 + m * 16 + fr;
                float sq = rowq<2>(row, u.pn, wc * 32 + 4 * fq, acc[ai][0][m][0], acc[ai][0][m][1], acc[ai][1][m][0], acc[ai][1][m][1]);
                if (ssq) { sq += __shfl_xor(sq, 16); sq += __shfl_xor(sq, 32); if (fq == 0) ssq[(size_t)row * 16 + u.pn * 4 + wc] = sq; }
            }
    }
    __device__ __forceinline__ void thin(int row, int pn, int h, int t, int fq, const f32x4 (&q)[2][1]) const {
        float sq = rowq<1>(row, pn, h * 64 + t * 16 + 4 * fq, q[0][0], q[0][0], q[1][0], q[1][0]);
        if (ssqs) { sq += __shfl_xor(sq, 16); sq += __shfl_xor(sq, 32); if (fq == 0) ssqs[(size_t)(row - MP) * 32 + (pn * 2 + h) * 4 + t] = sq; }
    }
};
struct EpiStoreBf16 {
    static constexpr bool PERM = true, HAS_MID = false;
    bf16_t* O; int ldc;
    __device__ __forceinline__ void operator()(const Acc& acc, const Unit& u, int wr, int wc, int fr, int fq) const {
#pragma unroll
        for (int ai = 0; ai < 2; ++ai)
#pragma unroll
            for (int m = 0; m < 4; ++m) { const int row = u.pm * BM + ai * HALF + wr * 64 + m * 16 + fr;
#pragma unroll
                for (int bj = 0; bj < 2; ++bj) { const f32x4 v0 = acc[ai][bj][m][0], v1 = acc[ai][bj][m][1]; u32x4 w; w.x = pk2(v0[0], v0[1]); w.y = pk2(v0[2], v0[3]); w.z = pk2(v1[0], v1[1]); w.w = pk2(v1[2], v1[3]);
                    *(u32x4*)(O + (size_t)row * ldc + u.pn * BM + bj * HALF + wc * 32 + 8 * fq) = w; } }
    }
};
}

#define XB_TMO      128
#define XB_XCNT(j)  (256  + 64 * (j))
#define XB_XSUB(j)  (1280 + 64 * (j))
#define XB_XGEN(j)  (2304 + 64 * (j))
#define XB_TOP      3328
#define XB_TOPGEN   3392
#define XCD_BAR_WORDS 3456
#define XB_SPIN_CAP (1u << 18)
__device__ __forceinline__ unsigned xb_ld(unsigned* p)              { return __hip_atomic_load(p, __ATOMIC_RELAXED, __HIP_MEMORY_SCOPE_AGENT); }
__device__ __forceinline__ unsigned xb_add(unsigned* p, unsigned v) { return __hip_atomic_fetch_add(p, v, __ATOMIC_RELAXED, __HIP_MEMORY_SCOPE_AGENT); }
__device__ __forceinline__ unsigned xb_xcc_id() { return (unsigned)__builtin_amdgcn_s_getreg((3 << 11) | 20) & 0xFu; }
#define XB_SPIN(cond, bar) do { unsigned _sp = 0; while (cond) { __builtin_amdgcn_s_sleep(1); \
    if ((++_sp & 255u) == 0u) { if (xb_ld(&(bar)[XB_TMO])) break; if (_sp > XB_SPIN_CAP) { atomicAdd(&(bar)[XB_TMO], 1u); break; } } } } while (0)
struct XcdBarrier { unsigned* bar; unsigned x; volatile LAS unsigned* st; };
__device__ __forceinline__ XcdBarrier xcd_barrier_post(unsigned* bar, volatile LAS unsigned* st) {
    XcdBarrier b; b.bar = bar; b.x = xb_xcc_id(); b.st = st;
    if (threadIdx.x == 0) (void)xb_add(&bar[XB_XCNT(b.x)], 1u);
    return b;
}
__device__ __forceinline__ void xcd_barrier_complete(unsigned* bar, unsigned x, unsigned& nloc, unsigned& nx) {
    const unsigned G = gridDim.x * gridDim.y * gridDim.z;
    unsigned sum, cnt, mine, sp = 0u;
    for (;;) {
        sum = 0u; cnt = 0u; mine = 0u;
#pragma unroll
        for (unsigned j = 0; j < 16; ++j) { const unsigned c = xb_ld(&bar[XB_XCNT(j)]); sum += c; cnt += (c > 0u) ? 1u : 0u; mine = (j == x) ? c : mine; }
        if (sum == G) break;
        __builtin_amdgcn_s_sleep(1);
        if ((++sp & 255u) == 0u) { if (xb_ld(&bar[XB_TMO])) break; if (sp > XB_SPIN_CAP) { atomicAdd(&bar[XB_TMO], 1u); break; } }
    }
    nloc = mine > 0u ? mine : 1u; nx = cnt > 0u ? cnt : 1u;
}
__device__ __forceinline__ void xcd_barrier(const XcdBarrier& b) {
    asm volatile("s_waitcnt vmcnt(0)" ::: "memory");
    __syncthreads();
    if (threadIdx.x == 0) {
        unsigned* bar = b.bar;
        __builtin_amdgcn_s_waitcnt(0);
        unsigned nloc = b.st[0], nx = b.st[1];
        if (nloc == 0u) { xcd_barrier_complete(bar, b.x, nloc, nx); b.st[0] = nloc; b.st[1] = nx; }
        const unsigned old = xb_add(&bar[XB_XSUB(b.x)], 1u);
        const unsigned gen = old / nloc;
        if (old + 1u == (gen + 1u) * nloc) {
            __builtin_amdgcn_fence(__ATOMIC_RELEASE, "agent");
            asm volatile("s_waitcnt vmcnt(0)" ::: "memory");
            const unsigned og = xb_add(&bar[XB_TOP], 1u);
            const unsigned tg = og / nx;
            if (og + 1u == (tg + 1u) * nx) xb_add(&bar[XB_TOPGEN], 1u);
            else XB_SPIN(xb_ld(&bar[XB_TOPGEN]) == tg, bar);
            __builtin_amdgcn_fence(__ATOMIC_ACQUIRE, "agent");
            xb_add(&bar[XB_XGEN(b.x)], 1u);
            asm volatile("s_waitcnt vmcnt(0)" ::: "memory");
        } else {
            XB_SPIN(xb_ld(&bar[XB_XGEN(b.x)]) == gen, bar);
            __builtin_amdgcn_fence(__ATOMIC_ACQUIRE, "agent");
            asm volatile("s_waitcnt vmcnt(0)" ::: "memory");
        }
    }
    __syncthreads();
}

constexpr int NWAVES = 8, NTHR = 512;
constexpr int RING_BYTES = 131072, LDSCTL_OFF = RING_BYTES, MISC_OFF = LDSCTL_OFF + 320, LDS_BYTES = 147456;
#define LDS_WAIT() asm volatile("s_waitcnt lgkmcnt(0)" ::: "memory")

struct Args {
    const float* in[26]; float* out; unsigned char* ws; int ph_lo, ph_hi, li, pad;
};
struct Ctx {
    LAS unsigned char* lds; int tid, lane, wave, vcu, G, gw, NGW;
};

__device__ __forceinline__ void ada_item(const Ctx& X, int it, const float* cp, const float* cs, const float* w_ada, const float* b_ada, float* modv) {
    const int j0 = it * 64, w = X.wave, lane = X.lane, kr = lane >> 4, c4 = lane & 15;
    LAS float* sl = (LAS float*)X.lds + w * (18 * 128);
    LAS float* part = (LAS float*)(X.lds + 73728);
    for (int rh = 0; rh < 2; ++rh) {
        for (int idx = lane; idx < 18 * 128; idx += 64) { const int r = rh * 18 + idx / 128, kk = idx % 128, k = w * 128 + kk;
            const float cv = r < NBP ? cp[r * DM + k] : cs[(r - NBP) * DM + k]; sl[idx] = cv / (1.0f + __expf(-cv)); }
        LDS_WAIT(); __syncthreads();
        f32x4 acc[18];
#pragma unroll
        for (int r = 0; r < 18; ++r) acc[r] = (f32x4){0.f, 0.f, 0.f, 0.f};
        const float* wp = w_ada + (size_t)(w * 128 + kr) * NMOD + j0 + 4 * c4;
#pragma unroll 8
        for (int i = 0; i < 32; ++i) { const f32x4 wv = *(const f32x4*)(wp + (size_t)(4 * i) * NMOD);
#pragma unroll
            for (int r = 0; r < 18; ++r) acc[r] += wv * sl[r * 128 + 4 * i + kr]; }
#pragma unroll
        for (int r = 0; r < 18; ++r) {
#pragma unroll
            for (int e = 0; e < 4; ++e) { float v = acc[r][e]; v += __shfl_xor(v, 16); v += __shfl_xor(v, 32); acc[r][e] = v; }
            if (kr == 0) *(LAS f32x4*)(part + (w * 18 + r) * 64 + 4 * c4) = acc[r]; }
        LDS_WAIT(); __syncthreads();
        for (int o = X.tid; o < 18 * 64; o += NTHR) { const int r = o / 64, j = o % 64; float sum = b_ada[j0 + j];
#pragma unroll
            for (int ww = 0; ww < 8; ++ww) sum += part[(ww * 18 + r) * 64 + j];
            modv[(size_t)(rh * 18 + r) * NMOD + j0 + j] = sum; }
        __syncthreads();
    }
}
struct TJ { int src, srcoff_stride, N, K, col0, col_stride, ncols, dst, dpitch, drow0, drow_stride, dcol0, rep; };
__constant__ TJ kJobs[] = {
    {12, 0, NGU, DM, 0,    128, 128, 0, DM, 0,   256, 0, 22},
    {12, 0, NGU, DM, DFF,  128, 128, 0, DM, 128, 256, 0, 22},
    {13, 0, DM, DFF, 0, 0, DM, 1, DFF, 0, 0, 0, 1},
    {16, 0, INW, DM, 0,    0, 1280, 2, DM, 0, 0, 0, 1},
    {16, 0, INW, DM, 1304, 128, 128, 2, DM, 1280, 256, 0, 4},
    {16, 0, INW, DM, 2328, 128, 128, 2, DM, 1408, 256, 0, 4},
    {16, 0, INW, DM, 1816, 0, 512, 2, DM, 2304, 0, 0, 1},
    {16, 0, INW, DM, 2840, 128, 128, 2, DM, 2816, 256, 0, 8},
    {16, 0, INW, DM, 3864, 128, 128, 2, DM, 2944, 256, 0, 8},
    {16, 0, INW, DM, 1280, 0, 24, 2, DM, 4864, 0, 0, 1},
    {21, 0, DM, 512, 0, 0, DM, 3, DM, 0, 0, 0, 1},
    {22, 0, DM, 512, 0, 0, DM, 3, DM, 0, 0, 512, 1},
    {23, 0, DM, DM, 0, 0, DM, 4, DM, 0, 0, 0, 1},
    {14, 0, NGU, DM, 0,    128, 128, 5, DM, 0,   256, 0, 22},
    {14, 0, NGU, DM, DFF,  128, 128, 5, DM, 128, 256, 0, 22},
    {15, 0, DM, DFF, 0, 0, DM, 6, DFF, 0, 0, 0, 1},
    {17, 1024 * 128, 128, DM, 0, 0, 128, 7, DM, 0, 128, 0, 4},
};
constexpr int NJOBS = sizeof(kJobs) / sizeof(TJ);
__device__ __forceinline__ int tj_items(const TJ& j) { return j.rep * (j.K / 64) * ((j.ncols + 63) / 64); }
__device__ __forceinline__ void transpose_item(const float* W, int N, int ncols, bf16_t* WT, int dpitch, LAS float* scr, int kb, int nb, int lane) {
    const int k0 = 64 * kb, n0 = 64 * nb, kr = lane >> 4, c4 = lane & 15; const bool okc = (n0 + 4 * c4) < ncols;
    f32x4 v[16];
#pragma unroll
    for (int i = 0; i < 16; ++i) v[i] = okc ? *(const f32x4*)(W + (size_t)(k0 + 4 * i + kr) * N + n0 + 4 * c4) : (f32x4){0.f, 0.f, 0.f, 0.f};
#pragma unroll
    for (int i = 0; i < 16; ++i) { const int k = 4 * i + kr; *(LAS f32x4*)(scr + k * 64 + ((4 * c4 + 4 * (k >> 3)) & 63)) = v[i]; }
    LDS_WAIT(); asm volatile("" ::: "memory");
    const int c = lane & 7, nl = lane >> 3;
#pragma unroll
    for (int j = 0; j < 8; ++j) { const int n = nl + 8 * j; const LAS float* sp = scr + (8 * c) * 64 + ((n + 4 * c) & 63);
        u32x4 o; o.x = pk2(sp[0 * 64], sp[1 * 64]); o.y = pk2(sp[2 * 64], sp[3 * 64]); o.z = pk2(sp[4 * 64], sp[5 * 64]); o.w = pk2(sp[6 * 64], sp[7 * 64]);
        if (n0 + n < ncols) *(u32x4*)(WT + (size_t)(n0 + n) * dpitch + k0 + 8 * c) = o; }
    LDS_WAIT(); asm volatile("" ::: "memory");
}
__device__ __forceinline__ bf16_t* wdst(unsigned char* ws, int id) {
    const size_t off = id == 0 ? WS_WGU1 : id == 1 ? WS_WD1 : id == 2 ? WS_WIN : id == 3 ? WS_WM : id == 4 ? WS_WO : id == 5 ? WS_WGU2 : id == 6 ? WS_WD2 : WS_WC1;
    return (bf16_t*)(ws + off);
}

struct EpiIn {
    static constexpr bool PERM = false, HAS_MID = false;
    const float* ssq; const float* ssqs; const float* shiftW; float* out; unsigned char* ws;
    template <int CASE, int NQ> __device__ __forceinline__ void rowq(int row, int pn, int cb, const f32x4 (&q)[2][NQ]) const {
        using namespace pg8;
        const bool live = row < MTOT, isp = row < MP;
        const float rt = row_rt(ssq, ssqs, row);
        const float* sw = shiftW + (size_t)bidx_of_row(row) * INWP + pn * BM + cb;
        const int b = isp ? (row >> 12) : ((row - MP) >> 2), t = isp ? (row & (TP - 1)) : ((row - MP) & 3);
#define PV(bj, n) (q[bj][n] * rt + *(const f32x4*)(sw + (bj) * HALF + (n) * 16))
        if constexpr (CASE == 0) {
            bf16_t* Q = (bf16_t*)(ws + WS_Q) + (size_t)row * 512 + pn * BM + cb;
#pragma unroll
            for (int bj = 0; bj < 2; ++bj)
#pragma unroll
                for (int n = 0; n < NQ; ++n) { const f32x4 v = PV(bj, n) * QSCALE; u32x2 w; w.x = pk2(v[0], v[1]); w.y = pk2(v[2], v[3]); *(u32x2*)(Q + bj * HALF + n * 16) = w; }
        } else if constexpr (CASE >= 1 && CASE <= 3) {
            const size_t obase = CASE == 1 ? (isp ? O_KVC_P + (size_t)row * 256 : O_KVC_S + (size_t)(row - MP) * 256)
                               : CASE == 2 ? (isp ? O_KVS_P + (size_t)row * 256 : O_KVS_S + (size_t)(row - MP) * 256)
                               : (isp ? O_KVW_P + ((size_t)b * 512 + (t - (TP - 512))) * 256 : O_KVW_S + ((size_t)b * 512 + 508 + t) * 256);
            const bool wout = live && (CASE != 3 || !isp || t >= TP - 512);
#pragma unroll
            for (int bj = 0; bj < 2; ++bj)
#pragma unroll
                for (int n = 0; n < NQ; ++n) { const int j = bj * HALF + cb + n * 16; const f32x4 v = PV(bj, n);
                    if (wout) *(f32x4*)(out + obase + j) = v;
                    if (isp) { const int gg = (j >> 6) & 1, d = j & 63; u32x2 w; w.x = pk2(v[0], v[1]); w.y = pk2(v[2], v[3]);
                        if constexpr (CASE == 1) *(u32x2*)((bf16_t*)(ws + WS_ACP) + ((size_t)(bj * 8 + b * 2 + gg) * 256 + (t >> 4)) * 1024 + (t & 15) * 64 + d) = w;
                        else *(u32x2*)((bf16_t*)(ws + (CASE == 2 ? (bj ? WS_VS : WS_KS) : (bj ? WS_VW : WS_KW))) + ((size_t)(b * 2 + gg) * TP + t) * 64 + d) = w; } }
        } else if constexpr (CASE == 4) {
            const bool wout = live && (isp ? t >= TP - 2 : t >= 2);
            const size_t obase = isp ? O_CONV_P + ((size_t)b * 2 + (t - (TP - 2))) * 512 : O_CONV_S + ((size_t)b * 2 + (t - 2)) * 512;
#pragma unroll
            for (int n = 0; n < NQ; ++n) { const int j = (pn - 5) * HALF + cb + n * 16; const f32x4 v = PV(0, n) * PV(1, n);
                u32x2 w; w.x = pk2(v[0], v[1]); w.y = pk2(v[2], v[3]); *(u32x2*)((bf16_t*)(ws + WS_PROD) + (size_t)row * 512 + j) = w;
                if (wout) *(f32x4*)(out + obase + j) = v; }
        } else if constexpr (CASE == 5) {
#pragma unroll
            for (int bj = 0; bj < 2; ++bj)
#pragma unroll
                for (int n = 0; n < NQ; ++n) { const int j = (pn - 9) * BM + bj * HALF + cb + n * 16; const f32x4 v = PV(bj, n);
                    u32x2 w; w.x = pk2(v[0], v[1]); w.y = pk2(v[2], v[3]); *(u32x2*)((bf16_t*)(ws + WS_CB) + (size_t)row * 512 + j) = w; }
        } else if constexpr (CASE == 6) {
#pragma unroll
            for (int n = 0; n < NQ; ++n) { const int j = (pn - 11) * HALF + cb + n * 16; const f32x4 a = PV(0, n), bb = PV(1, n);
                float ra[4], gb[4];
#pragma unroll
                for (int e = 0; e < 4; ++e) { const float sa = sigmoidf_(a[e]), sb = sigmoidf_(bb[e]); gb[e] = sb; ra[e] = sa / sb; }
                u32x2 w; w.x = pk2(ra[0], ra[1]); w.y = pk2(ra[2], ra[3]); *(u32x2*)((bf16_t*)(ws + WS_RATIO) + (size_t)row * DM + j) = w;
                u32x2 w2; w2.x = pk2(gb[0], gb[1]); w2.y = pk2(gb[2], gb[3]); *(u32x2*)((bf16_t*)(ws + WS_GB) + (size_t)row * DM + j) = w2; }
        } else {
#pragma unroll
            for (int n = 0; n < NQ; ++n) { const int j = cb + n * 16; if (j < 24) { const f32x4 v = PV(0, n);
#pragma unroll
                for (int e = 0; e < 4; ++e) if (j + e < 24) ((float*)(ws + WS_GATES))[(size_t)row * 24 + j + e] = sigmoidf_(v[e]); } }
        }
#undef PV
    }
    template <int CASE> __device__ __forceinline__ void body(const pg8::Acc& acc, const pg8::Unit& u, int wr, int wc, int fr, int fq) const {
        using namespace pg8;
#pragma unroll
        for (int ai = 0; ai < 2; ++ai)
#pragma unroll
            for (int m = 0; m < 4; ++m) {
                const int row = u.pm * BM + ai * HALF + wr * 64 + m * 16 + fr;
                const f32x4 q[2][2] = {{acc[ai][0][m][0], acc[ai][0][m][1]}, {acc[ai][1][m][0], acc[ai][1][m][1]}};
                rowq<CASE, 2>(row, u.pn, wc * 32 + 4 * fq, q);
                asm volatile("" ::: "memory");
            }
    }
    __device__ __forceinline__ static int case_of(int pn) { return pn < 2 ? 0 : pn == 2 ? 1 : pn == 3 ? 2 : pn == 4 ? 3 : pn < 9 ? 4 : pn < 11 ? 5 : pn < 19 ? 6 : 7; }
    __device__ __forceinline__ void operator()(const pg8::Acc& acc, const pg8::Unit& u, int wr, int wc, int fr, int fq) const {
        const int cs = case_of(u.pn);
        if (cs == 0) body<0>(acc, u, wr, wc, fr, fq); else if (cs == 1) body<1>(acc, u, wr, wc, fr, fq); else if (cs == 2) body<2>(acc, u, wr, wc, fr, fq); else if (cs == 3) body<3>(acc, u, wr, wc, fr, fq);
        else if (cs == 4) body<4>(acc, u, wr, wc, fr, fq); else if (cs == 5) body<5>(acc, u, wr, wc, fr, fq); else if (cs == 6) body<6>(acc, u, wr, wc, fr, fq); else body<7>(acc, u, wr, wc, fr, fq);
    }
    __device__ __forceinline__ void thin(int row, int pn, int h, int t, int fq, const f32x4 (&q)[2][1]) const {
        const int cs = case_of(pn), cb = h * 64 + t * 16 + 4 * fq;
        if (cs == 0) rowq<0, 1>(row, pn, cb, q); else if (cs == 1) rowq<1, 1>(row, pn, cb, q); else if (cs == 2) rowq<2, 1>(row, pn, cb, q); else if (cs == 3) rowq<3, 1>(row, pn, cb, q);
        else if (cs == 4) rowq<4, 1>(row, pn, cb, q); else if (cs == 5) rowq<5, 1>(row, pn, cb, q); else if (cs == 6) rowq<6, 1>(row, pn, cb, q); else rowq<7, 1>(row, pn, cb, q);
    }
};

struct EpiMerge {
    static constexpr bool PERM = true, HAS_MID = true;
    int mid_t; const bf16_t* RAT; const bf16_t* GB; bf16_t* MERGED;
    __device__ __forceinline__ void mid(pg8::Acc& acc, const pg8::Unit& u, int wr, int wc, int fr, int fq) const {
        using namespace pg8;
        asm volatile("" : "+v"(fr), "+v"(fq));
#pragma unroll
        for (int ai = 0; ai < 2; ++ai)
#pragma unroll
            for (int m = 0; m < 4; ++m) { const int row = u.pm * BM + ai * HALF + wr * 64 + m * 16 + fr;
#pragma unroll
                for (int bj = 0; bj < 2; ++bj) { const u32x4 r = *(const u32x4*)(RAT + (size_t)row * DM + u.pn * BM + bj * HALF + wc * 32 + 8 * fq);
                    acc[ai][bj][m][0] *= (f32x4){bflo(r.x), bfhi(r.x), bflo(r.y), bfhi(r.y)}; acc[ai][bj][m][1] *= (f32x4){bflo(r.z), bfhi(r.z), bflo(r.w), bfhi(r.w)}; }
                asm volatile("" ::: "memory"); }
    }
    __device__ __forceinline__ void thin_mid(int row, int pn, int h, int t, int fq, f32x4 (&q)[2][1]) const {
#pragma unroll
        for (int bj = 0; bj < 2; ++bj) { const u32x2 r = *(const u32x2*)(RAT + (size_t)row * DM + pn * pg8::BM + bj * pg8::HALF + h * 64 + t * 16 + 4 * fq); q[bj][0] *= (f32x4){bflo(r.x), bfhi(r.x), bflo(r.y), bfhi(r.y)}; }
    }
    __device__ __forceinline__ void thin(int row, int pn, int h, int t, int fq, const f32x4 (&q)[2][1]) const {
#pragma unroll
        for (int bj = 0; bj < 2; ++bj) { const size_t off = (size_t)row * DM + pn * pg8::BM + bj * pg8::HALF + h * 64 + t * 16 + 4 * fq; const u32x2 r = *(const u32x2*)(GB + off);
            const f32x4 v = q[bj][0] * (f32x4){bflo(r.x), bfhi(r.x), bflo(r.y), bfhi(r.y)}; u32x2 w; w.x = pk2(v[0], v[1]); w.y = pk2(v[2], v[3]); *(u32x2*)(MERGED + off) = w; }
    }
    __device__ __forceinline__ void operator()(const pg8::Acc& acc, const pg8::Unit& u, int wr, int wc, int fr, int fq) const {
        using namespace pg8;
#pragma unroll
        for (int ai = 0; ai < 2; ++ai)
#pragma unroll
            for (int m = 0; m < 4; ++m) { const int row = u.pm * BM + ai * HALF + wr * 64 + m * 16 + fr;
#pragma unroll
                for (int bj = 0; bj < 2; ++bj) { const size_t off = (size_t)row * DM + u.pn * BM + bj * HALF + wc * 32 + 8 * fq; const u32x4 r = *(const u32x4*)(GB + off);
                    const f32x4 v0 = acc[ai][bj][m][0] * (f32x4){bflo(r.x), bfhi(r.x), bflo(r.y), bfhi(r.y)}, v1 = acc[ai][bj][m][1] * (f32x4){bflo(r.z), bfhi(r.z), bflo(r.w), bfhi(r.w)};
                    u32x4 w; w.x = pk2(v0[0], v0[1]); w.y = pk2(v0[2], v0[3]); w.z = pk2(v1[0], v1[1]); w.w = pk2(v1[2], v1[3]); *(u32x4*)(MERGED + off) = w; }
                asm volatile("" ::: "memory"); }
    }
};

__device__ __forceinline__ float gelu_tanh(float x) { const float u = 0.7978845608028654f * (x + 0.044715f * x * x * x); const float e = fast_exp2(2.0f * LOG2E * u); return 0.5f * x * (2.0f - 2.0f * fast_rcp(1.0f + e)); }
template <bool SAMPLE> __device__ __forceinline__ void cmp_tail_item(const Ctx& X, int item, unsigned char* ws, const float* w_cmp2) {
    constexpr int NR = SAMPLE ? 512 : 256, NCH = NR / 64, NBG = SAMPLE ? 64 : 8, NVALID = NR - 1;
    const int c = item / (NBG * NCH), bg = (item / NCH) % NBG, n0 = (item % NCH) * 64;
    LAS float* w2s = (LAS float*)X.lds; LAS float* hid = (LAS float*)(X.lds + 32768);
    const float* w2 = w_cmp2 + (size_t)c * 128 * 64; const float* pet = (const float*)(ws + WS_PETERM) + c * 128;
    const bf16_t* P = (const bf16_t*)(ws + (SAMPLE ? WS_PCS : WS_PCP)) + (size_t)c * (NBG * NR) * 256;
    for (int i = X.tid; i < 128 * 64 / 4; i += NTHR) ((LAS f32x4*)w2s)[i] = ((const f32x4*)w2)[i];
    for (int idx = X.tid; idx < 64 * 128; idx += NTHR) { const int r = idx >> 7, e = idx & 127; const size_t base = (size_t)(bg * NR + n0 + r) * 256;
        const float v = bf2f(P[base + e]) + bf2f(P[base + 256 + 128 + e]) + pet[e]; hid[r * 129 + e] = gelu_tanh(v); }
    LDS_WAIT(); __syncthreads();
    const int r = X.tid >> 3, d0 = (X.tid & 7) * 8, n = n0 + r;
    float acc[8];
#pragma unroll
    for (int i = 0; i < 8; ++i) acc[i] = 0.f;
#pragma unroll 4
    for (int e = 0; e < 128; ++e) { const float h = hid[r * 129 + e]; const f32x4 wa = *(const LAS f32x4*)(w2s + e * 64 + d0), wb = *(const LAS f32x4*)(w2s + e * 64 + d0 + 4);
        acc[0] += h * wa[0]; acc[1] += h * wa[1]; acc[2] += h * wa[2]; acc[3] += h * wa[3]; acc[4] += h * wb[0]; acc[5] += h * wb[1]; acc[6] += h * wb[2]; acc[7] += h * wb[3]; }
    if constexpr (SAMPLE) {
        if (n < NVALID) { float* o = (float*)(ws + WS_KVCS) + (((size_t)bg * 512 + n) * 2 + c) * 64 + d0; *(f32x4*)o = (f32x4){acc[0], acc[1], acc[2], acc[3]}; *(f32x4*)(o + 4) = (f32x4){acc[4], acc[5], acc[6], acc[7]}; }
    } else {
        u32x4 w; if (n < NVALID) { w.x = pk2(acc[0], acc[1]); w.y = pk2(acc[2], acc[3]); w.z = pk2(acc[4], acc[5]); w.w = pk2(acc[6], acc[7]); } else w = (u32x4){0u, 0u, 0u, 0u};
        *(u32x4*)((bf16_t*)(ws + (c ? WS_VCP : WS_KCP)) + ((size_t)bg * 256 + n) * 64 + d0) = w;
    }
    __syncthreads();
}

namespace att {
typedef float f32x16 __attribute__((ext_vector_type(16)));
typedef short s16x4 __attribute__((ext_vector_type(4)));
typedef float f32x2_t __attribute__((ext_vector_type(2))); typedef __bf16 bf16x2_t __attribute__((ext_vector_type(2)));
constexpr int L_K = 0, L_V = 16384, L_WSF = 32768, L_BIAS = 36864, L_GATE = 38912, L_SEL = 41984, L_ANY = 42496, L_PSUM = 43008, L_SC = 108800, L_OST = 43008, PS_LD = 257, SC_LD = 65;
static_assert(L_SC + 64 * SC_LD * 4 <= RING_BYTES, "attention LDS map");
__constant__ unsigned char kBucket[128] = {0, 1, 2, 3, 4, 5, 6, 7, 8, 9, 10, 11, 12, 13, 14, 15, 16, 16, 16, 17, 17, 18, 18, 18, 19, 19, 19, 20, 20, 20, 20, 21, 21, 21, 21, 22, 22, 22, 22, 22, 23, 23, 23, 23, 23, 23, 24, 24, 24, 24, 24, 24, 25, 25, 25, 25, 25, 25, 25, 26, 26, 26, 26, 26, 26, 26, 26, 27, 27, 27, 27, 27, 27, 27, 27, 27, 27, 28, 28, 28, 28, 28, 28, 28, 28, 28, 28, 29, 29, 29, 29, 29, 29, 29, 29, 29, 29, 29, 29, 30, 30, 30, 30, 30, 30, 30, 30, 30, 30, 30, 30, 30, 30, 31, 31, 31, 31, 31, 31, 31, 31, 31, 31, 31, 31, 31, 31, 31};
__device__ __forceinline__ int crow(int r, int hi) { return (r & 3) + 8 * (r >> 2) + 4 * hi; }
__device__ __forceinline__ unsigned cvtpk_s(float lo, float hi) { f32x2_t v = {lo, hi}; bf16x2_t b = __builtin_convertvector(v, bf16x2_t); return __builtin_bit_cast(unsigned, b); }
#define ATT_SBAR() __builtin_amdgcn_sched_barrier(0)
__device__ __forceinline__ void qkt(f32x16& p0, f32x16& p1, const LAS unsigned char* Kslot, const bf16x8* qr, int r32, int hi) {
    const LAS unsigned char* kb = Kslot + hi * 1024 + r32 * 16;
    f32x16 z;
#pragma unroll
    for (int r = 0; r < 16; ++r) z[r] = 0.f;
    p0 = z; p1 = z;
#pragma unroll
    for (int d0 = 0; d0 < 4; ++d0) {
        const bf16x8 b0 = *(const LAS bf16x8*)(kb + d0 * 2048), b1 = *(const LAS bf16x8*)(kb + d0 * 2048 + 512);
        p0 = __builtin_amdgcn_mfma_f32_32x32x16_bf16(b0, qr[d0], p0, 0, 0, 0); p1 = __builtin_amdgcn_mfma_f32_32x32x16_bf16(b1, qr[d0], p1, 0, 0, 0); }
}
__device__ __forceinline__ float rowmax(const f32x16& p0, const f32x16& p1) {
    float a = fmaxf(p0[0], p1[0]);
#pragma unroll
    for (int r = 1; r < 16; ++r) a = fmaxf(a, fmaxf(p0[r], p1[r]));
    auto rr = __builtin_amdgcn_permlane32_swap(__float_as_uint(a), __float_as_uint(a), false, false);
    return fmaxf(__uint_as_float(rr[0]), __uint_as_float(rr[1]));
}
__device__ __forceinline__ float halfsum(float a) { auto rr = __builtin_amdgcn_permlane32_swap(__float_as_uint(a), __float_as_uint(a), false, false); return __uint_as_float(rr[0]) + __uint_as_float(rr[1]); }
__device__ __forceinline__ void pv(f32x16* o, int vb, bf16x8 pa0, bf16x8 pa1, bf16x8 pa2, bf16x8 pa3) {
#pragma unroll
    for (int d0 = 0; d0 < 2; ++d0) { s16x4 lo[4], hi[4];
#pragma unroll
        for (int ks = 0; ks < 4; ++ks) {
            asm volatile("ds_read_b64_tr_b16 %0,%1 offset:%c2" : "=&v"(lo[ks]) : "v"(vb), "i"(d0 * 4096 + ks * 1024) : "memory");
            asm volatile("ds_read_b64_tr_b16 %0,%1 offset:%c2" : "=&v"(hi[ks]) : "v"(vb), "i"(d0 * 4096 + ks * 1024 + 512) : "memory"); }
        asm volatile("s_waitcnt lgkmcnt(0)" ::: "memory"); ATT_SBAR();
#define ATT_PK(k) (bf16x8){lo[k][0], lo[k][1], lo[k][2], lo[k][3], hi[k][0], hi[k][1], hi[k][2], hi[k][3]}
        o[d0] = __builtin_amdgcn_mfma_f32_32x32x16_bf16(pa0, ATT_PK(0), o[d0], 0, 0, 0);
        o[d0] = __builtin_amdgcn_mfma_f32_32x32x16_bf16(pa1, ATT_PK(1), o[d0], 0, 0, 0);
        o[d0] = __builtin_amdgcn_mfma_f32_32x32x16_bf16(pa2, ATT_PK(2), o[d0], 0, 0, 0);
        o[d0] = __builtin_amdgcn_mfma_f32_32x32x16_bf16(pa3, ATT_PK(3), o[d0], 0, 0, 0);
#undef ATT_PK
    }
}
struct KVRegs { u32x4 k, v; };
__device__ __forceinline__ void stage_load(KVRegs& R, const bf16_t* Kg, const bf16_t* Vg, int tid) { const int off = (tid >> 3) * 64 + (tid & 7) * 8; R.k = *(const u32x4*)(Kg + off); R.v = *(const u32x4*)(Vg + off); }
__device__ __forceinline__ void stage_store(const KVRegs& R, LAS unsigned char* lds, int slot, int tid) { const int key = tid >> 3, ch = tid & 7;
    *(LAS u32x4*)(lds + L_K + slot * 8192 + ch * 1024 + key * 16) = R.k;
    *(LAS u32x4*)(lds + L_V + slot * 8192 + ((ch >> 2) * 4 + (key >> 4)) * 1024 + (key & 15) * 64 + (ch & 3) * 16) = R.v; }
struct SM { float m, l; f32x16 o[2]; };
__device__ __forceinline__ void sm_init(SM& s) { s.m = -1e30f; s.l = 0.f;
#pragma unroll
    for (int r = 0; r < 16; ++r) { s.o[0][r] = 0.f; s.o[1][r] = 0.f; } }
template <bool WITH_O> __device__ __forceinline__ void sm_update(SM& s, f32x16& p0, f32x16& p1, LAS float* wsf, int r32, int hi) {
    const float rm = rowmax(p0, p1), mnew = fmaxf(s.m, rm);
    if (__any(mnew > s.m)) {
        const float alpha = fast_exp2(s.m - mnew); s.l *= alpha;
        if constexpr (WITH_O) { if (hi == 0) wsf[r32] = alpha; LDS_WAIT();
#pragma unroll
            for (int r = 0; r < 16; ++r) { const float f = wsf[crow(r, hi)]; s.o[0][r] *= f; s.o[1][r] *= f; }
            LDS_WAIT(); }
        s.m = mnew;
    }
    float sum = 0.f;
#pragma unroll
    for (int r = 0; r < 16; ++r) { p0[r] = fast_exp2(p0[r] - s.m); p1[r] = fast_exp2(p1[r] - s.m); sum += p0[r] + p1[r]; }
    s.l += sum;
}
template <int MODE> __device__ __forceinline__ void mask_bias(f32x16& p0, f32x16& p1, int T, bool far, bool lsel, int qpos, int hi, const LAS float* bT, float b31) {
    const float NEG = -INFINITY;
    if (MODE != 0 && far) {
#pragma unroll
        for (int r = 0; r < 16; ++r) { p0[r] = lsel ? p0[r] + b31 : NEG; p1[r] = lsel ? p1[r] + b31 : NEG; }
    } else {
        int base = MODE == 0 ? qpos - 1024 * T - 64 * hi - 31 : qpos - 64 * T - 4 * hi;
        asm volatile("" : "+v"(base));
#pragma unroll
        for (int r = 0; r < 16; ++r) { const int kk = (r & 3) + 8 * (r >> 2); int d0, d1; bool v0, v1;
            if (MODE == 0) { d0 = base - 16 * kk; d1 = d0 - 512; v0 = d0 >= 0; v1 = d1 >= 0; }
            else { d0 = base - kk; d1 = d0 - 32; if (MODE == 1) { v0 = lsel && d0 >= 0; v1 = lsel && d1 >= 0; } else { v0 = d0 >= 0 && d0 < 512; v1 = d1 >= 0 && d1 < 512; } }
            const float b0 = bT[min(max(d0, 0), 127)], b1 = bT[min(max(d1, 0), 127)];
            p0[r] = v0 ? p0[r] + b0 : NEG; p1[r] = v1 ? p1[r] + b1 : NEG; }
    }
}
#define ATT_PACK(pw, P, B) pw = (u32x4){cvtpk_s(P[B], P[B + 1]), cvtpk_s(P[B + 2], P[B + 3]), cvtpk_s(P[B + 4], P[B + 5]), cvtpk_s(P[B + 6], P[B + 7])}
#define ATT_PV(S_, SLOT) do { u32x4 pw0, pw1, pw2, pw3; ATT_PACK(pw0, p0, 0); ATT_PACK(pw1, p0, 8); ATT_PACK(pw2, p1, 0); ATT_PACK(pw3, p1, 8); ATT_SBAR(); \
    pv((S_).o, vb0 + (SLOT) * 8192, __builtin_bit_cast(bf16x8, pw0), __builtin_bit_cast(bf16x8, pw1), __builtin_bit_cast(bf16x8, pw2), __builtin_bit_cast(bf16x8, pw3)); } while (0)
#define ATT_TILE_LOOP(NT, FIRST, NEXTEXPR, KB, VB, BODY) do { int tcur_ = (FIRST); stage_load(R, (KB) + (size_t)tcur_ * 4096, (VB) + (size_t)tcur_ * 4096, tid); stage_store(R, lds, 0, tid); LDS_WAIT(); __syncthreads(); \
    for (int i_ = 0; i_ < (NT); ++i_) { const bool more_ = i_ + 1 < (NT); int tnext_ = tcur_; \
        if (more_) { tnext_ = (NEXTEXPR); stage_load(R, (KB) + (size_t)tnext_ * 4096, (VB) + (size_t)tnext_ * 4096, tid); } \
        { const int T = tcur_; const int SLOT = i_ & 1; BODY } \
        if (more_) stage_store(R, lds, (i_ + 1) & 1, tid); \
        LDS_WAIT(); __syncthreads(); tcur_ = tnext_; } } while (0)
#define ATT_FINISH(S_, BR) do { const float lt_ = halfsum((S_).l); const float inv_ = lt_ > 0.f ? 1.0f / lt_ : 0.f; \
    if (hi == 0) wsf[64 + r32] = inv_ * gt[qloc * 12 + (BR) * 4 + hh]; LDS_WAIT(); \
    _Pragma("unroll") for (int r = 0; r < 16; ++r) { const float f = wsf[64 + crow(r, hi)]; oacc[0][r] += (S_).o[0][r] * f; oacc[1][r] += (S_).o[1][r] * f; } LDS_WAIT(); asm volatile("" : "+v"(oacc[0]), "+v"(oacc[1])); } while (0)

__device__ __forceinline__ void prompt_item(const Ctx& X, int bg, int qt, unsigned char* ws, const float* rel_bias) {
    LAS unsigned char* lds = X.lds; int tid = X.tid; asm volatile("" : "+v"(tid));
    const int lane = tid & 63, wid = __builtin_amdgcn_readfirstlane(tid >> 6), r32 = lane & 31, hi = lane >> 5;
    const int b = bg >> 1, g = bg & 1, hh = wid >> 1, qh = wid & 1, q0 = qt * 64, qloc = qh * 32 + r32, qpos = q0 + qloc;
    LAS float* biasT = (LAS float*)(lds + L_BIAS); LAS float* gt = (LAS float*)(lds + L_GATE); LAS float* psum = (LAS float*)(lds + L_PSUM); LAS float* sc = (LAS float*)(lds + L_SC);
    LAS float* wsf = (LAS float*)(lds + L_WSF) + wid * 128;
    const float* GATES = (const float*)(ws + WS_GATES);
    biasT[tid] = rel_bias[(int)kBucket[tid & 127] * 8 + g * 4 + (tid >> 7)] * LOG2E;
    for (int i = tid; i < 64 * 12; i += NTHR) { const int q = i / 12, e = i % 12; gt[i] = GATES[((size_t)b * TP + q0 + q) * 24 + (e >> 2) * 8 + g * 4 + (e & 3)]; }
    for (int i = tid; i < 64 * PS_LD; i += NTHR) psum[i] = 0.f;
    if (tid < 2) ((LAS unsigned*)(lds + L_ANY))[tid] = 0u;
    bf16x8 qr[4];
    { const bf16_t* Qp = (const bf16_t*)(ws + WS_Q) + ((size_t)b * TP + qpos) * 512 + (g * 4 + hh) * 64 + hi * 8;
#pragma unroll
      for (int d0 = 0; d0 < 4; ++d0) qr[d0] = *(const bf16x8*)(Qp + d0 * 16); }
    LDS_WAIT(); __syncthreads();
    const LAS float* bT = biasT + hh * 128; const float b31 = bT[127];
    const int vb0 = (int)(unsigned)(uintptr_t)(lds + L_V) + ((lane >> 4) & 1) * 32 + (lane & 3) * 8 + (4 * hi + ((lane & 15) >> 2)) * 64;
    f32x16 oacc[2];
#pragma unroll
    for (int r = 0; r < 16; ++r) { oacc[0][r] = 0.f; oacc[1][r] = 0.f; }
    KVRegs R; f32x16 p0, p1;
    { const bf16_t* KC = (const bf16_t*)(ws + WS_KCP) + (size_t)bg * 256 * 64; const bf16_t* VC = (const bf16_t*)(ws + WS_VCP) + (size_t)bg * 256 * 64;
      const int ncv = min(4 * qt + 3, 255), ntc = (ncv + 63) >> 6;
      SM s; sm_init(s);
      ATT_TILE_LOOP(ntc, 0, tcur_ + 1, KC, VC, {
          qkt(p0, p1, lds + L_K + SLOT * 8192, qr, r32, hi); mask_bias<0>(p0, p1, T, false, true, qpos, hi, bT, b31); sm_update<false>(s, p0, p1, wsf, r32, hi); });
      const float ltot = halfsum(s.l), invl = ltot > 0.f ? 1.0f / ltot : 0.f; s.l = 0.f;
      ATT_TILE_LOOP(ntc, 0, tcur_ + 1, KC, VC, {
          qkt(p0, p1, lds + L_K + SLOT * 8192, qr, r32, hi); mask_bias<0>(p0, p1, T, false, true, qpos, hi, bT, b31);
          float sum = 0.f;
          _Pragma("unroll") for (int r = 0; r < 16; ++r) { p0[r] = fast_exp2(p0[r] - s.m); p1[r] = fast_exp2(p1[r] - s.m); sum += p0[r] + p1[r]; }
          s.l += sum;
          for (int rr = 0; rr < 4; ++rr) { if (hh == rr) { LAS float* pr = psum + qloc * PS_LD + 64 * T;
              _Pragma("unroll") for (int r = 0; r < 16; ++r) { pr[crow(r, hi)] += p0[r] * invl; pr[32 + crow(r, hi)] += p1[r] * invl; } }
              LDS_WAIT(); __syncthreads(); }
          ATT_PV(s, SLOT); });
      ATT_FINISH(s, 0);
    }
    { const int q = tid >> 3, jg = tid & 7; float myv[8];
#pragma unroll
      for (int i = 0; i < 8; ++i) { const int j = jg * 8 + i; const LAS float* pr = psum + q * PS_LD + 4 * j;
          const float v = 2.0f * (pr[0] + pr[1] + pr[2]) + pr[3] + (j > 0 ? pr[-1] : 0.f);
          const bool valid = j <= qt, forced = (j == 0) || (j == qt) || (j == qt - 1);
          const float sv = valid ? v + (forced ? 1000.0f : 0.f) : -1e9f; myv[i] = sv; sc[q * SC_LD + j] = sv; }
      LDS_WAIT(); __syncthreads();
      int cnt[8];
#pragma unroll
      for (int i = 0; i < 8; ++i) cnt[i] = 0;
      for (int k = 0; k < 64; ++k) { const float v = sc[q * SC_LD + k];
#pragma unroll
          for (int i = 0; i < 8; ++i) cnt[i] += ((v > myv[i]) || (v == myv[i] && k < jg * 8 + i)) ? 1 : 0; }
      unsigned bits = 0u;
#pragma unroll
      for (int i = 0; i < 8; ++i) if (cnt[i] < 16 && jg * 8 + i <= qt) bits |= 1u << i;
      ((LAS unsigned char*)(lds + L_SEL))[q * 8 + jg] = (unsigned char)bits;
      atomicOr((unsigned*)((LAS unsigned*)(lds + L_ANY) + (jg >> 2)), bits << (8 * (jg & 3)));
      LDS_WAIT(); __syncthreads(); }
    { const unsigned lo_ = ((LAS unsigned*)(lds + L_SEL))[qloc * 2], hi_ = ((LAS unsigned*)(lds + L_SEL))[qloc * 2 + 1]; const unsigned long long selm = ((unsigned long long)hi_ << 32) | lo_;
      const unsigned long long anym = ((unsigned long long)((LAS unsigned*)(lds + L_ANY))[1] << 32) | ((LAS unsigned*)(lds + L_ANY))[0];
      unsigned long long rem = anym; const int nts = __builtin_popcountll(anym);
      const bf16_t* KS = (const bf16_t*)(ws + WS_KS) + (size_t)bg * TP * 64; const bf16_t* VS = (const bf16_t*)(ws + WS_VS) + (size_t)bg * TP * 64;
      SM s; sm_init(s);
      ATT_TILE_LOOP(nts, __builtin_ctzll(rem), (rem &= rem - 1, __builtin_ctzll(rem)), KS, VS, {
          qkt(p0, p1, lds + L_K + SLOT * 8192, qr, r32, hi); mask_bias<1>(p0, p1, T, T + 3 <= qt, ((selm >> T) & 1ull) != 0ull, qpos, hi, bT, b31);
          sm_update<true>(s, p0, p1, wsf, r32, hi); ATT_PV(s, SLOT); });
      ATT_FINISH(s, 1);
    }
    { const int jw0 = max(0, qt - 8), ntw = qt - jw0 + 1;
      const bf16_t* KW = (const bf16_t*)(ws + WS_KW) + (size_t)bg * TP * 64; const bf16_t* VW = (const bf16_t*)(ws + WS_VW) + (size_t)bg * TP * 64;
      SM s; sm_init(s);
      ATT_TILE_LOOP(ntw, jw0, tcur_ + 1, KW, VW, {
          qkt(p0, p1, lds + L_K + SLOT * 8192, qr, r32, hi); mask_bias<2>(p0, p1, T, (T + 3 <= qt) && (T + 8 > qt), true, qpos, hi, bT, b31);
          sm_update<true>(s, p0, p1, wsf, r32, hi); ATT_PV(s, SLOT); });
      ATT_FINISH(s, 2);
    }
    { LAS bf16_t* stg = (LAS bf16_t*)(lds + L_OST + wid * 4096);
#pragma unroll
      for (int r = 0; r < 16; ++r) { stg[crow(r, hi) * 64 + r32] = (bf16_t)f2bf(oacc[0][r]); stg[crow(r, hi) * 64 + 32 + r32] = (bf16_t)f2bf(oacc[1][r]); }
      LDS_WAIT();
      bf16_t* O = (bf16_t*)(ws + WS_ACAT) + ((size_t)b * TP + q0 + qh * 32) * DM + (g * 4 + hh) * 64;
#pragma unroll
      for (int i = 0; i < 4; ++i) { const int row = i * 8 + (lane >> 3), ch = lane & 7; const u32x4 v = *(const LAS u32x4*)(stg + row * 64 + ch * 8); *(u32x4*)(O + (size_t)row * DM + ch * 8) = v; }
    }
    LDS_WAIT(); __syncthreads();
}

constexpr int S_SC = 0, S_SCLD = 1040, S_PSUM = 16640  , S_SCORE = 18752  , S_SELIDX = 19328  , S_Q = 19456  , S_OH = 20480  , S_STAT = 22528  , S_GATE = 22592  , S_BIAS = 22656  ;
struct SampleCtx { int b, g, s, qpos; const float* cache_sel; const float* state_win; const int* pt; const float* out; const float* kvcs; };
template <int BR> __device__ __forceinline__ void skey(const SampleCtx& C, const LAS int* selidx, int k, const float*& Kp, int& dist, bool& valid) {
    if (BR == 0) { Kp = C.kvcs + (((size_t)(C.b * 2 + C.g) * 512 + k) * 2) * 64; dist = C.qpos - (16 * k + 31); valid = true; }
    else if (BR == 1) { const int j = selidx[k >> 6], r = k & 63;
        if (j < 128) { const int page = C.pt[C.b * NPAGE + (j >> 1)]; Kp = C.cache_sel + ((size_t)page * PAGE + (j & 1) * 64 + r) * 256 + C.g * 64; dist = C.qpos - (64 * j + r); valid = true; }
        else { const int rr = r < TS ? r : 0; Kp = C.out + O_KVS_S + ((size_t)C.b * TS + rr) * 256 + C.g * 64; dist = C.qpos - (PAST + r); valid = r <= C.s; } }
    else { Kp = (k < 512 ? C.state_win + ((size_t)C.b * 512 + k) * 256 : C.out + O_KVW_S + ((size_t)C.b * 512 + 508 + (k - 512)) * 256) + C.g * 64; dist = C.qpos - (PAST - 512 + k); valid = dist >= 0 && dist < 512; }
}
constexpr int S_KP = 24704  , S_META = 33024  , S_RED = 37184  ;
template <int BR> __device__ __forceinline__ void sample_branch(const Ctx& X, int tid, const SampleCtx& C, int nkeys, float& ofinal) {
    LAS unsigned char* lds = X.lds; const int lane = tid & 63, wid = __builtin_amdgcn_readfirstlane(tid >> 6);
    LAS float* scs = (LAS float*)(lds + S_SC); LAS float* qs = (LAS float*)(lds + S_Q); LAS float* stat = (LAS float*)(lds + S_STAT);
    LAS float* gts = (LAS float*)(lds + S_GATE); LAS float* bT = (LAS float*)(lds + S_BIAS); const LAS int* selidx = (const LAS int*)(lds + S_SELIDX);
    typedef const float* cfp; LAS cfp* kp = (LAS cfp*)(lds + S_KP); LAS int* meta = (LAS int*)(lds + S_META); LAS float* red = (LAS float*)(lds + S_RED);
    constexpr int VOFF = BR == 0 ? 64 : 128;
    for (int k = tid; k < nkeys; k += NTHR) { const float* Kp; int dist; bool valid; skey<BR>(C, selidx, k, Kp, dist, valid); kp[k] = Kp; meta[k] = valid ? min(max(dist, 0), 127) : -1; }
    LDS_WAIT(); __syncthreads();
    const int grp = tid >> 4, li = tid & 15, nit = (nkeys + 31) >> 5;
    { f32x4 q4[4];
#pragma unroll
      for (int h = 0; h < 4; ++h) q4[h] = *(const LAS f32x4*)(qs + h * 64 + li * 4);
      for (int i0 = 0; i0 < nit; i0 += 8) { f32x4 kx[8];
#pragma unroll
          for (int u = 0; u < 8; ++u) { const int k = grp + 32 * (i0 + u); kx[u] = k < nkeys ? *(const f32x4*)(kp[k] + li * 4) : (f32x4){0.f, 0.f, 0.f, 0.f}; }
#pragma unroll
          for (int u = 0; u < 8; ++u) { const int k = grp + 32 * (i0 + u); float pt4[4];
#pragma unroll
              for (int h = 0; h < 4; ++h) { float d = (kx[u][0] * q4[h][0] + kx[u][1] * q4[h][1]) + (kx[u][2] * q4[h][2] + kx[u][3] * q4[h][3]);
                  d += __shfl_xor(d, 1); d += __shfl_xor(d, 2); d += __shfl_xor(d, 4); d += __shfl_xor(d, 8); pt4[h] = d; }
              if (li < 4 && k < nkeys) { const float d = li == 0 ? pt4[0] : li == 1 ? pt4[1] : li == 2 ? pt4[2] : pt4[3]; const int mt = meta[k];
                  scs[li * S_SCLD + k] = mt >= 0 ? d + bT[li * 128 + mt] : -INFINITY; } } } }
    LDS_WAIT(); __syncthreads();
    if (wid < 4) { LAS float* sr = scs + wid * S_SCLD; float m = -INFINITY;
        for (int k = lane; k < nkeys; k += 64) m = fmaxf(m, sr[k]);
#pragma unroll
        for (int o = 1; o < 64; o <<= 1) m = fmaxf(m, __shfl_xor(m, o));
        if (m == -INFINITY) m = 0.f;
        float l = 0.f;
        for (int k = lane; k < nkeys; k += 64) { const float e = fast_exp2(sr[k] - m); sr[k] = e; l += e; }
#pragma unroll
        for (int o = 1; o < 64; o <<= 1) l += __shfl_xor(l, o);
        if (lane == 0) { stat[wid] = m; stat[4 + wid] = l; } }
    LDS_WAIT(); __syncthreads();
    { f32x4 acc[4];
#pragma unroll
      for (int h = 0; h < 4; ++h) acc[h] = (f32x4){0.f, 0.f, 0.f, 0.f};
      for (int i0 = 0; i0 < nit; i0 += 8) { f32x4 vx[8];
#pragma unroll
          for (int u = 0; u < 8; ++u) { const int k = grp + 32 * (i0 + u); vx[u] = k < nkeys ? *(const f32x4*)(kp[k] + VOFF + li * 4) : (f32x4){0.f, 0.f, 0.f, 0.f}; }
#pragma unroll
          for (int u = 0; u < 8; ++u) { const int k = grp + 32 * (i0 + u); if (k < nkeys) {
#pragma unroll
              for (int h = 0; h < 4; ++h) acc[h] += vx[u] * scs[h * S_SCLD + k]; } } }
#pragma unroll
      for (int h = 0; h < 4; ++h) *(LAS f32x4*)(red + (grp * 4 + h) * 64 + li * 4) = acc[h]; }
    LDS_WAIT(); __syncthreads();
    if (tid < 256) { const int h = tid >> 6, d = tid & 63; float o = 0.f;
#pragma unroll 8
        for (int gq = 0; gq < 32; ++gq) o += red[(gq * 4 + h) * 64 + d];
        const float l = stat[4 + h]; ofinal += o * (l > 0.f ? 1.0f / l : 0.f) * gts[BR * 4 + h]; }
}
__device__ __forceinline__ void sample_item(const Ctx& X, int item, unsigned char* ws, const Args& A) {
    LAS unsigned char* lds = X.lds; int tid = X.tid; asm volatile("" : "+v"(tid));
    SampleCtx C; C.b = item >> 3; C.g = (item >> 2) & 1; C.s = item & 3; C.qpos = PAST + C.s; C.cache_sel = A.in[3]; C.state_win = A.in[4]; C.pt = (const int*)A.in[6]; C.out = A.out; C.kvcs = (const float*)(ws + WS_KVCS);
    const int mrow = MP + C.b * TS + C.s;
    LAS float* scs = (LAS float*)(lds + S_SC); LAS float* qs = (LAS float*)(lds + S_Q); LAS float* stat = (LAS float*)(lds + S_STAT); LAS float* gts = (LAS float*)(lds + S_GATE); LAS float* bT = (LAS float*)(lds + S_BIAS);
    LAS float* psum = (LAS float*)(lds + S_PSUM); LAS float* score = (LAS float*)(lds + S_SCORE); LAS int* selidx = (LAS int*)(lds + S_SELIDX);
    bT[tid] = A.in[24][(int)kBucket[tid & 127] * 8 + C.g * 4 + (tid >> 7)] * LOG2E;
    if (tid < 256) qs[tid] = bf2f(((const bf16_t*)(ws + WS_Q))[(size_t)mrow * 512 + C.g * 256 + tid]);
    if (tid < 12) gts[tid] = ((const float*)(ws + WS_GATES))[(size_t)mrow * 24 + (tid >> 2) * 8 + C.g * 4 + (tid & 3)];
    LDS_WAIT(); __syncthreads();
    float ofinal = 0.f;
    sample_branch<0>(X, tid, C, 511, ofinal);
    for (int n = tid; n < 520; n += NTHR) { float v = 0.f; if (n < 511) { v = scs[n] / stat[4] + scs[S_SCLD + n] / stat[5] + scs[2 * S_SCLD + n] / stat[6] + scs[3 * S_SCLD + n] / stat[7]; } psum[n] = v; }
    LDS_WAIT(); __syncthreads();
    if (tid < 129) { const int j = tid; const float v = 2.0f * (psum[4 * j] + psum[4 * j + 1] + psum[4 * j + 2]) + psum[4 * j + 3] + (j > 0 ? psum[4 * j - 1] : 0.f);
        score[j] = v + ((j == 0 || j == 128 || j == 127) ? 1000.0f : 0.f); }
    LDS_WAIT(); __syncthreads();
    if (tid < 129) { const float mv = score[tid]; int cnt = 0; for (int k = 0; k < 129; ++k) { const float v = score[k]; cnt += ((v > mv) || (v == mv && k < tid)) ? 1 : 0; } if (cnt < 16) selidx[cnt] = tid; }
    LDS_WAIT(); __syncthreads();
    sample_branch<1>(X, tid, C, 1024, ofinal);
    __syncthreads();
    sample_branch<2>(X, tid, C, 516, ofinal);
    if (tid < 256) ((bf16_t*)(ws + WS_ACAT))[(size_t)mrow * DM + C.g * 256 + tid] = (bf16_t)f2bf(ofinal);
    LDS_WAIT(); __syncthreads();
}
}

template <class Epi> __device__ __forceinline__ void thin_gemm(const Ctx& X, const bf16_t* A, const bf16_t* Bt, int K, int npn, const Epi& E) {
    LAS f32x4* red = (LAS f32x4*)X.lds;
    int tid = X.tid; asm volatile("" : "+v"(tid));
    const int lane = tid & 63, wid = __builtin_amdgcn_readfirstlane(tid >> 6), fr = lane & 15, fq = lane >> 4;
    const int kw = K >> 3, nks = kw >> 5, nunits = npn * 32;
    for (int u = blockIdx.x; u < nunits; u += X.G) {
        const int pn = u >> 5, c16 = (u >> 2) & 7, r32 = u & 3;
        const bf16_t* ap = A + (size_t)(32 * r32 + fr) * K + wid * kw + 8 * fq;
        const bf16_t* bp = Bt + (size_t)(pn * 256 + 16 * c16 + fr) * K + wid * kw + 8 * fq;
        const size_t a16 = (size_t)16 * K, b128 = (size_t)128 * K;
        f32x4 acc[2][2];
#pragma unroll
        for (int rt = 0; rt < 2; ++rt) { acc[rt][0] = (f32x4){0.f, 0.f, 0.f, 0.f}; acc[rt][1] = (f32x4){0.f, 0.f, 0.f, 0.f}; }
        for (int ks0 = 0; ks0 < nks; ks0 += 6) {
            bf16x8 af[6][2], bf[6][2];
#pragma unroll
            for (int i = 0; i < 6; ++i) if (ks0 + i < nks) { const int ko = 32 * (ks0 + i);
                af[i][0] = *(const bf16x8*)(ap + ko); af[i][1] = *(const bf16x8*)(ap + a16 + ko); bf[i][0] = *(const bf16x8*)(bp + ko); bf[i][1] = *(const bf16x8*)(bp + b128 + ko); }
#pragma unroll
            for (int i = 0; i < 6; ++i) if (ks0 + i < nks) {
#pragma unroll
                for (int rt = 0; rt < 2; ++rt) { acc[rt][0] = __builtin_amdgcn_mfma_f32_16x16x32_bf16(bf[i][0], af[i][rt], acc[rt][0], 0, 0, 0); acc[rt][1] = __builtin_amdgcn_mfma_f32_16x16x32_bf16(bf[i][1], af[i][rt], acc[rt][1], 0, 0, 0); } }
        }
#pragma unroll
        for (int rt = 0; rt < 2; ++rt) { red[((wid * 2 + rt) * 2 + 0) * 64 + lane] = acc[rt][0]; red[((wid * 2 + rt) * 2 + 1) * 64 + lane] = acc[rt][1]; }
        LDS_WAIT(); __syncthreads();
        if (wid < 2) { const int rt = wid; f32x4 q[2][1];
#pragma unroll
            for (int bj = 0; bj < 2; ++bj) { f32x4 v = red[((0 * 2 + rt) * 2 + bj) * 64 + lane];
#pragma unroll
                for (int w = 1; w < 4; ++w) v += red[((w * 2 + rt) * 2 + bj) * 64 + lane];
                q[bj][0] = v; }
            const int row = MP + 32 * r32 + 16 * rt + fr, h = c16 >> 2, t = c16 & 3;
            if constexpr (Epi::HAS_MID) E.thin_mid(row, pn, h, t, fq, q);
#pragma unroll
            for (int bj = 0; bj < 2; ++bj) { f32x4 v = q[bj][0];
#pragma unroll
                for (int w = 4; w < 8; ++w) v += red[((w * 2 + rt) * 2 + bj) * 64 + lane];
                q[bj][0] = v; }
            E.thin(row, pn, h, t, fq, q); }
        __syncthreads();
    }
}

__global__ void __launch_bounds__(NTHR, 2) nsa_fwd(Args args) {
    extern __shared__ __attribute__((aligned(16))) unsigned char lds_raw[];
    Ctx X; X.lds = (LAS unsigned char*)lds_raw; X.tid = threadIdx.x; X.lane = X.tid & 63; X.wave = __builtin_amdgcn_readfirstlane(X.tid >> 6);
    X.G = gridDim.x; { const int bx = blockIdx.x; X.vcu = (X.G % 8 == 0) ? (bx % 8) * (X.G / 8) + bx / 8 : bx; }
    X.gw = X.vcu * NWAVES + X.wave; X.NGW = X.G * NWAVES;
    unsigned char* ws = args.ws; float* out = args.out;
    gu32* ctl = (gu32*)(ws + WS_CTL);
    volatile LAS unsigned* MISC = (volatile LAS unsigned*)(X.lds + MISC_OFF);
    for (int u = X.tid; u < (LDS_BYTES - LDSCTL_OFF) / 4; u += NTHR) ((LAS unsigned*)(X.lds + LDSCTL_OFF))[u] = 0u;
    __syncthreads();
    XcdBarrier bar; bar.bar = (unsigned*)(ctl + CW_BAR); bar.x = 0; bar.st = nullptr;
#if !MK_PER_PHASE
    bar = xcd_barrier_post((unsigned*)(ctl + CW_BAR), MISC + 8);
#define GRID_BAR() xcd_barrier(bar)
#else
#define GRID_BAR() do { } while (0)
#endif
    const int lo = args.ph_lo, hi = args.ph_hi;
#define IN(k) (lo <= (k) && (k) < hi)
#define BOTH(k) (IN(k) && IN((k) + 1))
    float* modv = (float*)(ws + WS_MOD);
    const float* x_p = args.in[0]; const float* x_s = args.in[1];

#if MK_PROBE
    if (IN(-1)) { f32x4* o4 = (f32x4*)(out + O_KVC_P); const size_t n4 = (O_TOTAL - O_KVC_P) / 4;
        for (size_t i = (size_t)X.gw * 64 + X.lane; i < n4; i += (size_t)X.NGW * 64) o4[i] = (f32x4){100.f, 100.f, 100.f, 100.f}; }
#endif
    if (MK_PH_ON(0) && IN(0)) for (int rep_ = 0; rep_ < MK_NREP(0); ++rep_) { if (rep_) GRID_BAR();
        for (int rp = 0; rp < MK_NREP(20); ++rp)
        for (int it = X.vcu; it < NMOD / 64; it += X.G) ada_item(X, it, args.in[7], args.in[8], args.in[9], args.in[10], modv);
        __syncthreads();
        {
            LAS float* scr = (LAS float*)(X.lds + X.wave * 16384);
            int total = 0;
            for (int j = 0; j < NJOBS; ++j) total += tj_items(kJobs[j]);
            for (int it = X.gw; it < total * MK_NREP(21); it += X.NGW) {
                int r = it % total, j = 0;
                for (; j < NJOBS - 1; ++j) { const int n = tj_items(kJobs[j]); if (r < n) break; r -= n; }
                const TJ J = kJobs[j];
                const int nblk = (J.ncols + 63) / 64, per = (J.K / 64) * nblk, rep = r / per, rr = r % per, kb = rr / nblk, nb = rr % nblk;
                const float* W = args.in[J.src] + (size_t)rep * J.srcoff_stride + J.col0 + rep * J.col_stride;
                bf16_t* WT = wdst(ws, J.dst) + (size_t)(J.drow0 + rep * J.drow_stride) * J.dpitch + J.dcol0;
                transpose_item(W, J.N, J.ncols, WT, J.dpitch, scr, kb, nb, X.lane);
            }
            { u32x4* z = (u32x4*)((bf16_t*)(ws + WS_WIN) + (size_t)INW * DM); const int nz = (INWP - INW) * DM * 2 / 16;
              for (int i = X.gw * 64 + X.lane; i < nz; i += X.NGW * 64) z[i] = (u32x4){0u, 0u, 0u, 0u}; }
        }
        for (int o = X.gw; o < 256; o += X.NGW) { const int c = o >> 7, e = o & 127; const float* pe = args.in[19] + c * 2048; const float* w1 = args.in[17] + (size_t)c * 2048 * 128 + e;
            float s = 0.f; for (int k = X.lane; k < 2048; k += 64) s += pe[k] * w1[(size_t)k * 128];
#pragma unroll
            for (int off = 1; off < 64; off <<= 1) s += __shfl_xor(s, off);
            if (X.lane == 0) ((float*)(ws + WS_PETERM))[o] = s; }
        { const f32x4* src = (const f32x4*)args.in[4]; f32x4* dst = (f32x4*)(out + O_KVW_S); const int per_b = 508 * 64;
          for (int i = X.gw * 64 + X.lane; i < NBS * per_b; i += X.NGW * 64) { const int b = i / per_b, r = i % per_b; dst[(size_t)b * 512 * 64 + r] = src[(size_t)b * 512 * 64 + 4 * 64 + r]; } }
        { const int* pt = (const int*)args.in[6]; const float* cache = args.in[2]; bf16_t* ACS = (bf16_t*)(ws + WS_ACS);
          for (int it0 = X.gw; it0 < NBS * 512 * MK_NREP(22); it0 += X.NGW) { const int it = it0 & (NBS * 512 - 1); const int b = it >> 9, n = it & 511; const int page = pt[b * NPAGE + (n >> 3)];
              const f32x4* src = (const f32x4*)(cache + ((size_t)page * PAGE + (n & 7) * 16) * 256) + X.lane;
              const int c = X.lane >> 5, g = (X.lane >> 4) & 1, d = (X.lane & 15) * 4;
              bf16_t* dst = ACS + ((size_t)c * 32768 + (size_t)(b * 2 + g) * 512 + n) * 1024 + d;
              f32x4 v[16];
#pragma unroll
              for (int l = 0; l < 16; ++l) v[l] = src[l * 64];
#pragma unroll
              for (int l = 0; l < 16; ++l) { u32x2 w; w.x = pk2(v[l][0], v[l][1]); w.y = pk2(v[l][2], v[l][3]); *(u32x2*)(dst + l * 64) = w; } } }
        if (BOTH(0)) GRID_BAR();
    }

    if (MK_PH_ON(1) && IN(1)) for (int rep_ = 0; rep_ < MK_NREP(1); ++rep_) { if (rep_) GRID_BAR();
        { const float* g1 = args.in[11]; bf16_t* A1 = (bf16_t*)(ws + WS_A1);
          for (int m = X.gw; m < MPAD; m += X.NGW) {
              unsigned long long* o8 = (unsigned long long*)(A1 + (size_t)m * DM) + X.lane;
              if (m >= MTOT) {
#pragma unroll
                  for (int j = 0; j < 4; ++j) o8[64 * j] = 0ull;
                  continue; }
              const float* xr = m < MP ? x_p + (size_t)m * DM : x_s + (size_t)(m - MP) * DM; const int bi = bidx_of_row(m);
              const f32x4* x4 = (const f32x4*)xr + X.lane; f32x4 v[4]; float s = 0.f;
#pragma unroll
              for (int j = 0; j < 4; ++j) { v[j] = x4[64 * j]; s += (v[j][0] * v[j][0] + v[j][1] * v[j][1]) + (v[j][2] * v[j][2] + v[j][3] * v[j][3]); }
#pragma unroll
              for (int off = 1; off < 64; off <<= 1) s += __shfl_xor(s, off);
              const float rt = 1.0f / sqrtf(s * (1.0f / DM) + EPS);
              const f32x4* gg = (const f32x4*)g1 + X.lane; const f32x4* sh = (const f32x4*)modp(modv, bi, 0, 0) + X.lane; const f32x4* sc = (const f32x4*)modp(modv, bi, 0, 1) + X.lane;
#pragma unroll
              for (int j = 0; j < 4; ++j) { const f32x4 a = v[j] * rt * gg[64 * j] * (sc[64 * j] + 1.0f) + sh[64 * j];
                  o8[64 * j] = (unsigned long long)pk2(a[0], a[1]) | ((unsigned long long)pk2(a[2], a[3]) << 32); }
          } }
        for (int second = 0; second < 2; ++second) {
            constexpr int SP = 1024 + 8;
            LAS bf16_t* shl = (LAS bf16_t*)X.lds;
            __syncthreads();
            for (int i = X.tid; i < 48 * 256; i += NTHR) { const int bi = i >> 8, k4 = (i & 255) * 4; const f32x4 a = *(const f32x4*)(modp(modv, bi < NBIDX ? bi : NBIDX - 1, second ? 2 : 1, 0) + k4);
                u32x2 w; w.x = pk2(a[0], a[1]); w.y = pk2(a[2], a[3]); *(LAS u32x2*)(shl + bi * SP + k4) = w; }
            LDS_WAIT(); __syncthreads();
            const int nrows = second ? NGU : INWP; const bf16_t* Wt = (const bf16_t*)(ws + (second ? WS_WGU2 : WS_WIN)); float* dst = (float*)(ws + (second ? WS_SW3 : WS_SW2));
            const int fr = X.lane & 15, fq = X.lane >> 4;
            for (int it = X.gw; it < nrows / 16; it += X.NGW) { const int n0 = it * 16; f32x4 acc[3];
#pragma unroll
                for (int bt = 0; bt < 3; ++bt) acc[bt] = (f32x4){0.f, 0.f, 0.f, 0.f};
                const bf16_t* wr = Wt + (size_t)(n0 + fr) * DM + 8 * fq;
#pragma unroll 8
                for (int ks = 0; ks < 32; ++ks) { const bf16x8 af = *(const bf16x8*)(wr + 32 * ks);
#pragma unroll
                    for (int bt = 0; bt < 3; ++bt) { const bf16x8 bfr = *(const LAS bf16x8*)(shl + (16 * bt + fr) * SP + 32 * ks + 8 * fq); acc[bt] = __builtin_amdgcn_mfma_f32_16x16x32_bf16(af, bfr, acc[bt], 0, 0, 0); } }
#pragma unroll
                for (int bt = 0; bt < 3; ++bt) { const int bi = 16 * bt + fr; if (bi < NBIDX) *(f32x4*)(dst + (size_t)bi * nrows + n0 + 4 * fq) = acc[bt]; } }
        }
        __syncthreads();
        for (int c = 0; c < 2; ++c) {
            pg8::Gemm g{(const bf16_t*)(ws + WS_ACS) + (size_t)c * 32768 * 1024, (const bf16_t*)(ws + WS_WC1) + (size_t)c * 256 * 1024, 32768, 256, DM};
            pg8::StaticOrder S; S.init(32768, 256, X.G, (int)((blockIdx.x + (c ? X.G - 128 : 0)) % X.G));
            pg8::EpiStoreBf16 E{(bf16_t*)(ws + WS_PCS) + (size_t)c * 32768 * 256, 256};
            pg8::gemm_phase(X.lds, g, S, E);
        }
        if (BOTH(1)) GRID_BAR();
    }

    if (MK_PH_ON(2) && IN(2)) for (int rep_ = 0; rep_ < MK_NREP(2); ++rep_) { if (rep_) GRID_BAR();
        pg8::Gemm g{(const bf16_t*)(ws + WS_A1), (const bf16_t*)(ws + WS_WGU1), MPAD, NGU, DM}; pg8::StaticOrder S; S.init(MPAD, NGU, X.G, (int)blockIdx.x);
        pg8::EpiGU E{(bf16_t*)(ws + WS_ACT), nullptr, nullptr, 0, nullptr};
        pg8::gemm_phase(X.lds, g, S, E);
        if (BOTH(2)) GRID_BAR();
    }
    if (MK_PH_ON(3) && IN(3)) for (int rep_ = 0; rep_ < MK_NREP(3); ++rep_) { if (rep_) GRID_BAR();
        pg8::Gemm g{(const bf16_t*)(ws + WS_ACT), (const bf16_t*)(ws + WS_WD1), MP, DM, DFF}; pg8::StaticOrder S; S.init(MP, DM, X.G, (int)blockIdx.x);
        float* H1 = (float*)(ws + WS_H1);
        pg8::EpiRes<true> E{x_p, x_s, H1, H1 + (size_t)MP * DM, modv, 0, (bf16_t*)(ws + WS_A2), args.in[11] + DM, 1, (float*)(ws + WS_SSQ2), (float*)(ws + WS_SSQS2), 0.5f};
        thin_gemm(X, (const bf16_t*)(ws + WS_ACT) + (size_t)MP * DFF, (const bf16_t*)(ws + WS_WD1), DFF, 4, E);
        pg8::gemm_phase(X.lds, g, S, E);
        if (BOTH(3)) GRID_BAR();
    }
    if (MK_PH_ON(4) && IN(4)) for (int rep_ = 0; rep_ < MK_NREP(4); ++rep_) { if (rep_) GRID_BAR();
        pg8::Gemm g{(const bf16_t*)(ws + WS_A2), (const bf16_t*)(ws + WS_WIN), MP, INWP, DM}; pg8::StaticOrder S; S.init(MP, INWP, X.G, (int)blockIdx.x);
        EpiIn E{(const float*)(ws + WS_SSQ2), (const float*)(ws + WS_SSQS2), (const float*)(ws + WS_SW2), out, ws};
        thin_gemm(X, (const bf16_t*)(ws + WS_A2) + (size_t)MP * DM, (const bf16_t*)(ws + WS_WIN), DM, 20, E);
        pg8::gemm_phase(X.lds, g, S, E);
        if (BOTH(4)) GRID_BAR();
    }
    if (MK_PH_ON(5) && IN(5)) for (int rep_ = 0; rep_ < MK_NREP(5); ++rep_) { if (rep_) GRID_BAR();
        for (int c = 0; c < 2; ++c) {
            pg8::Gemm g{(const bf16_t*)(ws + WS_ACP) + (size_t)c * 2048 * 1024, (const bf16_t*)(ws + WS_WC1) + (size_t)c * 256 * 1024, 2048, 256, DM};
            pg8::StaticOrder S; S.init(2048, 256, X.G, (int)((blockIdx.x + (c ? X.G - 8 : 0)) % X.G));
            pg8::EpiStoreBf16 E{(bf16_t*)(ws + WS_PCP) + (size_t)c * 2048 * 256, 256};
            pg8::gemm_phase(X.lds, g, S, E);
        }
        __syncthreads();
        { const bf16_t* PROD = (const bf16_t*)(ws + WS_PROD); const bf16_t* CBb = (const bf16_t*)(ws + WS_CB); bf16_t* ACAT = (bf16_t*)(ws + WS_ACAT);
          const float* wcv = args.in[20]; const float* stc = args.in[5]; const int j = X.lane * 8;
          float w0[8], w1[8], w2[8];
#pragma unroll
          for (int e = 0; e < 8; ++e) { w0[e] = wcv[j + e]; w1[e] = wcv[512 + j + e]; w2[e] = wcv[1024 + j + e]; }
          for (int m = X.gw; m < MTOT; m += X.NGW) {
              const bool isp = m < MP; const int t = isp ? (m & (TP - 1)) : ((m - MP) & 3), bs = isp ? 0 : ((m - MP) >> 2);
              float a2[8], a1[8], a0[8], cbv[8];
              { const u32x4 v = *(const u32x4*)(PROD + (size_t)m * 512 + j); const u32x4 c4 = *(const u32x4*)(CBb + (size_t)m * 512 + j);
#pragma unroll
                for (int e = 0; e < 4; ++e) { a0[2 * e] = bflo(v[e]); a0[2 * e + 1] = bfhi(v[e]); cbv[2 * e] = bflo(c4[e]); cbv[2 * e + 1] = bfhi(c4[e]); } }
              if (t >= 1) { const u32x4 v = *(const u32x4*)(PROD + (size_t)(m - 1) * 512 + j);
#pragma unroll
                  for (int e = 0; e < 4; ++e) { a1[2 * e] = bflo(v[e]); a1[2 * e + 1] = bfhi(v[e]); } }
              else {
#pragma unroll
                  for (int e = 0; e < 8; ++e) a1[e] = isp ? 0.f : stc[((size_t)bs * 2 + 1) * 512 + j + e]; }
              if (t >= 2) { const u32x4 v = *(const u32x4*)(PROD + (size_t)(m - 2) * 512 + j);
#pragma unroll
                  for (int e = 0; e < 4; ++e) { a2[2 * e] = bflo(v[e]); a2[2 * e + 1] = bfhi(v[e]); } }
              else {
#pragma unroll
                  for (int e = 0; e < 8; ++e) a2[e] = isp ? 0.f : stc[((size_t)bs * 2 + t) * 512 + j + e]; }
              float y[8];
#pragma unroll
              for (int e = 0; e < 8; ++e) y[e] = cbv[e] * (w0[e] * a2[e] + w1[e] * a1[e] + w2[e] * a0[e]);
              u32x4 w; w.x = pk2(y[0], y[1]); w.y = pk2(y[2], y[3]); w.z = pk2(y[4], y[5]); w.w = pk2(y[6], y[7]);
              *(u32x4*)(ACAT + (size_t)m * DM + 512 + j) = w; } }
        for (int it = X.vcu; it < 2 * 64 * 8; it += X.G) cmp_tail_item<true>(X, it, ws, args.in[18]);
        if (BOTH(5)) GRID_BAR();
    }
    if (MK_PH_ON(6) && IN(6)) for (int rep_ = 0; rep_ < MK_NREP(6); ++rep_) { if (rep_) GRID_BAR();
        for (int it = X.vcu; it < 2 * 8 * 4; it += X.G) cmp_tail_item<false>(X, it, ws, args.in[18]);
        if (BOTH(6)) GRID_BAR();
    }
    if (MK_PH_ON(7) && IN(7)) {
        for (int i = X.vcu; i < 512 * MK_NREP(7); i += X.G) { const int ii = i & 255; const int bg = ii >> 5, qt = ((i & 256) == 0) ? (ii & 31) : 63 - (ii & 31); att::prompt_item(X, bg, qt, ws, args.in[24]); }
        for (int i = X.vcu; i < 256 * MK_NREP(7); i += X.G) att::sample_item(X, i & 255, ws, args);
        if (BOTH(7)) GRID_BAR();
    }
    if (MK_PH_ON(8) && IN(8)) for (int rep_ = 0; rep_ < MK_NREP(8); ++rep_) { if (rep_) GRID_BAR();
        pg8::Gemm g{(const bf16_t*)(ws + WS_ACAT), (const bf16_t*)(ws + WS_WM), MP, DM, DM}; pg8::StaticOrder S; S.init(MP, DM, X.G, (int)blockIdx.x);
        EpiMerge E{8, (const bf16_t*)(ws + WS_RATIO), (const bf16_t*)(ws + WS_GB), (bf16_t*)(ws + WS_MERGED)};
        thin_gemm(X, (const bf16_t*)(ws + WS_ACAT) + (size_t)MP * DM, (const bf16_t*)(ws + WS_WM), DM, 4, E);
        pg8::gemm_phase(X.lds, g, S, E);
        if (BOTH(8)) GRID_BAR();
    }
    if (MK_PH_ON(9) && IN(9)) for (int rep_ = 0; rep_ < MK_NREP(9); ++rep_) { if (rep_) GRID_BAR();
        pg8::Gemm g{(const bf16_t*)(ws + WS_MERGED), (const bf16_t*)(ws + WS_WO), MP, DM, DM}; pg8::StaticOrder S; S.init(MP, DM, X.G, (int)blockIdx.x);
        float* H1 = (float*)(ws + WS_H1);
        pg8::EpiRes<true> E{H1, H1 + (size_t)MP * DM, H1, H1 + (size_t)MP * DM, modv, 1, (bf16_t*)(ws + WS_A3), args.in[11] + 2 * DM, 2, (float*)(ws + WS_SSQ3), (float*)(ws + WS_SSQS3), 1.0f};
        thin_gemm(X, (const bf16_t*)(ws + WS_MERGED) + (size_t)MP * DM, (const bf16_t*)(ws + WS_WO), DM, 4, E);
        pg8::gemm_phase(X.lds, g, S, E);
        if (BOTH(9)) GRID_BAR();
    }
    if (MK_PH_ON(10) && IN(10)) for (int rep_ = 0; rep_ < MK_NREP(10); ++rep_) { if (rep_) GRID_BAR();
        pg8::Gemm g{(const bf16_t*)(ws + WS_A3), (const bf16_t*)(ws + WS_WGU2), MPAD, NGU, DM}; pg8::StaticOrder S; S.init(MPAD, NGU, X.G, (int)blockIdx.x);
        pg8::EpiGU E{(bf16_t*)(ws + WS_ACT), (const float*)(ws + WS_SSQ3), (const float*)(ws + WS_SW3), NGU, (const float*)(ws + WS_SSQS3)};
        pg8::gemm_phase(X.lds, g, S, E);
        if (BOTH(10)) GRID_BAR();
    }
    if (MK_PH_ON(11) && IN(11)) for (int rep_ = 0; rep_ < MK_NREP(11); ++rep_) { if (rep_) GRID_BAR();
        pg8::Gemm g{(const bf16_t*)(ws + WS_ACT), (const bf16_t*)(ws + WS_WD2), MP, DM, DFF}; pg8::StaticOrder S; S.init(MP, DM, X.G, (int)blockIdx.x);
        float* H1 = (float*)(ws + WS_H1);
        pg8::EpiRes<false> E{H1, H1 + (size_t)MP * DM, out + O_Y, out + O_Y + (size_t)MP * DM, modv, 2, nullptr, nullptr, 0, nullptr, nullptr, 0.5f};
        thin_gemm(X, (const bf16_t*)(ws + WS_ACT) + (size_t)MP * DFF, (const bf16_t*)(ws + WS_WD2), DFF, 4, E);
        pg8::gemm_phase(X.lds, g, S, E);
        if (BOTH(11)) GRID_BAR();
    }
    if (MK_PH_ON(12) && IN(12)) for (int rep_ = 0; rep_ < MK_NREP(12); ++rep_) { if (rep_) GRID_BAR();
        const f32x4* gf = (const f32x4*)args.in[25] + X.lane;
        for (int m = X.gw; m < MTOT; m += X.NGW) { f32x4* y4 = (f32x4*)(out + O_Y + (size_t)m * DM) + X.lane; f32x4 v[4]; float s = 0.f;
#pragma unroll
            for (int j = 0; j < 4; ++j) { v[j] = y4[64 * j]; s += (v[j][0] * v[j][0] + v[j][1] * v[j][1]) + (v[j][2] * v[j][2] + v[j][3] * v[j][3]); }
#pragma unroll
            for (int off = 1; off < 64; off <<= 1) s += __shfl_xor(s, off);
            const float rt = 1.0f / sqrtf(s * (1.0f / DM) + EPS);
#pragma unroll
            for (int j = 0; j < 4; ++j) y4[64 * j] = v[j] * rt * gf[64 * j]; }
    }
#if MK_PROBE
    if (IN(13)) { f32x4* o4 = (f32x4*)(out + O_KVC_P); const size_t n4 = (O_TOTAL - O_KVC_P) / 4;
        for (size_t i = (size_t)X.gw * 64 + X.lane; i < n4; i += (size_t)X.NGW * 64) o4[i] = o4[i] * 3.0f; }
#endif
#undef IN
#undef BOTH
}

extern "C" void kernel_launch(void* const* d_in, const int* in_sizes, int n_in, void* d_out, int out_size, void* d_ws, size_t ws_size, hipStream_t stream) {
    static int grid = 0;
    if (grid == 0) {
        if (n_in != 26 || out_size != (int)O_TOTAL || ws_size < WS_END) { fprintf(stderr, "kernel_launch: unexpected shapes n_in %d out %d ws %zu\n", n_in, out_size, ws_size); grid = -1; return; }
        int dev = 0, cus = 0;
        if (hipGetDevice(&dev) != hipSuccess || hipDeviceGetAttribute(&cus, hipDeviceAttributeMultiprocessorCount, dev) != hipSuccess) { grid = -1; return; }
        if (hipFuncSetAttribute((const void*)nsa_fwd, hipFuncAttributeMaxDynamicSharedMemorySize, LDS_BYTES) != hipSuccess) { fprintf(stderr, "kernel_launch: hipFuncSetAttribute failed\n"); grid = -1; return; }
        int per_cu = 0;
        if (hipOccupancyMaxActiveBlocksPerMultiprocessor(&per_cu, (const void*)nsa_fwd, NTHR, LDS_BYTES) != hipSuccess || per_cu < 1) fprintf(stderr, "kernel_launch: occupancy query says %d\n", per_cu);
        (void)hipGetLastError();
        grid = cus;
    }
    if (grid < 0) return;
    (void)hipMemsetAsync((char*)d_ws + WS_CTL, 0, CTL_ZERO_BYTES, stream);
    Args a{};
    for (int i = 0; i < 26; ++i) a.in[i] = (const float*)d_in[i];
    a.out = (float*)d_out; a.ws = (unsigned char*)d_ws;
    constexpr int NPH = MK_LAST_PHASE + 1 + (MK_PROBE ? 1 : 0);
#if MK_PER_PHASE
    for (int p = (MK_PROBE ? -1 : 0); p < NPH; ++p) { a.ph_lo = p; a.ph_hi = p + 1; a.li = 0; hipLaunchKernelGGL(nsa_fwd, dim3(grid), dim3(NTHR), LDS_BYTES, stream, a); }
#else
    a.ph_lo = 0; a.ph_hi = NPH; a.li = 0; hipLaunchKernelGGL(nsa_fwd, dim3(grid), dim3(NTHR), LDS_BYTES, stream, a);
#endif
}
```

```cpp
#include <hip/hip_runtime.h>
#include <hip/hip_bf16.h>
#include <cstdio>
#include <cstdint>
#include <cmath>

#ifndef MK_PER_PHASE
#define MK_PER_PHASE 0
#endif
#ifndef MK_PH_MASK
#define MK_PH_MASK 0xffffffffu
#endif
#define MK_PH_ON(k) (((MK_PH_MASK >> (k)) & 1u) && !(MK_CHECK && (k) >= 8))
#ifndef MK_CHECK
#define MK_CHECK 0
#endif
#ifndef MK_CHECK_TOL
#define MK_CHECK_TOL 0.02f
#endif
#ifndef MK_CHECK_MAXBAD
#define MK_CHECK_MAXBAD 2
#endif
#ifndef MK_PROBE
#define MK_PROBE 0
#endif
#ifndef MK_DUP
#define MK_DUP (-1)
#endif
#define MK_NREP(k) ((k) == MK_DUP ? 2 : 1)
#ifndef MK_LAST_PHASE
#define MK_LAST_PHASE 12
#endif

constexpr int DM = 1024, NBP = 4, TP = 4096, MP = NBP * TP, NBS = 32, TS = 4, MS = NBS * TS, MTOT = MP + MS, MPAD = 16640;
constexpr int HD = 64, NH = 8, HKV = 2, GRP = 4, DFF = 2816, NGU = 2 * DFF, INW = 4888, INWP = 5120, DCONV = 512;
constexpr int PAST = 8192, NPAGE = 64, PAGE = 128, NPHYS = 2560;
constexpr int NBIDX = NBP + NBS;
constexpr int NMOD = 9 * DM;
constexpr float EPS = 1e-6f;
constexpr float LOG2E = 1.4426950408889634f;
constexpr float QSCALE = 0.125f * LOG2E;

constexpr size_t O_Y = 0;
constexpr size_t O_KVC_P = (size_t)MTOT * DM;
constexpr size_t O_KVS_P = O_KVC_P + (size_t)MP * 256;
constexpr size_t O_KVW_P = O_KVS_P + (size_t)MP * 256;
constexpr size_t O_CONV_P = O_KVW_P + (size_t)NBP * 512 * 256;
constexpr size_t O_KVC_S = O_CONV_P + (size_t)NBP * 2 * 512;
constexpr size_t O_KVS_S = O_KVC_S + (size_t)MS * 256;
constexpr size_t O_KVW_S = O_KVS_S + (size_t)MS * 256;
constexpr size_t O_CONV_S = O_KVW_S + (size_t)NBS * 512 * 256;
constexpr size_t O_TOTAL = O_CONV_S + (size_t)NBS * 2 * 512;
static_assert(O_TOTAL == 30117888, "output size");

constexpr size_t MiB = 1u << 20;
constexpr size_t WS_CTL = 0, CTL_ZERO_BYTES = 1 * MiB;
constexpr size_t WS_MOD = 1 * MiB;
constexpr size_t WS_PETERM = 3 * MiB;
constexpr size_t WS_SW2 = 4 * MiB;
constexpr size_t WS_SW3 = 5 * MiB;
constexpr size_t WS_SSQ2 = 6 * MiB, WS_SSQ3 = 8 * MiB;
constexpr size_t WS_SSQS2 = 7 * MiB + 512 * 1024, WS_SSQS3 = 9 * MiB + 512 * 1024;
constexpr size_t WS_GATES = 10 * MiB;
constexpr size_t WS_WGU1 = 16 * MiB;
constexpr size_t WS_WD1 = 28 * MiB;
constexpr size_t WS_WIN = 34 * MiB;
constexpr size_t WS_WM = 46 * MiB;
constexpr size_t WS_WO = 48 * MiB;
constexpr size_t WS_WGU2 = 50 * MiB;
constexpr size_t WS_WD2 = 62 * MiB;
constexpr size_t WS_WC1 = 68 * MiB;
constexpr size_t WS_A1 = 72 * MiB;
constexpr size_t WS_A2 = 106 * MiB;
constexpr size_t WS_A3 = 140 * MiB;
constexpr size_t WS_ACT = 174 * MiB;
constexpr size_t WS_H1 = 266 * MiB;
constexpr size_t WS_Q = 332 * MiB;
constexpr size_t WS_KS = 350 * MiB, WS_VS = 354 * MiB, WS_KW = 358 * MiB, WS_VW = 362 * MiB;
constexpr size_t WS_ACP = 366 * MiB;
constexpr size_t WS_PCP = 376 * MiB;
constexpr size_t WS_KCP = 380 * MiB, WS_VCP = 381 * MiB;
constexpr size_t WS_KVCS = 382 * MiB;
constexpr size_t WS_PROD = 400 * MiB;
constexpr size_t WS_CB = 418 * MiB;
constexpr size_t WS_RATIO = 436 * MiB;
constexpr size_t WS_GB = 470 * MiB;
constexpr size_t WS_ACAT = 504 * MiB;
constexpr size_t WS_MERGED = 538 * MiB;
constexpr size_t WS_PCS = 572 * MiB;
constexpr size_t WS_ACS = 608 * MiB;
constexpr size_t WS_END = 740 * MiB;

constexpr int CW_TMO = 0, CW_CODE = 1, CW_BAR = 4096;

#define GAS __attribute__((address_space(1)))
#define LAS __attribute__((address_space(3)))
typedef unsigned short bf16_t;
typedef short bf16x8 __attribute__((ext_vector_type(8)));
typedef float f32x4 __attribute__((ext_vector_type(4)));
typedef float f32x2 __attribute__((ext_vector_type(2)));
typedef unsigned u32x4 __attribute__((ext_vector_type(4)));
typedef unsigned u32x2 __attribute__((ext_vector_type(2)));
typedef GAS unsigned gu32;

__device__ __forceinline__ unsigned f2bf(float f) { unsigned u = __builtin_bit_cast(unsigned, f); return (u + 0x7fffu + ((u >> 16) & 1u)) >> 16; }
__device__ __forceinline__ unsigned pk2(float lo, float hi) { return f2bf(lo) | (f2bf(hi) << 16); }
__device__ __forceinline__ float bf2f(unsigned short b) { return __builtin_bit_cast(float, (unsigned)b << 16); }
__device__ __forceinline__ float bflo(unsigned w) { return __builtin_bit_cast(float, w << 16); }
__device__ __forceinline__ float bfhi(unsigned w) { return __builtin_bit_cast(float, w & 0xffff0000u); }
__device__ __forceinline__ float fast_exp2(float x) { return __builtin_amdgcn_exp2f(x); }
__device__ __forceinline__ float fast_rcp(float x) { return __builtin_amdgcn_rcpf(x); }
__device__ __forceinline__ float sigmoidf_(float x) { return fast_rcp(1.0f + fast_exp2(-x * LOG2E)); }
__device__ __forceinline__ float siluf_(float x) { return x * sigmoidf_(x); }
__device__ __forceinline__ int bidx_of_row(int row) { int b = row < MP ? (row >> 12) : NBP + ((row - MP) >> 2); return b < NBIDX ? b : NBIDX - 1; }
__device__ __forceinline__ const float* modp(const float* modv, int bidx, int sub, int kind) { return modv + ((size_t)(bidx * 3 + sub) * 3 + kind) * DM; }

__device__ __forceinline__ unsigned k_img(int ntile, int bg, int t, int d) { return (unsigned)((bg * ntile + (t >> 6)) * 4096 + (d >> 3) * 512 + (t & 63) * 8 + (d & 7)); }
__device__ __forceinline__ unsigned v_img(int ntile, int bg, int t, int d) { return (unsigned)((bg * ntile + (t >> 6)) * 4096 + ((d >> 5) * 4 + ((t & 63) >> 4)) * 512 + (t & 15) * 32 + (d & 31)); }

namespace pg8 {
constexpr int BM = 256, BK = 64, HALF = 128, HTB = HALF * BK * 2, STAGE_BYTES = 8 * HTB, NXCD = 8, WGM = 8;
__host__ __device__ __forceinline__ int lds_byte(int r, int c) { const int st = (r >> 4) * 2 + (c >> 5), rr = r & 15, cc = c & 31, ob = rr * 64 + cc * 2; return st * 1024 + (ob ^ (((ob >> 9) & 1) << 5)); }
__host__ __device__ __forceinline__ void stage_rc(int b, int& R, int& C) { const int st = b / 1024, sb = b % 1024, swz = sb ^ (((sb >> 9) & 1) << 5); R = (st >> 1) * 16 + swz / 64; C = (st & 1) * 32 + (swz % 64) / 2; }
__host__ __device__ __forceinline__ int perm32(int rho) { const int n = rho >> 4, i = rho & 15; return 8 * (i >> 2) + 4 * n + (i & 3); }
struct Unit { int pm, pn; };
struct Gemm { const bf16_t* A; const bf16_t* Bt; int M, N, K; };
struct StaticOrder {
    int nM, nN, nwg, G, c;
    __host__ __device__ void init(int M, int N, int G_, int c_) { nM = M / BM; nN = N / BM; nwg = nM * nN; G = G_; c = c_; }
    __host__ __device__ bool next(int i, Unit& u) const {
        const long L = (long)i * G + c; if (L >= nwg) return false;
        int wgid = (int)L; { const int q = nwg / NXCD, r = nwg % NXCD, xcd = wgid % NXCD, off = wgid / NXCD; wgid = (xcd < r ? xcd * (q + 1) : r * (q + 1) + (xcd - r) * q) + off; }
        const int nig = WGM * nN, gid = wgid / nig, fm = gid * WGM, gsz = (nM - fm) < WGM ? (nM - fm) : WGM;
        u.pm = fm + ((wgid % nig) % gsz); u.pn = (wgid % nig) / gsz; return true;
    }
    __device__ __forceinline__ void a_ready(const Unit&) const {}
    __device__ __forceinline__ void done(const Unit&) const {}
};
template <class Epi, class Sched>
__device__ __forceinline__ void gemm_phase(LAS unsigned char* lds, const Gemm g, const Sched& S, const Epi& E) {
    const int tid = threadIdx.x, wid = __builtin_amdgcn_readfirstlane(tid >> 6), lane = tid & 63, wr = wid >> 2, wc = wid & 3, fr = lane & 15, fq = lane >> 4;
    const int K = g.K, nt = K / BK;
    unsigned voffA[2], voffB[2];
#pragma unroll
    for (int i = 0; i < 2; ++i) { int R, C; stage_rc(tid * 16 + i * 8192, R, C); const int Rb = Epi::PERM ? ((R & ~31) + perm32(R & 31)) : R;
        voffA[i] = (unsigned)(R * K + C) * 2u; voffB[i] = (unsigned)(Rb * K + C) * 2u; }
    const size_t kstep = (size_t)(BK * 2);
    const size_t hstep = (size_t)HALF * K * 2;
    const size_t tstep = 2 * hstep;
    const unsigned ldsw = (unsigned)wid * 1024u;
    const int aoff = lds_byte(wr * 64 + fr, fq * 8), boff = lds_byte(wc * 32 + fr, fq * 8);
#define PG8_SA(b, h) (((b) * 2 + (h)) * HTB)
#define PG8_SB(b, h) ((4 + (b) * 2 + (h)) * HTB)
#define PG8_STAGE(bufoff, gbase, voff) do { _Pragma("unroll") for (int _i = 0; _i < 2; ++_i) \
        __builtin_amdgcn_global_load_lds((const unsigned*)((const char*)(gbase) + (voff)[_i]), (LAS unsigned*)(lds + (bufoff) + ldsw + _i * 8192), 16, 0, 0); } while (0)
#define PG8_LDA(dst, b, h) do { _Pragma("unroll") for (int m = 0; m < 4; ++m) _Pragma("unroll") for (int k = 0; k < 2; ++k) dst[m][k] = *(const LAS bf16x8*)(lds + PG8_SA(b, h) + aoff + m * 2048 + k * 1024); } while (0)
#define PG8_LDB(dst, b, h) do { _Pragma("unroll") for (int n = 0; n < 2; ++n) _Pragma("unroll") for (int k = 0; k < 2; ++k) dst[n][k] = *(const LAS bf16x8*)(lds + PG8_SB(b, h) + boff + n * 2048 + k * 1024); } while (0)
#define PG8_MMA(ai, bj, At, Bt) do { __builtin_amdgcn_s_setprio(1); _Pragma("unroll") for (int m = 0; m < 4; ++m) _Pragma("unroll") for (int n = 0; n < 2; ++n) _Pragma("unroll") for (int k = 0; k < 2; ++k) \
        acc[ai][bj][m][n] = __builtin_amdgcn_mfma_f32_16x16x32_bf16(Bt[n][k], At[m][k], acc[ai][bj][m][n], 0, 0, 0); __builtin_amdgcn_s_setprio(0); } while (0)
#define PG8_WAIT_V(n) asm volatile("s_waitcnt vmcnt(" #n ")" ::: "memory")
#define PG8_WAIT_L(n) asm volatile("s_waitcnt lgkmcnt(" #n ")" ::: "memory")
#define PG8_BAR __builtin_amdgcn_s_barrier()
#define PG8_SCHED __builtin_amdgcn_sched_barrier(0)
    Unit cur, nxt; int ui = 0;
    if (!S.next(0, cur)) return;
    f32x4 acc[2][2][4][2];
#pragma unroll
    for (int a = 0; a < 2; ++a)
#pragma unroll
        for (int b = 0; b < 2; ++b)
#pragma unroll
            for (int m = 0; m < 4; ++m)
#pragma unroll
                for (int n = 0; n < 2; ++n) acc[a][b][m][n] = (f32x4){0.f, 0.f, 0.f, 0.f};
    bf16x8 At[4][2], B0[2][2], B1[2][2];
    const char* cA = (const char*)g.A + (size_t)cur.pm * tstep; const char* cB = (const char*)g.Bt + (size_t)cur.pn * tstep;
    S.a_ready(cur);
    PG8_STAGE(PG8_SB(0, 0), cB, voffB); PG8_STAGE(PG8_SB(0, 1), cB + hstep, voffB); PG8_STAGE(PG8_SA(0, 0), cA, voffA); PG8_STAGE(PG8_SA(0, 1), cA + hstep, voffA);
    if (wr == 1) PG8_BAR;
    PG8_WAIT_V(2); PG8_BAR;
    PG8_STAGE(PG8_SB(1, 0), cB + kstep, voffB); PG8_STAGE(PG8_SA(1, 0), cA + kstep, voffA); PG8_STAGE(PG8_SB(1, 1), cB + hstep + kstep, voffB);
    PG8_WAIT_V(6); PG8_BAR;
    for (;;) {
        const bool has_next = S.next(ui + 1, nxt);
        const char* nA = has_next ? (const char*)g.A + (size_t)nxt.pm * tstep : cA; const char* nB = has_next ? (const char*)g.Bt + (size_t)nxt.pn * tstep : cB;
        for (int t = 0; t < nt; t += 2) {
            const bool last = (t == nt - 2);
            const char* a1 = cA + (size_t)(t + 1) * kstep;
            const char* a2 = last ? nA : cA + (size_t)(t + 2) * kstep; const char* b2 = last ? nB : cB + (size_t)(t + 2) * kstep;
            const char* a3 = a2 + kstep; const char* b3 = b2 + kstep;
            if (last && has_next) S.a_ready(nxt);
            if constexpr (Epi::HAS_MID) { if (t == E.mid_t) E.mid(acc, cur, wr, wc, fr, fq); }
            PG8_LDB(B0, 0, 0); PG8_LDB(B1, 0, 1); PG8_SCHED; PG8_LDA(At, 0, 0); PG8_STAGE(PG8_SA(1, 1), a1 + hstep, voffA);
            PG8_WAIT_V(8); PG8_WAIT_L(0); PG8_BAR; PG8_MMA(0, 0, At, B0); PG8_MMA(0, 1, At, B1); PG8_BAR; PG8_SCHED;
            PG8_LDA(At, 0, 1); PG8_STAGE(PG8_SB(0, 0), b2, voffB); PG8_STAGE(PG8_SB(0, 1), b2 + hstep, voffB); PG8_STAGE(PG8_SA(0, 0), a2, voffA);
            PG8_WAIT_V(8); PG8_WAIT_L(0); PG8_BAR; PG8_MMA(1, 0, At, B0); PG8_MMA(1, 1, At, B1); PG8_BAR; PG8_SCHED;
            PG8_LDB(B0, 1, 0); PG8_LDB(B1, 1, 1); PG8_SCHED; PG8_LDA(At, 1, 0); PG8_STAGE(PG8_SA(0, 1), a2 + hstep, voffA);
            PG8_WAIT_V(8); PG8_WAIT_L(0); PG8_BAR; PG8_MMA(0, 0, At, B0); PG8_MMA(0, 1, At, B1); PG8_BAR; PG8_SCHED;
            PG8_LDA(At, 1, 1); PG8_STAGE(PG8_SB(1, 0), b3, voffB); PG8_STAGE(PG8_SB(1, 1), b3 + hstep, voffB); PG8_STAGE(PG8_SA(1, 0), a3, voffA);
            PG8_WAIT_V(8); PG8_WAIT_L(0); PG8_BAR; PG8_MMA(1, 0, At, B0); PG8_MMA(1, 1, At, B1); PG8_BAR; PG8_SCHED;
        }
        if (wr == 0) PG8_BAR;
        E(acc, cur, wr, wc, fr, fq); S.done(cur);
        if (!has_next) break;
#pragma unroll
        for (int a = 0; a < 2; ++a)
#pragma unroll
            for (int b = 0; b < 2; ++b)
#pragma unroll
                for (int m = 0; m < 4; ++m)
#pragma unroll
                    for (int n = 0; n < 2; ++n) acc[a][b][m][n] = (f32x4){0.f, 0.f, 0.f, 0.f};
        cur = nxt; cA = nA; cB = nB; ++ui;
        if (wr == 1) PG8_BAR;
    }
    PG8_WAIT_V(0);
    PG8_BAR;
#undef PG8_SA
#undef PG8_SB
#undef PG8_STAGE
#undef PG8_LDA
#undef PG8_LDB
#undef PG8_MMA
#undef PG8_WAIT_V
#undef PG8_WAIT_L
#undef PG8_BAR
#undef PG8_SCHED
}
__device__ __forceinline__ float row_rt(const float* ssq, const float* ssqs, int row) {
    float s;
    if (row < MP) { const f32x4* sp = (const f32x4*)(ssq + (size_t)row * 16); const f32x4 s0 = sp[0], s1 = sp[1], s2 = sp[2], s3 = sp[3];
        s = ((s0[0] + s0[1]) + (s0[2] + s0[3])) + ((s1[0] + s1[1]) + (s1[2] + s1[3])) + ((s2[0] + s2[1]) + (s2[2] + s2[3])) + ((s3[0] + s3[1]) + (s3[2] + s3[3])); }
    else { const f32x4* sp = (const f32x4*)(ssqs + (size_t)(row - MP) * 32); s = 0.f;
#pragma unroll
        for (int i = 0; i < 8; ++i) { const f32x4 v = sp[i]; s += (v[0] + v[1]) + (v[2] + v[3]); } }
    return 1.0f / sqrtf(s * (1.0f / DM) + EPS);
}
typedef f32x4 Acc[2][2][4][2];

struct EpiGU {
    static constexpr bool PERM = true, HAS_MID = false;
    bf16_t* ACT; const float* ssq; const float* shiftW; int ldsw; const float* ssqs;
    __device__ __forceinline__ void operator()(const Acc& acc, const Unit& u, int wr, int wc, int fr, int fq) const {
        const int cl = wc * 32 + 8 * fq;
#pragma unroll
        for (int ai = 0; ai < 2; ++ai)
#pragma unroll
            for (int m = 0; m < 4; ++m) {
                const int row = u.pm * BM + ai * HALF + wr * 64 + m * 16 + fr;
                float rt = 1.f; f32x4 sg[2], sv[2]; sg[0] = sg[1] = sv[0] = sv[1] = (f32x4){0.f, 0.f, 0.f, 0.f};
                if (ssq) {
                    rt = row_rt(ssq, ssqs, row);
                    const float* sw = shiftW + (size_t)bidx_of_row(row) * ldsw + u.pn * BM + cl;
                    sg[0] = *(const f32x4*)(sw); sg[1] = *(const f32x4*)(sw + 4); sv[0] = *(const f32x4*)(sw + HALF); sv[1] = *(const f32x4*)(sw + HALF + 4);
                }
                u32x4 w;
#pragma unroll
                for (int n = 0; n < 2; ++n) {
                    const f32x4 gv = acc[ai][0][m][n] * rt + sg[n], vv = acc[ai][1][m][n] * rt + sv[n];
                    const float a0 = siluf_(gv[0]) * vv[0], a1 = siluf_(gv[1]) * vv[1], a2 = siluf_(gv[2]) * vv[2], a3 = siluf_(gv[3]) * vv[3];
                    w[2 * n] = pk2(a0, a1); w[2 * n + 1] = pk2(a2, a3);
                }
                *(u32x4*)(ACT + (size_t)row * DFF + u.pn * HALF + cl) = w;
            }
    }
};
template <bool HAS_A> struct EpiRes {
    static constexpr bool PERM = false, HAS_MID = false;
    const float* res_p; const float* res_s;
    float* out_p; float* out_s;
    const float* modv; int gsub;
    bf16_t* Aout; const float* gnorm; int ssub;
    float* ssq;
    float* ssqs;
    float gfac;
    template <int NQ> __device__ __forceinline__ float rowq(int row, int pn, int cb, const f32x4 q00, const f32x4 q01, const f32x4 q10, const f32x4 q11) const {
        const bool live = row < MTOT;
        const int bi = bidx_of_row(row);
        const float* rp = row < MP ? res_p + (size_t)row * DM : res_s + (size_t)(live ? row - MP : 0) * DM;
        float* op = row < MP ? out_p + (size_t)row * DM : out_s + (size_t)(live ? row - MP : 0) * DM;
        const float* gp = modp(modv, bi, gsub, 2); const float* scp = modp(modv, bi, ssub, 1);
        const float gf = gfac; bf16_t* const ao = Aout; const float* const gnp = gnorm;
        float sq = 0.f;
#pragma unroll
        for (int bj = 0; bj < 2; ++bj)
#pragma unroll
            for (int n = 0; n < NQ; ++n) {
                const int c = pn * BM + bj * HALF + cb + n * 16;
                const f32x4 r4 = *(const f32x4*)(rp + c), g4 = *(const f32x4*)(gp + c);
                const f32x4 qv = bj == 0 ? (n == 0 ? q00 : q01) : (n == 0 ? q10 : q11);
                const f32x4 h = r4 + (g4 * gf) * qv;
                if (live) *(f32x4*)(op + c) = h;
                sq += (h[0] * h[0] + h[1] * h[1]) + (h[2] * h[2] + h[3] * h[3]);
                if constexpr (HAS_A) { const f32x4 gn = *(const f32x4*)(gnp + c), sc = *(const f32x4*)(scp + c); const f32x4 a = h * gn * (sc + 1.0f);
                    u32x2 w; w.x = pk2(a[0], a[1]); w.y = pk2(a[2], a[3]); if (live) *(u32x2*)(ao + (size_t)row * DM + c) = w; }
            }
        return sq;
    }
    __device__ __forceinline__ void operator()(const Acc& acc, const Unit& u, int wr, int wc, int fr, int fq) const {
#pragma unroll
        for (int ai = 0; ai < 2; ++ai)
#pragma unroll
            for (int m = 0; m < 4; ++m) {
                const int row = u.pm * BM + ai * HALF + wr * 64 + m * 16 + fr;
                float sq = rowq<2>(row, u.pn, wc * 32 + 4 * fq, acc[ai][0][m][0], acc[ai][0][m][1], acc[ai][1][m][0], acc[ai][1][m][1]);
                if (ssq) { sq += __shfl_xor(sq, 16); sq += __shfl_xor(sq, 32); if (fq == 0) ssq[(size_t)row * 16 + u.pn * 4 + wc] = sq; }
            }
    }
    __device__ __forceinline__ void thin(int row, int pn, int h, int t, int fq, const f32x4 (&q)[2][1]) const {
        float sq = rowq<1>(row, pn, h * 64 + t * 16 + 4 * fq, q[0][0], q[0][0], q[1][0], q[1][0]);
        if (ssqs) { sq += __shfl_xor(sq, 16); sq += __shfl_xor(sq, 32); if (fq == 0) ssqs[(size_t)(row - MP) * 32 + (pn * 2 + h) * 4 + t] = sq; }
    }
};
struct EpiStoreBf16 {
    static constexpr bool PERM = true, HAS_MID = false;
    bf16_t* O; int ldc;
    __device__ __forceinline__ void thin(int row, int pn, int h, int t, int fq, const f32x4 (&q)[2][1]) const {
#pragma unroll
        for (int bj = 0; bj < 2; ++bj) { const f32x4 v = q[bj][0]; u32x2 w; w.x = pk2(v[0], v[1]); w.y = pk2(v[2], v[3]); *(u32x2*)(O + (size_t)row * ldc + pn * BM + bj * HALF + h * 64 + t * 16 + 4 * fq) = w; }
    }
    __device__ __forceinline__ void operator()(const Acc& acc, const Unit& u, int wr, int wc, int fr, int fq) const {
#pragma unroll
        for (int ai = 0; ai < 2; ++ai)
#pragma unroll
            for (int m = 0; m < 4; ++m) { const int row = u.pm * BM + ai * HALF + wr * 64 + m * 16 + fr;
#pragma unroll
                for (int bj = 0; bj < 2; ++bj) { const f32x4 v0 = acc[ai][bj][m][0], v1 = acc[ai][bj][m][1]; u32x4 w; w.x = pk2(v0[0], v0[1]); w.y = pk2(v0[2], v0[3]); w.z = pk2(v1[0], v1[1]); w.w = pk2(v1[2], v1[3]);
                    *(u32x4*)(O + (size_t)row * ldc + u.pn * BM + bj * HALF + wc * 32 + 8 * fq) = w; } }
    }
};
}

#define XB_TMO      128
#define XB_XCNT(j)  (256  + 64 * (j))
#define XB_XSUB(j)  (1280 + 64 * (j))
#define XB_XGEN(j)  (2304 + 64 * (j))
#define XB_TOP      3328
#define XB_TOPGEN   3392
#define XCD_BAR_WORDS 3456
#define XB_SPIN_CAP (1u << 18)
__device__ __forceinline__ unsigned xb_ld(unsigned* p)              { return __hip_atomic_load(p, __ATOMIC_RELAXED, __HIP_MEMORY_SCOPE_AGENT); }
__device__ __forceinline__ unsigned xb_add(unsigned* p, unsigned v) { return __hip_atomic_fetch_add(p, v, __ATOMIC_RELAXED, __HIP_MEMORY_SCOPE_AGENT); }
__device__ __forceinline__ unsigned xb_xcc_id() { return (unsigned)__builtin_amdgcn_s_getreg((3 << 11) | 20) & 0xFu; }
#define XB_SPIN(cond, bar) do { unsigned _sp = 0; while (cond) { __builtin_amdgcn_s_sleep(1); \
    if ((++_sp & 255u) == 0u) { if (xb_ld(&(bar)[XB_TMO])) break; if (_sp > XB_SPIN_CAP) { atomicAdd(&(bar)[XB_TMO], 1u); break; } } } } while (0)
struct XcdBarrier { unsigned* bar; unsigned x; volatile LAS unsigned* st; };
__device__ __forceinline__ XcdBarrier xcd_barrier_post(unsigned* bar, volatile LAS unsigned* st) {
    XcdBarrier b; b.bar = bar; b.x = xb_xcc_id(); b.st = st;
    if (threadIdx.x == 0) (void)xb_add(&bar[XB_XCNT(b.x)], 1u);
    return b;
}
__device__ __forceinline__ void xcd_barrier_complete(unsigned* bar, unsigned x, unsigned& nloc, unsigned& nx) {
    const unsigned G = gridDim.x * gridDim.y * gridDim.z;
    unsigned sum, cnt, mine, sp = 0u;
    for (;;) {
        sum = 0u; cnt = 0u; mine = 0u;
#pragma unroll
        for (unsigned j = 0; j < 16; ++j) { const unsigned c = xb_ld(&bar[XB_XCNT(j)]); sum += c; cnt += (c > 0u) ? 1u : 0u; mine = (j == x) ? c : mine; }
        if (sum == G) break;
        __builtin_amdgcn_s_sleep(1);
        if ((++sp & 255u) == 0u) { if (xb_ld(&bar[XB_TMO])) break; if (sp > XB_SPIN_CAP) { atomicAdd(&bar[XB_TMO], 1u); break; } }
    }
    nloc = mine > 0u ? mine : 1u; nx = cnt > 0u ? cnt : 1u;
}
__device__ __forceinline__ void xcd_barrier(const XcdBarrier& b) {
    asm volatile("s_waitcnt vmcnt(0)" ::: "memory");
    __syncthreads();
    if (threadIdx.x == 0) {
        unsigned* bar = b.bar;
        __builtin_amdgcn_s_waitcnt(0);
        unsigned nloc = b.st[0], nx = b.st[1];
        if (nloc == 0u) { xcd_barrier_complete(bar, b.x, nloc, nx); b.st[0] = nloc; b.st[1] = nx; }
        const unsigned old = xb_add(&bar[XB_XSUB(b.x)], 1u);
        const unsigned gen = old / nloc;
        if (old + 1u == (gen + 1u) * nloc) {
            __builtin_amdgcn_fence(__ATOMIC_RELEASE, "agent");
            asm volatile("s_waitcnt vmcnt(0)" ::: "memory");
            const unsigned og = xb_add(&bar[XB_TOP], 1u);
            const unsigned tg = og / nx;
            if (og + 1u == (tg + 1u) * nx) xb_add(&bar[XB_TOPGEN], 1u);
            else XB_SPIN(xb_ld(&bar[XB_TOPGEN]) == tg, bar);
            __builtin_amdgcn_fence(__ATOMIC_ACQUIRE, "agent");
            xb_add(&bar[XB_XGEN(b.x)], 1u);
            asm volatile("s_waitcnt vmcnt(0)" ::: "memory");
        } else {
            XB_SPIN(xb_ld(&bar[XB_XGEN(b.x)]) == gen, bar);
            __builtin_amdgcn_fence(__ATOMIC_ACQUIRE, "agent");
            asm volatile("s_waitcnt vmcnt(0)" ::: "memory");
        }
    }
    __syncthreads();
}

constexpr int NWAVES = 8, NTHR = 512;
constexpr int RING_BYTES = 131072, LDSCTL_OFF = RING_BYTES, MISC_OFF = LDSCTL_OFF + 320, LDS_BYTES = 147456;
#define LDS_WAIT() asm volatile("s_waitcnt lgkmcnt(0)" ::: "memory")

struct Args {
    const float* in[26]; float* out; unsigned char* ws; int ph_lo, ph_hi, li, pad;
};
struct Ctx {
    LAS unsigned char* lds; int tid, lane, wave, vcu, G, gw, NGW;
};

__device__ __forceinline__ void ada_item(const Ctx& X, int it, const float* cp, const float* cs, const float* w_ada, const float* b_ada, float* modv) {
    const int j0 = it * 64, w = X.wave, lane = X.lane, kr = lane >> 4, c4 = lane & 15;
    LAS float* sl = (LAS float*)X.lds + w * (18 * 128);
    LAS float* part = (LAS float*)(X.lds + 73728);
    for (int rh = 0; rh < 2; ++rh) {
        for (int idx = lane; idx < 18 * 128; idx += 64) { const int r = rh * 18 + idx / 128, kk = idx % 128, k = w * 128 + kk;
            const float cv = r < NBP ? cp[r * DM + k] : cs[(r - NBP) * DM + k]; sl[idx] = cv / (1.0f + __expf(-cv)); }
        LDS_WAIT(); __syncthreads();
        f32x4 acc[18];
#pragma unroll
        for (int r = 0; r < 18; ++r) acc[r] = (f32x4){0.f, 0.f, 0.f, 0.f};
        const float* wp = w_ada + (size_t)(w * 128 + kr) * NMOD + j0 + 4 * c4;
#pragma unroll 8
        for (int i = 0; i < 32; ++i) { const f32x4 wv = *(const f32x4*)(wp + (size_t)(4 * i) * NMOD);
#pragma unroll
            for (int r = 0; r < 18; ++r) acc[r] += wv * sl[r * 128 + 4 * i + kr]; }
#pragma unroll
        for (int r = 0; r < 18; ++r) {
#pragma unroll
            for (int e = 0; e < 4; ++e) { float v = acc[r][e]; v += __shfl_xor(v, 16); v += __shfl_xor(v, 32); acc[r][e] = v; }
            if (kr == 0) *(LAS f32x4*)(part + (w * 18 + r) * 64 + 4 * c4) = acc[r]; }
        LDS_WAIT(); __syncthreads();
        for (int o = X.tid; o < 18 * 64; o += NTHR) { const int r = o / 64, j = o % 64; float sum = b_ada[j0 + j];
#pragma unroll
            for (int ww = 0; ww < 8; ++ww) sum += part[(ww * 18 + r) * 64 + j];
            modv[(size_t)(rh * 18 + r) * NMOD + j0 + j] = sum; }
        __syncthreads();
    }
}
struct TJ { int src, srcoff_stride, N, K, col0, col_stride, ncols, dst, dpitch, drow0, drow_stride, dcol0, rep; };
__constant__ TJ kJobs[] = {
    {12, 0, NGU, DM, 0,    128, 128, 0, DM, 0,   256, 0, 22},
    {12, 0, NGU, DM, DFF,  128, 128, 0, DM, 128, 256, 0, 22},
    {13, 0, DM, DFF, 0, 0, DM, 1, DFF, 0, 0, 0, 1},
    {16, 0, INW, DM, 0,    0, 1280, 2, DM, 0, 0, 0, 1},
    {16, 0, INW, DM, 1304, 128, 128, 2, DM, 1280, 256, 0, 4},
    {16, 0, INW, DM, 2328, 128, 128, 2, DM, 1408, 256, 0, 4},
    {16, 0, INW, DM, 1816, 0, 512, 2, DM, 2304, 0, 0, 1},
    {16, 0, INW, DM, 2840, 128, 128, 2, DM, 2816, 256, 0, 8},
    {16, 0, INW, DM, 3864, 128, 128, 2, DM, 2944, 256, 0, 8},
    {16, 0, INW, DM, 1280, 0, 24, 2, DM, 4864, 0, 0, 1},
    {21, 0, DM, 512, 0, 0, DM, 3, DM, 0, 0, 0, 1},
    {22, 0, DM, 512, 0, 0, DM, 3, DM, 0, 0, 512, 1},
    {23, 0, DM, DM, 0, 0, DM, 4, DM, 0, 0, 0, 1},
    {14, 0, NGU, DM, 0,    128, 128, 5, DM, 0,   256, 0, 22},
    {14, 0, NGU, DM, DFF,  128, 128, 5, DM, 128, 256, 0, 22},
    {15, 0, DM, DFF, 0, 0, DM, 6, DFF, 0, 0, 0, 1},
    {17, 1024 * 128, 128, DM, 0, 0, 128, 7, DM, 0, 128, 0, 4},
};
constexpr int NJOBS = sizeof(kJobs) / sizeof(TJ);
__device__ __forceinline__ int tj_items(const TJ& j) { return j.rep * (j.K / 64) * ((j.ncols + 63) / 64); }
__device__ __forceinline__ void transpose_item(const float* W, int N, int ncols, bf16_t* WT, int dpitch, LAS float* scr, int kb, int nb, int lane) {
    const int k0 = 64 * kb, n0 = 64 * nb, kr = lane >> 4, c4 = lane & 15; const bool okc = (n0 + 4 * c4) < ncols;
    f32x4 v[16];
#pragma unroll
    for (int i = 0; i < 16; ++i) v[i] = okc ? *(const f32x4*)(W + (size_t)(k0 + 4 * i + kr) * N + n0 + 4 * c4) : (f32x4){0.f, 0.f, 0.f, 0.f};
#pragma unroll
    for (int i = 0; i < 16; ++i) { const int k = 4 * i + kr; *(LAS f32x4*)(scr + k * 64 + ((4 * c4 + 4 * (k >> 3)) & 63)) = v[i]; }
    LDS_WAIT(); asm volatile("" ::: "memory");
    const int c = lane & 7, nl = lane >> 3;
#pragma unroll
    for (int j = 0; j < 8; ++j) { const int n = nl + 8 * j; const LAS float* sp = scr + (8 * c) * 64 + ((n + 4 * c) & 63);
        u32x4 o; o.x = pk2(sp[0 * 64], sp[1 * 64]); o.y = pk2(sp[2 * 64], sp[3 * 64]); o.z = pk2(sp[4 * 64], sp[5 * 64]); o.w = pk2(sp[6 * 64], sp[7 * 64]);
        if (n0 + n < ncols) *(u32x4*)(WT + (size_t)(n0 + n) * dpitch + k0 + 8 * c) = o; }
    LDS_WAIT(); asm volatile("" ::: "memory");
}
__device__ __forceinline__ bf16_t* wdst(unsigned char* ws, int id) {
    const size_t off = id == 0 ? WS_WGU1 : id == 1 ? WS_WD1 : id == 2 ? WS_WIN : id == 3 ? WS_WM : id == 4 ? WS_WO : id == 5 ? WS_WGU2 : id == 6 ? WS_WD2 : WS_WC1;
    return (bf16_t*)(ws + off);
}

struct EpiIn {
    static constexpr bool PERM = false, HAS_MID = false;
    const float* ssq; const float* ssqs; const float* shiftW; float* out; unsigned char* ws;
    template <int CASE, int NQ> __device__ __forceinline__ void rowq(int row, int pn, int cb, const f32x4 (&q)[2][NQ]) const {
        using namespace pg8;
        const bool live = row < MTOT, isp = row < MP;
        const float rt = row_rt(ssq, ssqs, row);
        const float* sw = shiftW + (size_t)bidx_of_row(row) * INWP + pn * BM + cb;
        const int b = isp ? (row >> 12) : ((row - MP) >> 2), t = isp ? (row & (TP - 1)) : ((row - MP) & 3);
#define PV(bj, n) (q[bj][n] * rt + *(const f32x4*)(sw + (bj) * HALF + (n) * 16))
        if constexpr (CASE == 0) {
            bf16_t* Q = (bf16_t*)(ws + WS_Q) + (size_t)row * 512 + pn * BM + cb;
#pragma unroll
            for (int bj = 0; bj < 2; ++bj)
#pragma unroll
                for (int n = 0; n < NQ; ++n) { const f32x4 v = PV(bj, n) * QSCALE; u32x2 w; w.x = pk2(v[0], v[1]); w.y = pk2(v[2], v[3]); *(u32x2*)(Q + bj * HALF + n * 16) = w; }
        } else if constexpr (CASE >= 1 && CASE <= 3) {
            const size_t obase = CASE == 1 ? (isp ? O_KVC_P + (size_t)row * 256 : O_KVC_S + (size_t)(row - MP) * 256)
                               : CASE == 2 ? (isp ? O_KVS_P + (size_t)row * 256 : O_KVS_S + (size_t)(row - MP) * 256)
                               : (isp ? O_KVW_P + ((size_t)b * 512 + (t - (TP - 512))) * 256 : O_KVW_S + ((size_t)b * 512 + 508 + t) * 256);
            const bool wout = live && (CASE != 3 || !isp || t >= TP - 512);
#pragma unroll
            for (int bj = 0; bj < 2; ++bj)
#pragma unroll
                for (int n = 0; n < NQ; ++n) { const int j = bj * HALF + cb + n * 16; const f32x4 v = PV(bj, n);
                    if (wout) *(f32x4*)(out + obase + j) = v;
                    if (isp) { const int gg = (j >> 6) & 1, d = j & 63; u32x2 w; w.x = pk2(v[0], v[1]); w.y = pk2(v[2], v[3]);
                        if constexpr (CASE == 1) *(u32x2*)((bf16_t*)(ws + WS_ACP) + ((size_t)(bj * 8 + b * 2 + gg) * 256 + (t >> 4)) * 1024 + (t & 15) * 64 + d) = w;
                        else *(u32x2*)((bf16_t*)(ws + (CASE == 2 ? (bj ? WS_VS : WS_KS) : (bj ? WS_VW : WS_KW))) + (bj ? v_img(TP / 64, b * 2 + gg, t, d) : k_img(TP / 64, b * 2 + gg, t, d))) = w; } }
        } else if constexpr (CASE == 4) {
            const bool wout = live && (isp ? t >= TP - 2 : t >= 2);
            const size_t obase = isp ? O_CONV_P + ((size_t)b * 2 + (t - (TP - 2))) * 512 : O_CONV_S + ((size_t)b * 2 + (t - 2)) * 512;
#pragma unroll
            for (int n = 0; n < NQ; ++n) { const int j = (pn - 5) * HALF + cb + n * 16; const f32x4 v = PV(0, n) * PV(1, n);
                u32x2 w; w.x = pk2(v[0], v[1]); w.y = pk2(v[2], v[3]); *(u32x2*)((bf16_t*)(ws + WS_PROD) + (size_t)row * 512 + j) = w;
                if (wout) *(f32x4*)(out + obase + j) = v; }
        } else if constexpr (CASE == 5) {
#pragma unroll
            for (int bj = 0; bj < 2; ++bj)
#pragma unroll
                for (int n = 0; n < NQ; ++n) { const int j = (pn - 9) * BM + bj * HALF + cb + n * 16; const f32x4 v = PV(bj, n);
                    u32x2 w; w.x = pk2(v[0], v[1]); w.y = pk2(v[2], v[3]); *(u32x2*)((bf16_t*)(ws + WS_CB) + (size_t)row * 512 + j) = w; }
        } else if constexpr (CASE == 6) {
#pragma unroll
            for (int n = 0; n < NQ; ++n) { const int j = (pn - 11) * HALF + cb + n * 16; const f32x4 a = PV(0, n), bb = PV(1, n);
                float ra[4], gb[4];
#pragma unroll
                for (int e = 0; e < 4; ++e) { const float sa = sigmoidf_(a[e]), sb = sigmoidf_(bb[e]); gb[e] = sb; ra[e] = sa / sb; }
                u32x2 w; w.x = pk2(ra[0], ra[1]); w.y = pk2(ra[2], ra[3]); *(u32x2*)((bf16_t*)(ws + WS_RATIO) + (size_t)row * DM + j) = w;
                u32x2 w2; w2.x = pk2(gb[0], gb[1]); w2.y = pk2(gb[2], gb[3]); *(u32x2*)((bf16_t*)(ws + WS_GB) + (size_t)row * DM + j) = w2; }
        } else {
#pragma unroll
            for (int n = 0; n < NQ; ++n) { const int j = cb + n * 16; if (j < 24) { const f32x4 v = PV(0, n);
#pragma unroll
                for (int e = 0; e < 4; ++e) if (j + e < 24) ((float*)(ws + WS_GATES))[(size_t)row * 24 + j + e] = sigmoidf_(v[e]); } }
        }
#undef PV
    }
    template <int CASE> __device__ __forceinline__ void body(const pg8::Acc& acc, const pg8::Unit& u, int wr, int wc, int fr, int fq) const {
        using namespace pg8;
#pragma unroll
        for (int ai = 0; ai < 2; ++ai)
#pragma unroll
            for (int m = 0; m < 4; ++m) {
                const int row = u.pm * BM + ai * HALF + wr * 64 + m * 16 + fr;
                const f32x4 q[2][2] = {{acc[ai][0][m][0], acc[ai][0][m][1]}, {acc[ai][1][m][0], acc[ai][1][m][1]}};
                rowq<CASE, 2>(row, u.pn, wc * 32 + 4 * fq, q);
                asm volatile("" ::: "memory");
            }
    }
    __device__ __forceinline__ static int case_of(int pn) { return pn < 2 ? 0 : pn == 2 ? 1 : pn == 3 ? 2 : pn == 4 ? 3 : pn < 9 ? 4 : pn < 11 ? 5 : pn < 19 ? 6 : 7; }
    __device__ __forceinline__ void operator()(const pg8::Acc& acc, const pg8::Unit& u, int wr, int wc, int fr, int fq) const {
        const int cs = case_of(u.pn);
        if (cs == 0) body<0>(acc, u, wr, wc, fr, fq); else if (cs == 1) body<1>(acc, u, wr, wc, fr, fq); else if (cs == 2) body<2>(acc, u, wr, wc, fr, fq); else if (cs == 3) body<3>(acc, u, wr, wc, fr, fq);
        else if (cs == 4) body<4>(acc, u, wr, wc, fr, fq); else if (cs == 5) body<5>(acc, u, wr, wc, fr, fq); else if (cs == 6) body<6>(acc, u, wr, wc, fr, fq); else body<7>(acc, u, wr, wc, fr, fq);
    }
    __device__ __forceinline__ void thin(int row, int pn, int h, int t, int fq, const f32x4 (&q)[2][1]) const {
        const int cs = case_of(pn), cb = h * 64 + t * 16 + 4 * fq;
        if (cs == 0) rowq<0, 1>(row, pn, cb, q); else if (cs == 1) rowq<1, 1>(row, pn, cb, q); else if (cs == 2) rowq<2, 1>(row, pn, cb, q); else if (cs == 3) rowq<3, 1>(row, pn, cb, q);
        else if (cs == 4) rowq<4, 1>(row, pn, cb, q); else if (cs == 5) rowq<5, 1>(row, pn, cb, q); else if (cs == 6) rowq<6, 1>(row, pn, cb, q); else rowq<7, 1>(row, pn, cb, q);
    }
};

struct EpiMerge {
    static constexpr bool PERM = true, HAS_MID = true;
    int mid_t; const bf16_t* RAT; const bf16_t* GB; bf16_t* MERGED;
    __device__ __forceinline__ void mid(pg8::Acc& acc, const pg8::Unit& u, int wr, int wc, int fr, int fq) const {
        using namespace pg8;
        asm volatile("" : "+v"(fr), "+v"(fq));
#pragma unroll
        for (int ai = 0; ai < 2; ++ai)
#pragma unroll
            for (int m = 0; m < 4; ++m) { const int row = u.pm * BM + ai * HALF + wr * 64 + m * 16 + fr;
#pragma unroll
                for (int bj = 0; bj < 2; ++bj) { const u32x4 r = *(const u32x4*)(RAT + (size_t)row * DM + u.pn * BM + bj * HALF + wc * 32 + 8 * fq);
                    acc[ai][bj][m][0] *= (f32x4){bflo(r.x), bfhi(r.x), bflo(r.y), bfhi(r.y)}; acc[ai][bj][m][1] *= (f32x4){bflo(r.z), bfhi(r.z), bflo(r.w), bfhi(r.w)}; }
                asm volatile("" ::: "memory"); }
    }
    __device__ __forceinline__ void thin_mid(int row, int pn, int h, int t, int fq, f32x4 (&q)[2][1]) const {
#pragma unroll
        for (int bj = 0; bj < 2; ++bj) { const u32x2 r = *(const u32x2*)(RAT + (size_t)row * DM + pn * pg8::BM + bj * pg8::HALF + h * 64 + t * 16 + 4 * fq); q[bj][0] *= (f32x4){bflo(r.x), bfhi(r.x), bflo(r.y), bfhi(r.y)}; }
    }
    __device__ __forceinline__ void thin(int row, int pn, int h, int t, int fq, const f32x4 (&q)[2][1]) const {
#pragma unroll
        for (int bj = 0; bj < 2; ++bj) { const size_t off = (size_t)row * DM + pn * pg8::BM + bj * pg8::HALF + h * 64 + t * 16 + 4 * fq; const u32x2 r = *(const u32x2*)(GB + off);
            const f32x4 v = q[bj][0] * (f32x4){bflo(r.x), bfhi(r.x), bflo(r.y), bfhi(r.y)}; u32x2 w; w.x = pk2(v[0], v[1]); w.y = pk2(v[2], v[3]); *(u32x2*)(MERGED + off) = w; }
    }
    __device__ __forceinline__ void operator()(const pg8::Acc& acc, const pg8::Unit& u, int wr, int wc, int fr, int fq) const {
        using namespace pg8;
#pragma unroll
        for (int ai = 0; ai < 2; ++ai)
#pragma unroll
            for (int m = 0; m < 4; ++m) { const int row = u.pm * BM + ai * HALF + wr * 64 + m * 16 + fr;
#pragma unroll
                for (int bj = 0; bj < 2; ++bj) { const size_t off = (size_t)row * DM + u.pn * BM + bj * HALF + wc * 32 + 8 * fq; const u32x4 r = *(const u32x4*)(GB + off);
                    const f32x4 v0 = acc[ai][bj][m][0] * (f32x4){bflo(r.x), bfhi(r.x), bflo(r.y), bfhi(r.y)}, v1 = acc[ai][bj][m][1] * (f32x4){bflo(r.z), bfhi(r.z), bflo(r.w), bfhi(r.w)};
                    u32x4 w; w.x = pk2(v0[0], v0[1]); w.y = pk2(v0[2], v0[3]); w.z = pk2(v1[0], v1[1]); w.w = pk2(v1[2], v1[3]); *(u32x4*)(MERGED + off) = w; }
                asm volatile("" ::: "memory"); }
    }
};

__device__ __forceinline__ float gelu_tanh(float x) { const float u = 0.7978845608028654f * (x + 0.044715f * x * x * x); const float e = fast_exp2(2.0f * LOG2E * u); return 0.5f * x * (2.0f - 2.0f * fast_rcp(1.0f + e)); }
template <bool SAMPLE> __device__ __forceinline__ void cmp_tail_item(const Ctx& X, int item, unsigned char* ws, const float* w_cmp2, int& c_loaded) {
    constexpr int NR = SAMPLE ? 512 : 256, NCH = NR / 64, NBG = SAMPLE ? 64 : 8, NVALID = NR - 1;
    const int c = item / (NBG * NCH), bg = (item / NCH) % NBG, n0 = (item % NCH) * 64;
    LAS float* w2s = (LAS float*)X.lds; LAS float* hid = (LAS float*)(X.lds + 32768);
    const float* w2 = w_cmp2 + (size_t)c * 128 * 64; const float* pet = (const float*)(ws + WS_PETERM) + c * 128;
    const bf16_t* P = (const bf16_t*)(ws + (SAMPLE ? WS_PCS : WS_PCP)) + (size_t)c * (NBG * NR) * 256;
    if (c != c_loaded) { for (int i = X.tid; i < 128 * 64 / 4; i += NTHR) ((LAS f32x4*)w2s)[i] = ((const f32x4*)w2)[i]; c_loaded = c; }
#pragma unroll
    for (int k = 0; k < 2; ++k) { const int idx = X.tid + k * NTHR, r = idx >> 4, e8 = (idx & 15) * 8; const size_t base = (size_t)(bg * NR + n0 + r) * 256;
        const u32x4 a = *(const u32x4*)(P + base + e8), bb = *(const u32x4*)(P + base + 256 + 128 + e8); const f32x4 p0 = *(const f32x4*)(pet + e8), p1 = *(const f32x4*)(pet + e8 + 4);
#pragma unroll
        for (int j = 0; j < 4; ++j) { hid[r * 129 + e8 + 2 * j] = gelu_tanh(bflo(a[j]) + bflo(bb[j]) + (j < 2 ? p0[2 * j] : p1[2 * j - 4])); hid[r * 129 + e8 + 2 * j + 1] = gelu_tanh(bfhi(a[j]) + bfhi(bb[j]) + (j < 2 ? p0[2 * j + 1] : p1[2 * j - 3])); } }
    LDS_WAIT(); __syncthreads();
    const int r = X.tid >> 3, d0 = (X.tid & 7) * 8, n = n0 + r;
    float acc[8];
#pragma unroll
    for (int i = 0; i < 8; ++i) acc[i] = 0.f;
#pragma unroll 4
    for (int e = 0; e < 128; ++e) { const float h = hid[r * 129 + e]; const f32x4 wa = *(const LAS f32x4*)(w2s + e * 64 + d0), wb = *(const LAS f32x4*)(w2s + e * 64 + d0 + 4);
        acc[0] += h * wa[0]; acc[1] += h * wa[1]; acc[2] += h * wa[2]; acc[3] += h * wa[3]; acc[4] += h * wb[0]; acc[5] += h * wb[1]; acc[6] += h * wb[2]; acc[7] += h * wb[3]; }
    if constexpr (SAMPLE) {
        if (n < NVALID) { float* o = (float*)(ws + WS_KVCS) + (((size_t)bg * 512 + n) * 2 + c) * 64 + d0; *(f32x4*)o = (f32x4){acc[0], acc[1], acc[2], acc[3]}; *(f32x4*)(o + 4) = (f32x4){acc[4], acc[5], acc[6], acc[7]}; }
    } else {
        u32x4 w; if (n < NVALID) { w.x = pk2(acc[0], acc[1]); w.y = pk2(acc[2], acc[3]); w.z = pk2(acc[4], acc[5]); w.w = pk2(acc[6], acc[7]); } else w = (u32x4){0u, 0u, 0u, 0u};
        *(u32x4*)((bf16_t*)(ws + (c ? WS_VCP : WS_KCP)) + (c ? v_img(4, bg, n, d0) : k_img(4, bg, n, d0))) = w;
    }
    __syncthreads();
}

namespace att {
typedef float f32x16 __attribute__((ext_vector_type(16)));
typedef short s16x4 __attribute__((ext_vector_type(4)));
typedef float f32x2_t __attribute__((ext_vector_type(2))); typedef __bf16 bf16x2_t __attribute__((ext_vector_type(2)));
constexpr int L_K = 0, L_V = 24576, L_WSF = 49152, L_BIAS = 53248, L_GATE = 55296, L_SEL = 58368, L_ANY = 58880, L_PSLC = 59392, L_SC = 76288, L_OST = 92928, PL_LD = 66, SC_LD = 65;
static_assert(L_OST + 8 * 4096 <= RING_BYTES && L_SC + 64 * SC_LD * 4 <= L_OST && L_PSLC + 64 * PL_LD * 4 <= L_SC, "attention LDS map");
__constant__ unsigned char kBucket[128] = {0, 1, 2, 3, 4, 5, 6, 7, 8, 9, 10, 11, 12, 13, 14, 15, 16, 16, 16, 17, 17, 18, 18, 18, 19, 19, 19, 20, 20, 20, 20, 21, 21, 21, 21, 22, 22, 22, 22, 22, 23, 23, 23, 23, 23, 23, 24, 24, 24, 24, 24, 24, 25, 25, 25, 25, 25, 25, 25, 26, 26, 26, 26, 26, 26, 26, 26, 27, 27, 27, 27, 27, 27, 27, 27, 27, 27, 28, 28, 28, 28, 28, 28, 28, 28, 28, 28, 29, 29, 29, 29, 29, 29, 29, 29, 29, 29, 29, 29, 30, 30, 30, 30, 30, 30, 30, 30, 30, 30, 30, 30, 30, 30, 31, 31, 31, 31, 31, 31, 31, 31, 31, 31, 31, 31, 31, 31, 31};
__device__ __forceinline__ int crow(int r, int hi) { return (r & 3) + 8 * (r >> 2) + 4 * hi; }
__device__ __forceinline__ unsigned cvtpk_s(float lo, float hi) { f32x2_t v = {lo, hi}; bf16x2_t b = __builtin_convertvector(v, bf16x2_t); return __builtin_bit_cast(unsigned, b); }
#define ATT_SBAR() __builtin_amdgcn_sched_barrier(0)
__device__ __forceinline__ void qkt(f32x16& p0, f32x16& p1, const LAS unsigned char* Kslot, const bf16x8* qr, int r32, int hi, float cinit) {
    const LAS unsigned char* kb = Kslot + hi * 1024 + r32 * 16;
    f32x16 z;
#pragma unroll
    for (int r = 0; r < 16; ++r) z[r] = cinit;
    p0 = z; p1 = z;
#pragma unroll
    for (int d0 = 0; d0 < 4; ++d0) {
        const bf16x8 b0 = *(const LAS bf16x8*)(kb + d0 * 2048), b1 = *(const LAS bf16x8*)(kb + d0 * 2048 + 512);
        p0 = __builtin_amdgcn_mfma_f32_32x32x16_bf16(b0, qr[d0], p0, 0, 0, 0); p1 = __builtin_amdgcn_mfma_f32_32x32x16_bf16(b1, qr[d0], p1, 0, 0, 0); }
}
__device__ __forceinline__ float rowmax(const f32x16& p0, const f32x16& p1) {
    float a = fmaxf(p0[0], p1[0]);
#pragma unroll
    for (int r = 1; r < 16; ++r) a = fmaxf(a, fmaxf(p0[r], p1[r]));
    auto rr = __builtin_amdgcn_permlane32_swap(__float_as_uint(a), __float_as_uint(a), false, false);
    return fmaxf(__uint_as_float(rr[0]), __uint_as_float(rr[1]));
}
__device__ __forceinline__ float halfsum(float a) { auto rr = __builtin_amdgcn_permlane32_swap(__float_as_uint(a), __float_as_uint(a), false, false); return __uint_as_float(rr[0]) + __uint_as_float(rr[1]); }
__device__ __forceinline__ void pv(f32x16* o, int vb, bf16x8 pa0, bf16x8 pa1, bf16x8 pa2, bf16x8 pa3) {
#pragma unroll
    for (int d0 = 0; d0 < 2; ++d0) { s16x4 lo[4], hi[4];
#pragma unroll
        for (int ks = 0; ks < 4; ++ks) {
            asm volatile("ds_read_b64_tr_b16 %0,%1 offset:%c2" : "=&v"(lo[ks]) : "v"(vb), "i"(d0 * 4096 + ks * 1024) : "memory");
            asm volatile("ds_read_b64_tr_b16 %0,%1 offset:%c2" : "=&v"(hi[ks]) : "v"(vb), "i"(d0 * 4096 + ks * 1024 + 512) : "memory"); }
        asm volatile("s_waitcnt lgkmcnt(0)" ::: "memory"); ATT_SBAR();
#define ATT_PK(k) (bf16x8){lo[k][0], lo[k][1], lo[k][2], lo[k][3], hi[k][0], hi[k][1], hi[k][2], hi[k][3]}
        o[d0] = __builtin_amdgcn_mfma_f32_32x32x16_bf16(pa0, ATT_PK(0), o[d0], 0, 0, 0);
        o[d0] = __builtin_amdgcn_mfma_f32_32x32x16_bf16(pa1, ATT_PK(1), o[d0], 0, 0, 0);
        o[d0] = __builtin_amdgcn_mfma_f32_32x32x16_bf16(pa2, ATT_PK(2), o[d0], 0, 0, 0);
        o[d0] = __builtin_amdgcn_mfma_f32_32x32x16_bf16(pa3, ATT_PK(3), o[d0], 0, 0, 0);
#undef ATT_PK
    }
}
__device__ __forceinline__ void tile_dma(const bf16_t* Kt, const bf16_t* Vt, LAS unsigned char* lds, int slot, int wid, int lane) {
    __builtin_amdgcn_global_load_lds((const unsigned*)((const char*)Kt + wid * 1024 + lane * 16), (LAS unsigned*)(lds + L_K + slot * 8192 + wid * 1024), 16, 0, 0);
    __builtin_amdgcn_global_load_lds((const unsigned*)((const char*)Vt + wid * 1024 + lane * 16), (LAS unsigned*)(lds + L_V + slot * 8192 + wid * 1024), 16, 0, 0);
}
struct SM { float m, l; f32x16 o[2]; };
__device__ __forceinline__ void sm_init(SM& s) { s.m = -1e30f; s.l = 0.f;
#pragma unroll
    for (int r = 0; r < 16; ++r) { s.o[0][r] = 0.f; s.o[1][r] = 0.f; } }
template <bool WITH_O> __device__ __forceinline__ void sm_update(SM& s, f32x16& p0, f32x16& p1, LAS float* wsf, int r32, int hi, bool lm) {
    float rm = rowmax(p0, p1); rm = lm ? rm : -INFINITY;
    if (__any(rm > s.m + 8.0f)) {
        const float mnew = fmaxf(s.m, rm), alpha = fast_exp2(s.m - mnew); s.l *= alpha;
        if constexpr (WITH_O) { if (hi == 0) wsf[r32] = alpha; LDS_WAIT();
#pragma unroll
            for (int r = 0; r < 16; ++r) { const float f = wsf[crow(r, hi)]; s.o[0][r] *= f; s.o[1][r] *= f; }
            LDS_WAIT(); }
        s.m = mnew;
    }
    const float meff = lm ? s.m : INFINITY;
    float sum = 0.f;
#pragma unroll
    for (int r = 0; r < 16; ++r) { p0[r] = fast_exp2(p0[r] - meff); p1[r] = fast_exp2(p1[r] - meff); sum += p0[r] + p1[r]; }
    s.l += sum;
}
template <int MODE> __device__ __forceinline__ void mask_bias(f32x16& p0, f32x16& p1, int T, bool lsel, int qpos, int hi, const LAS float* bT) {
    const float NEG = -INFINITY;
    int base = MODE == 0 ? qpos - 1024 * T - 64 * hi - 31 : qpos - 64 * T - 4 * hi;
    asm volatile("" : "+v"(base));
#pragma unroll
    for (int r = 0; r < 16; ++r) { const int kk = (r & 3) + 8 * (r >> 2); int d0, d1; bool v0, v1;
        if (MODE == 0) { d0 = base - 16 * kk; d1 = d0 - 512; v0 = d0 >= 0; v1 = d1 >= 0; }
        else { d0 = base - kk; d1 = d0 - 32; if (MODE == 1) { v0 = lsel && d0 >= 0; v1 = lsel && d1 >= 0; } else { v0 = d0 >= 0 && d0 < 512; v1 = d1 >= 0 && d1 < 512; } }
        const float b0 = bT[min(max(d0, 0), 127)], b1 = bT[min(max(d1, 0), 127)];
        p0[r] = v0 ? p0[r] + b0 : NEG; p1[r] = v1 ? p1[r] + b1 : NEG; }
}
#define ATT_PACK(pw, P, B) pw = (u32x4){cvtpk_s(P[B], P[B + 1]), cvtpk_s(P[B + 2], P[B + 3]), cvtpk_s(P[B + 4], P[B + 5]), cvtpk_s(P[B + 6], P[B + 7])}
#define ATT_PV(S_, SLOT) do { u32x4 pw0, pw1, pw2, pw3; ATT_PACK(pw0, p0, 0); ATT_PACK(pw1, p0, 8); ATT_PACK(pw2, p1, 0); ATT_PACK(pw3, p1, 8); ATT_SBAR(); \
    pv((S_).o, vb0 + (SLOT) * 8192, __builtin_bit_cast(bf16x8, pw0), __builtin_bit_cast(bf16x8, pw1), __builtin_bit_cast(bf16x8, pw2), __builtin_bit_cast(bf16x8, pw3)); } while (0)
#define ATT_TILE_LOOP(NT, FIRST, NEXT, KB, VB, ...) do { const int nt_ = (NT); int t0_ = (FIRST), t1_ = t0_, t2_ = t0_; \
    tile_dma((KB) + (size_t)t0_ * 4096, (VB) + (size_t)t0_ * 4096, lds, 0, wid, lane); \
    if (nt_ > 1) { int tcur_ = t0_; (void)tcur_; t1_ = (NEXT); tile_dma((KB) + (size_t)t1_ * 4096, (VB) + (size_t)t1_ * 4096, lds, 1, wid, lane); } \
    for (int i_ = 0; i_ < nt_; ++i_) { \
        if (i_ + 1 < nt_) asm volatile("s_waitcnt vmcnt(2) lgkmcnt(0)" ::: "memory"); else asm volatile("s_waitcnt vmcnt(0) lgkmcnt(0)" ::: "memory"); \
        __builtin_amdgcn_s_barrier(); asm volatile("" ::: "memory"); \
        if (i_ + 2 < nt_) { int tcur_ = t1_; (void)tcur_; t2_ = (NEXT); tile_dma((KB) + (size_t)t2_ * 4096, (VB) + (size_t)t2_ * 4096, lds, (i_ + 2) % 3, wid, lane); } \
        { const int T = t0_; const int SLOT = i_ % 3; __VA_ARGS__ } \
        t0_ = t1_; t1_ = t2_; } \
    asm volatile("s_waitcnt lgkmcnt(0)" ::: "memory"); __builtin_amdgcn_s_barrier(); asm volatile("" ::: "memory"); } while (0)
#define ATT_FINISH(S_, BR) do { const float lt_ = halfsum((S_).l); const float inv_ = lt_ > 0.f ? 1.0f / lt_ : 0.f; \
    if (hi == 0) wsf[64 + r32] = inv_ * gt[qloc * 12 + (BR) * 4 + hh]; LDS_WAIT(); \
    _Pragma("unroll") for (int r = 0; r < 16; ++r) { const float f = wsf[64 + crow(r, hi)]; oacc[0][r] += (S_).o[0][r] * f; oacc[1][r] += (S_).o[1][r] * f; } LDS_WAIT(); asm volatile("" : "+v"(oacc[0]), "+v"(oacc[1])); } while (0)

__device__ __forceinline__ void prompt_item(const Ctx& X, int bg, int qt, unsigned char* ws, const float* rel_bias) {
    LAS unsigned char* lds = X.lds; int tid = X.tid; asm volatile("" : "+v"(tid));
    const int lane = tid & 63, wid = __builtin_amdgcn_readfirstlane(tid >> 6), r32 = lane & 31, hi = lane >> 5;
    const int b = bg >> 1, g = bg & 1, hh = wid >> 1, qh = wid & 1, q0 = qt * 64, qloc = qh * 32 + r32, qpos = q0 + qloc;
    LAS float* biasT = (LAS float*)(lds + L_BIAS); LAS float* gt = (LAS float*)(lds + L_GATE); LAS float* pslc = (LAS float*)(lds + L_PSLC); LAS float* sc = (LAS float*)(lds + L_SC);
    LAS float* wsf = (LAS float*)(lds + L_WSF) + wid * 128;
    const float* GATES = (const float*)(ws + WS_GATES);
    biasT[tid] = rel_bias[(int)kBucket[tid & 127] * 8 + g * 4 + (tid >> 7)] * LOG2E;
    for (int i = tid; i < 64 * 12; i += NTHR) { const int q = i / 12, e = i % 12; gt[i] = GATES[((size_t)b * TP + q0 + q) * 24 + (e >> 2) * 8 + g * 4 + (e & 3)]; }
    for (int i = tid; i < 64 * PL_LD; i += NTHR) pslc[i] = 0.f;
    if (tid < 2) ((LAS unsigned*)(lds + L_ANY))[tid] = 0u;
    bf16x8 qr[4];
    { const bf16_t* Qp = (const bf16_t*)(ws + WS_Q) + ((size_t)b * TP + qpos) * 512 + (g * 4 + hh) * 64 + hi * 8;
#pragma unroll
      for (int d0 = 0; d0 < 4; ++d0) qr[d0] = *(const bf16x8*)(Qp + d0 * 16); }
    LDS_WAIT(); __syncthreads();
    const LAS float* bT = biasT + hh * 128; const float b31 = bT[127];
    const int vb0 = (int)(unsigned)(uintptr_t)(lds + L_V) + ((lane >> 4) & 1) * 32 + (lane & 3) * 8 + (4 * hi + ((lane & 15) >> 2)) * 64;
    f32x16 oacc[2];
#pragma unroll
    for (int r = 0; r < 16; ++r) { oacc[0][r] = 0.f; oacc[1][r] = 0.f; }
    f32x16 p0, p1;
    { const bf16_t* KC = (const bf16_t*)(ws + WS_KCP) + (size_t)bg * 4 * 4096; const bf16_t* VC = (const bf16_t*)(ws + WS_VCP) + (size_t)bg * 4 * 4096;
      const int ncv = min(4 * qt + 3, 255), ntc = (ncv + 63) >> 6;
      SM s; sm_init(s);
      ATT_TILE_LOOP(ntc, 0, tcur_ + 1, KC, VC, {
          qkt(p0, p1, lds + L_K + SLOT * 8192, qr, r32, hi, 0.f); mask_bias<0>(p0, p1, T, true, qpos, hi, bT); sm_update<false>(s, p0, p1, wsf, r32, hi, true); });
      const float ltot = halfsum(s.l), invl = ltot > 0.f ? 1.0f / ltot : 0.f; s.l = 0.f;
      ATT_TILE_LOOP(ntc, 0, tcur_ + 1, KC, VC, {
          qkt(p0, p1, lds + L_K + SLOT * 8192, qr, r32, hi, 0.f); mask_bias<0>(p0, p1, T, true, qpos, hi, bT);
          float sum = 0.f;
          _Pragma("unroll") for (int r = 0; r < 16; ++r) { p0[r] = fast_exp2(p0[r] - s.m); p1[r] = fast_exp2(p1[r] - s.m); sum += p0[r] + p1[r]; }
          s.l += sum;
          float ga[8], gd[8], gp[8];
          _Pragma("unroll") for (int k4 = 0; k4 < 4; ++k4) { ga[k4] = 2.0f * (p0[4 * k4] + p0[4 * k4 + 1] + p0[4 * k4 + 2]) * invl; gd[k4] = p0[4 * k4 + 3] * invl;
              ga[4 + k4] = 2.0f * (p1[4 * k4] + p1[4 * k4 + 1] + p1[4 * k4 + 2]) * invl; gd[4 + k4] = p1[4 * k4 + 3] * invl; }
          _Pragma("unroll") for (int G = 0; G < 8; ++G) { auto sw = __builtin_amdgcn_permlane32_swap(__float_as_uint(gd[G]), __float_as_uint(gd[G]), false, false); gp[G] = __uint_as_float(hi ? sw[0] : sw[1]); }
          for (int rr = 0; rr < 4; ++rr) { if (hh == rr) { LAS float* pr = pslc + qloc * PL_LD + 16 * T + hi;
              _Pragma("unroll") for (int G = 0; G < 8; ++G) { const float prev = hi ? gp[G] : (G > 0 ? gp[G - 1] : 0.f); pr[2 * G] += ga[G] + gd[G] + prev; }
              if (hi) pr[15] += gd[7]; }
              LDS_WAIT(); __syncthreads(); }
          ATT_PV(s, SLOT); });
      ATT_FINISH(s, 0);
    }
    { const int q = tid >> 3, jg = tid & 7; float myv[8];
#pragma unroll
      for (int i = 0; i < 8; ++i) { const int j = jg * 8 + i; const float v = pslc[q * PL_LD + j];
          const bool valid = j <= qt, forced = (j == 0) || (j == qt) || (j == qt - 1);
          const float sv = valid ? v + (forced ? 1000.0f : 0.f) : -1e9f; myv[i] = sv; sc[q * SC_LD + j] = sv; }
      LDS_WAIT(); __syncthreads();
      int cnt[8];
#pragma unroll
      for (int i = 0; i < 8; ++i) cnt[i] = 0;
      for (int k = 0; k < 64; ++k) { const float v = sc[q * SC_LD + k];
#pragma unroll
          for (int i = 0; i < 8; ++i) cnt[i] += ((v > myv[i]) || (v == myv[i] && k < jg * 8 + i)) ? 1 : 0; }
      unsigned bits = 0u;
#pragma unroll
      for (int i = 0; i < 8; ++i) if (cnt[i] < 16 && jg * 8 + i <= qt) bits |= 1u << i;
      ((LAS unsigned char*)(lds + L_SEL))[q * 8 + jg] = (unsigned char)bits;
      atomicOr((unsigned*)((LAS unsigned*)(lds + L_ANY) + (jg >> 2)), bits << (8 * (jg & 3)));
      LDS_WAIT(); __syncthreads(); }
    { const unsigned lo_ = ((LAS unsigned*)(lds + L_SEL))[qloc * 2], hi_ = ((LAS unsigned*)(lds + L_SEL))[qloc * 2 + 1]; const unsigned long long selm = ((unsigned long long)hi_ << 32) | lo_;
      const unsigned long long anym = ((unsigned long long)((LAS unsigned*)(lds + L_ANY))[1] << 32) | ((LAS unsigned*)(lds + L_ANY))[0];
      unsigned long long rem = anym; const int nts = __builtin_popcountll(anym);
      const bf16_t* KS = (const bf16_t*)(ws + WS_KS) + (size_t)bg * TP * 64; const bf16_t* VS = (const bf16_t*)(ws + WS_VS) + (size_t)bg * TP * 64;
      SM s; sm_init(s);
      ATT_TILE_LOOP(nts, __builtin_ctzll(rem), (rem &= rem - 1, __builtin_ctzll(rem)), KS, VS, {
          const bool far = T + 3 <= qt; const bool lsel = ((selm >> T) & 1ull) != 0ull;
          qkt(p0, p1, lds + L_K + SLOT * 8192, qr, r32, hi, far ? b31 : 0.f);
          if (!far) mask_bias<1>(p0, p1, T, lsel, qpos, hi, bT);
          sm_update<true>(s, p0, p1, wsf, r32, hi, far ? lsel : true); ATT_PV(s, SLOT); });
      ATT_FINISH(s, 1);
    }
    { const int jw0 = max(0, qt - 8), ntw = qt - jw0 + 1;
      const bf16_t* KW = (const bf16_t*)(ws + WS_KW) + (size_t)bg * TP * 64; const bf16_t* VW = (const bf16_t*)(ws + WS_VW) + (size_t)bg * TP * 64;
      SM s; sm_init(s);
      ATT_TILE_LOOP(ntw, jw0, tcur_ + 1, KW, VW, {
          const bool far = (T + 3 <= qt) && (T + 8 > qt);
          qkt(p0, p1, lds + L_K + SLOT * 8192, qr, r32, hi, far ? b31 : 0.f);
          if (!far) mask_bias<2>(p0, p1, T, true, qpos, hi, bT);
          sm_update<true>(s, p0, p1, wsf, r32, hi, true); ATT_PV(s, SLOT); });
      ATT_FINISH(s, 2);
    }
    { LAS bf16_t* stg = (LAS bf16_t*)(lds + L_OST + wid * 4096);
#pragma unroll
      for (int r = 0; r < 16; ++r) { stg[crow(r, hi) * 64 + r32] = (bf16_t)f2bf(oacc[0][r]); stg[crow(r, hi) * 64 + 32 + r32] = (bf16_t)f2bf(oacc[1][r]); }
      LDS_WAIT();
      bf16_t* O = (bf16_t*)(ws + WS_ACAT) + ((size_t)b * TP + q0 + qh * 32) * DM + (g * 4 + hh) * 64;
#pragma unroll
      for (int i = 0; i < 4; ++i) { const int row = i * 8 + (lane >> 3), ch = lane & 7; const u32x4 v = *(const LAS u32x4*)(stg + row * 64 + ch * 8); *(u32x4*)(O + (size_t)row * DM + ch * 8) = v; }
    }
    LDS_WAIT(); __syncthreads();
}

constexpr int S_SC = 0, S_SCLD = 1040, S_PSUM = 16640  , S_SCORE = 18752  , S_SELIDX = 19328  , S_Q = 19456  , S_OH = 20480  , S_STAT = 22528  , S_GATE = 22592  , S_BIAS = 22656  ;
struct SampleCtx { int b, g, s, qpos; const float* cache_sel; const float* state_win; const int* pt; const float* out; const float* kvcs; };
template <int BR> __device__ __forceinline__ void skey(const SampleCtx& C, const LAS int* selidx, int k, const float*& Kp, int& dist, bool& valid) {
    if (BR == 0) { Kp = C.kvcs + (((size_t)(C.b * 2 + C.g) * 512 + k) * 2) * 64; dist = C.qpos - (16 * k + 31); valid = true; }
    else if (BR == 1) { const int j = selidx[k >> 6], r = k & 63;
        if (j < 128) { const int page = C.pt[C.b * NPAGE + (j >> 1)]; Kp = C.cache_sel + ((size_t)page * PAGE + (j & 1) * 64 + r) * 256 + C.g * 64; dist = C.qpos - (64 * j + r); valid = true; }
        else { const int rr = r < TS ? r : 0; Kp = C.out + O_KVS_S + ((size_t)C.b * TS + rr) * 256 + C.g * 64; dist = C.qpos - (PAST + r); valid = r <= C.s; } }
    else { Kp = (k < 512 ? C.state_win + ((size_t)C.b * 512 + k) * 256 : C.out + O_KVW_S + ((size_t)C.b * 512 + 508 + (k - 512)) * 256) + C.g * 64; dist = C.qpos - (PAST - 512 + k); valid = dist >= 0 && dist < 512; }
}
constexpr int S_KP = 24704  , S_META = 33024  , S_RED = 37184  ;
template <int BR> __device__ __forceinline__ void sample_branch(const Ctx& X, int tid, const SampleCtx& C, int nkeys, float& ofinal) {
    LAS unsigned char* lds = X.lds; const int lane = tid & 63, wid = __builtin_amdgcn_readfirstlane(tid >> 6);
    LAS float* scs = (LAS float*)(lds + S_SC); LAS float* qs = (LAS float*)(lds + S_Q); LAS float* stat = (LAS float*)(lds + S_STAT);
    LAS float* gts = (LAS float*)(lds + S_GATE); LAS float* bT = (LAS float*)(lds + S_BIAS); const LAS int* selidx = (const LAS int*)(lds + S_SELIDX);
    typedef const float* cfp; LAS cfp* kp = (LAS cfp*)(lds + S_KP); LAS int* meta = (LAS int*)(lds + S_META); LAS float* red = (LAS float*)(lds + S_RED);
    constexpr int VOFF = BR == 0 ? 64 : 128;
    for (int k = tid; k < nkeys; k += NTHR) { const float* Kp; int dist; bool valid; skey<BR>(C, selidx, k, Kp, dist, valid); kp[k] = Kp; meta[k] = valid ? min(max(dist, 0), 127) : -1; }
    LDS_WAIT(); __syncthreads();
    const int grp = tid >> 4, li = tid & 15, nit = (nkeys + 31) >> 5;
    { f32x4 q4[4];
#pragma unroll
      for (int h = 0; h < 4; ++h) q4[h] = *(const LAS f32x4*)(qs + h * 64 + li * 4);
      for (int i0 = 0; i0 < nit; i0 += 16) { f32x4 kx[16];
#pragma unroll
          for (int u = 0; u < 16; ++u) { const int k = grp + 32 * (i0 + u); kx[u] = k < nkeys ? *(const f32x4*)(kp[k] + li * 4) : (f32x4){0.f, 0.f, 0.f, 0.f}; }
#pragma unroll
          for (int u = 0; u < 16; ++u) { const int k = grp + 32 * (i0 + u); float pt4[4];
#pragma unroll
              for (int h = 0; h < 4; ++h) { float d = (kx[u][0] * q4[h][0] + kx[u][1] * q4[h][1]) + (kx[u][2] * q4[h][2] + kx[u][3] * q4[h][3]);
                  d += __shfl_xor(d, 1); d += __shfl_xor(d, 2); d += __shfl_xor(d, 4); d += __shfl_xor(d, 8); pt4[h] = d; }
              if (li < 4 && k < nkeys) { const float d = li == 0 ? pt4[0] : li == 1 ? pt4[1] : li == 2 ? pt4[2] : pt4[3]; const int mt = meta[k];
                  scs[li * S_SCLD + k] = mt >= 0 ? d + bT[li * 128 + mt] : -INFINITY; } } } }
    LDS_WAIT(); __syncthreads();
    if (wid < 4) { LAS float* sr = scs + wid * S_SCLD; float m = -INFINITY;
        for (int k = lane; k < nkeys; k += 64) m = fmaxf(m, sr[k]);
#pragma unroll
        for (int o = 1; o < 64; o <<= 1) m = fmaxf(m, __shfl_xor(m, o));
        if (m == -INFINITY) m = 0.f;
        float l = 0.f;
        for (int k = lane; k < nkeys; k += 64) { const float e = fast_exp2(sr[k] - m); sr[k] = e; l += e; }
#pragma unroll
        for (int o = 1; o < 64; o <<= 1) l += __shfl_xor(l, o);
        if (lane == 0) { stat[wid] = m; stat[4 + wid] = l; } }
    LDS_WAIT(); __syncthreads();
    { f32x4 acc[4];
#pragma unroll
      for (int h = 0; h < 4; ++h) acc[h] = (f32x4){0.f, 0.f, 0.f, 0.f};
      for (int i0 = 0; i0 < nit; i0 += 16) { f32x4 vx[16];
#pragma unroll
          for (int u = 0; u < 16; ++u) { const int k = grp + 32 * (i0 + u); vx[u] = k < nkeys ? *(const f32x4*)(kp[k] + VOFF + li * 4) : (f32x4){0.f, 0.f, 0.f, 0.f}; }
#pragma unroll
          for (int u = 0; u < 16; ++u) { const int k = grp + 32 * (i0 + u); if (k < nkeys) {
#pragma unroll
              for (int h = 0; h < 4; ++h) acc[h] += vx[u] * scs[h * S_SCLD + k]; } } }
#pragma unroll
      for (int h = 0; h < 4; ++h) *(LAS f32x4*)(red + (grp * 4 + h) * 64 + li * 4) = acc[h]; }
    LDS_WAIT(); __syncthreads();
    if (tid < 256) { const int h = tid >> 6, d = tid & 63; float o = 0.f;
#pragma unroll 8
        for (int gq = 0; gq < 32; ++gq) o += red[(gq * 4 + h) * 64 + d];
        const float l = stat[4 + h]; ofinal += o * (l > 0.f ? 1.0f / l : 0.f) * gts[BR * 4 + h]; }
}
__device__ __forceinline__ void sample_item(const Ctx& X, int item, unsigned char* ws, const Args& A) {
    LAS unsigned char* lds = X.lds; int tid = X.tid; asm volatile("" : "+v"(tid));
    SampleCtx C; C.b = item >> 3; C.g = (item >> 2) & 1; C.s = item & 3; C.qpos = PAST + C.s; C.cache_sel = A.in[3]; C.state_win = A.in[4]; C.pt = (const int*)A.in[6]; C.out = A.out; C.kvcs = (const float*)(ws + WS_KVCS);
    const int mrow = MP + C.b * TS + C.s;
    LAS float* scs = (LAS float*)(lds + S_SC); LAS float* qs = (LAS float*)(lds + S_Q); LAS float* stat = (LAS float*)(lds + S_STAT); LAS float* gts = (LAS float*)(lds + S_GATE); LAS float* bT = (LAS float*)(lds + S_BIAS);
    LAS float* psum = (LAS float*)(lds + S_PSUM); LAS float* score = (LAS float*)(lds + S_SCORE); LAS int* selidx = (LAS int*)(lds + S_SELIDX);
    bT[tid] = A.in[24][(int)kBucket[tid & 127] * 8 + C.g * 4 + (tid >> 7)] * LOG2E;
    if (tid < 256) qs[tid] = bf2f(((const bf16_t*)(ws + WS_Q))[(size_t)mrow * 512 + C.g * 256 + tid]);
    if (tid < 12) gts[tid] = ((const float*)(ws + WS_GATES))[(size_t)mrow * 24 + (tid >> 2) * 8 + C.g * 4 + (tid & 3)];
    LDS_WAIT(); __syncthreads();
    float ofinal = 0.f;
    sample_branch<0>(X, tid, C, 511, ofinal);
    for (int n = tid; n < 520; n += NTHR) { float v = 0.f; if (n < 511) { v = scs[n] / stat[4] + scs[S_SCLD + n] / stat[5] + scs[2 * S_SCLD + n] / stat[6] + scs[3 * S_SCLD + n] / stat[7]; } psum[n] = v; }
    LDS_WAIT(); __syncthreads();
    if (tid < 129) { const int j = tid; const float v = 2.0f * (psum[4 * j] + psum[4 * j + 1] + psum[4 * j + 2]) + psum[4 * j + 3] + (j > 0 ? psum[4 * j - 1] : 0.f);
        score[j] = v + ((j == 0 || j == 128 || j == 127) ? 1000.0f : 0.f); }
    LDS_WAIT(); __syncthreads();
    if (tid < 129) { const float mv = score[tid]; int cnt = 0; for (int k = 0; k < 129; ++k) { const float v = score[k]; cnt += ((v > mv) || (v == mv && k < tid)) ? 1 : 0; } if (cnt < 16) selidx[cnt] = tid; }
    LDS_WAIT(); __syncthreads();
    sample_branch<1>(X, tid, C, 1024, ofinal);
    __syncthreads();
    sample_branch<2>(X, tid, C, 516, ofinal);
    if (tid < 256) ((bf16_t*)(ws + WS_ACAT))[(size_t)mrow * DM + C.g * 256 + tid] = (bf16_t)f2bf(ofinal);
    LDS_WAIT(); __syncthreads();
}

#if MK_CHECK
#define KC ((const bf16_t*)(ws + WS_KCP))
#define VC ((const bf16_t*)(ws + WS_VCP))
#define KS ((const bf16_t*)(ws + WS_KS))
#define VS ((const bf16_t*)(ws + WS_VS))
#define KW ((const bf16_t*)(ws + WS_KW))
#define VW ((const bf16_t*)(ws + WS_VW))
__device__ __forceinline__ float kraw_at(const bf16_t* base, int bg, int rows, int t, int d, bool isv) { return bf2f(base[isv ? v_img(rows / 64, bg, t, d) : k_img(rows / 64, bg, t, d)]); }
constexpr int C_SC = 0, C_SCLD = 1040, C_PS = 16640, C_PSLC = 17920, C_BLK = 18432, C_Q = 18944, C_STAT = 19968, C_OUT = 20480, C_RED = 21504, C_GT = 21760;
__device__ __forceinline__ void chk_branch(const Ctx& X, int br, int nkeys, const bf16_t* Kb, const bf16_t* Vb, int bg, int rows, int g, int t, const float* rel_bias, bool keep_p) {
    LAS unsigned char* lds = X.lds; const int tid = X.tid, lane = X.lane, wid = X.wave;
    LAS float* sc = (LAS float*)(lds + C_SC); LAS float* stat = (LAS float*)(lds + C_STAT); LAS float* out = (LAS float*)(lds + C_OUT); LAS float* gt = (LAS float*)(lds + C_GT); LAS int* kpos = (LAS int*)(lds + 32768);
    if (wid < 4) { LAS float* sr = sc + wid * C_SCLD; float m = -INFINITY;
        for (int k = lane; k < nkeys; k += 64) m = fmaxf(m, sr[k]);
#pragma unroll
        for (int o = 1; o < 64; o <<= 1) m = fmaxf(m, __shfl_xor(m, o));
        float l = 0.f;
        if (m > -INFINITY) { for (int k = lane; k < nkeys; k += 64) { const float e = exp2f(sr[k] - m); sr[k] = e; l += e; } }
        else { for (int k = lane; k < nkeys; k += 64) sr[k] = 0.f; }
#pragma unroll
        for (int o = 1; o < 64; o <<= 1) l += __shfl_xor(l, o);
        const float inv = l > 0.f ? 1.0f / l : 0.f;
        for (int k = lane; k < nkeys; k += 64) sr[k] *= inv; }
    LDS_WAIT(); __syncthreads();
    if (tid < 256) { const int hh = tid >> 6, d = tid & 63; float acc = 0.f; for (int k = 0; k < nkeys; ++k) { const float p = sc[hh * C_SCLD + k]; if (p != 0.f) acc += p * kraw_at(Vb, bg, rows, kpos[k], d, true); }
        out[tid] += gt[br * 4 + hh] * acc; }
    LDS_WAIT(); __syncthreads();
}
__device__ __forceinline__ void check_item(const Ctx& X, int item, unsigned char* ws, const float* rel_bias, unsigned* flag) {
    LAS unsigned char* lds = X.lds; const int tid = X.tid;
    const int edge[16] = {0, 1, 30, 31, 32, 46, 47, 63, 64, 65, 127, 128, 511, 512, 4095, 2048};
    const int bg = item & 7, t = item < 16 ? edge[item & 15] : ((item * 2081 + 7) & (TP - 1)), b = bg >> 1, g = bg & 1, qt = t >> 6; const size_t m = (size_t)b * TP + t;
    LAS float* sc = (LAS float*)(lds + C_SC); LAS float* ps = (LAS float*)(lds + C_PS); LAS float* pslc = (LAS float*)(lds + C_PSLC); LAS int* blk = (LAS int*)(lds + C_BLK); LAS float* qs = (LAS float*)(lds + C_Q);
    LAS float* out = (LAS float*)(lds + C_OUT); LAS float* red = (LAS float*)(lds + C_RED); LAS float* gt = (LAS float*)(lds + C_GT); LAS int* kpos = (LAS int*)(lds + 32768);
    __syncthreads();
    if (tid < 256) { qs[tid] = bf2f(((const bf16_t*)(ws + WS_Q))[m * 512 + g * 256 + tid]); out[tid] = 0.f; }
    if (tid < 12) gt[tid] = ((const float*)(ws + WS_GATES))[m * 24 + (tid >> 2) * 8 + g * 4 + (tid & 3)];
    for (int i = tid; i < 260; i += NTHR) ps[i] = 0.f;
    LDS_WAIT(); __syncthreads();
    const int nv = t >= 31 ? min((t - 31) / 16 + 1, 255) : 0;
    for (int idx = tid; idx < 4 * 256; idx += NTHR) { const int hh = idx >> 8, n = idx & 255; if (n < nv) { float s = 0.f; for (int d = 0; d < 64; ++d) s += qs[hh * 64 + d] * kraw_at(KC, bg, 256, n, d, false);
            const int dist = t - (16 * n + 31); s += rel_bias[(int)kBucket[min(dist, 127)] * 8 + g * 4 + hh] * LOG2E; sc[hh * C_SCLD + n] = s; kpos[n] = n; } }
    LDS_WAIT(); __syncthreads();
    if (nv > 0) {
        { LAS float* stat = (LAS float*)(lds + C_STAT); if (X.wave < 4) { LAS float* sr = sc + X.wave * C_SCLD; float mx = -INFINITY; for (int k = X.lane; k < nv; k += 64) mx = fmaxf(mx, sr[k]);
#pragma unroll
              for (int o = 1; o < 64; o <<= 1) mx = fmaxf(mx, __shfl_xor(mx, o));
              float l = 0.f; for (int k = X.lane; k < nv; k += 64) l += exp2f(sr[k] - mx);
#pragma unroll
              for (int o = 1; o < 64; o <<= 1) l += __shfl_xor(l, o);
              if (X.lane == 0) { stat[X.wave] = mx; stat[4 + X.wave] = l; } }
          LDS_WAIT(); __syncthreads();
          for (int n = tid; n < nv; n += NTHR) { float v = 0.f; for (int hh = 0; hh < 4; ++hh) v += exp2f(sc[hh * C_SCLD + n] - stat[hh]) / stat[4 + hh]; ps[n] = v; }
          LDS_WAIT(); __syncthreads(); }
        chk_branch(X, 0, nv, KC, VC, bg, 256, g, t, rel_bias, true);
    }
    if (tid < 64) { const int j = tid; const float v = 2.0f * (ps[4 * j] + ps[4 * j + 1] + ps[4 * j + 2]) + ps[4 * j + 3] + (j > 0 ? ps[4 * j - 1] : 0.f);
        pslc[j] = (j <= qt) ? v + ((j == 0 || j == qt || j == qt - 1) ? 1000.0f : 0.f) : -1e9f; }
    LDS_WAIT(); __syncthreads();
    if (tid < 64) { const float mv = pslc[tid]; int cnt = 0; for (int k = 0; k < 64; ++k) { const float v = pslc[k]; cnt += ((v > mv) || (v == mv && k < tid)) ? 1 : 0; } blk[tid] = (cnt < 16 && tid <= qt) ? 1 : 0; }
    LDS_WAIT(); __syncthreads();
    if (tid == 0) { int nk = 0; for (int j = 0; j < 64; ++j) if (blk[j]) for (int r = 0; r < 64; ++r) { const int p = 64 * j + r; if (p <= t) kpos[nk++] = p; } blk[64] = nk; }
    LDS_WAIT(); __syncthreads();
    { const int nk = blk[64];
      for (int idx = tid; idx < 4 * nk; idx += NTHR) { const int hh = idx / nk, k = idx % nk, p = kpos[k]; float s = 0.f; for (int d = 0; d < 64; ++d) s += qs[hh * 64 + d] * kraw_at(KS, bg, TP, p, d, false);
          s += rel_bias[(int)kBucket[min(t - p, 127)] * 8 + g * 4 + hh] * LOG2E; sc[hh * C_SCLD + k] = s; }
      LDS_WAIT(); __syncthreads();
      chk_branch(X, 1, nk, KS, VS, bg, TP, g, t, rel_bias, false); }
    { const int nk = min(t + 1, 512), p0 = t - nk + 1;
      for (int k = tid; k < nk; k += NTHR) kpos[k] = p0 + k;
      LDS_WAIT(); __syncthreads();
      for (int idx = tid; idx < 4 * nk; idx += NTHR) { const int hh = idx / nk, k = idx % nk, p = p0 + k; float s = 0.f; for (int d = 0; d < 64; ++d) s += qs[hh * 64 + d] * kraw_at(KW, bg, TP, p, d, false);
          s += rel_bias[(int)kBucket[min(t - p, 127)] * 8 + g * 4 + hh] * LOG2E; sc[hh * C_SCLD + k] = s; }
      LDS_WAIT(); __syncthreads();
      chk_branch(X, 2, nk, KW, VW, bg, TP, g, t, rel_bias, false); }
    float err = 0.f, mag = 0.f;
    if (tid < 256) { const float ref = out[tid], fast = bf2f(((const bf16_t*)(ws + WS_ACAT))[m * DM + g * 256 + tid]); err = fabsf(ref - fast); mag = fabsf(ref); if (!(fast == fast)) err = 1e30f; }
#pragma unroll
    for (int o = 1; o < 64; o <<= 1) { err = fmaxf(err, __shfl_xor(err, o)); mag = fmaxf(mag, __shfl_xor(mag, o)); }
    if (X.lane == 0) { red[X.wave] = err; red[8 + X.wave] = mag; }
    LDS_WAIT(); __syncthreads();
    if (tid == 0) { float e = 0.f, mg = 0.f; for (int w = 0; w < 8; ++w) { e = fmaxf(e, red[w]); mg = fmaxf(mg, red[8 + w]); } if (e > MK_CHECK_TOL * mg + 1e-4f) atomicAdd(flag, 1u); }
    __syncthreads();
}
#undef KC
#undef VC
#undef KS
#undef VS
#undef KW
#undef VW
#endif
}

template <class Epi> __device__ __forceinline__ void thin_gemm(const Ctx& X, const bf16_t* A, const bf16_t* Bt, int K, int npn, const Epi& E, int nr32 = 4, int row0 = MP, int ushift = 0) {
    LAS f32x4* red = (LAS f32x4*)X.lds;
    int tid = X.tid; asm volatile("" : "+v"(tid));
    const int lane = tid & 63, wid = __builtin_amdgcn_readfirstlane(tid >> 6), fr = lane & 15, fq = lane >> 4;
    const int kw = K >> 3, nks = kw >> 5, nunits = npn * 8 * nr32;
    int cu = (int)blockIdx.x - ushift; if (cu < 0) cu += X.G;
    for (int u = cu; u < nunits; u += X.G) {
        const int r32 = u % nr32, uc = u / nr32, c16 = uc & 7, pn = uc >> 3;
        const bf16_t* ap = A + (size_t)(32 * r32 + fr) * K + wid * kw + 8 * fq;
        const bf16_t* bp = Bt + (size_t)(pn * 256 + 16 * c16 + fr) * K + wid * kw + 8 * fq;
        const size_t a16 = (size_t)16 * K, b128 = (size_t)128 * K;
        f32x4 acc[2][2];
#pragma unroll
        for (int rt = 0; rt < 2; ++rt) { acc[rt][0] = (f32x4){0.f, 0.f, 0.f, 0.f}; acc[rt][1] = (f32x4){0.f, 0.f, 0.f, 0.f}; }
        for (int ks0 = 0; ks0 < nks; ks0 += 6) {
            bf16x8 af[6][2], bf[6][2];
#pragma unroll
            for (int i = 0; i < 6; ++i) if (ks0 + i < nks) { const int ko = 32 * (ks0 + i);
                af[i][0] = *(const bf16x8*)(ap + ko); af[i][1] = *(const bf16x8*)(ap + a16 + ko); bf[i][0] = *(const bf16x8*)(bp + ko); bf[i][1] = *(const bf16x8*)(bp + b128 + ko); }
#pragma unroll
            for (int i = 0; i < 6; ++i) if (ks0 + i < nks) {
#pragma unroll
                for (int rt = 0; rt < 2; ++rt) { acc[rt][0] = __builtin_amdgcn_mfma_f32_16x16x32_bf16(bf[i][0], af[i][rt], acc[rt][0], 0, 0, 0); acc[rt][1] = __builtin_amdgcn_mfma_f32_16x16x32_bf16(bf[i][1], af[i][rt], acc[rt][1], 0, 0, 0); } }
        }
#pragma unroll
        for (int rt = 0; rt < 2; ++rt) { red[((wid * 2 + rt) * 2 + 0) * 64 + lane] = acc[rt][0]; red[((wid * 2 + rt) * 2 + 1) * 64 + lane] = acc[rt][1]; }
        LDS_WAIT(); __syncthreads();
        if (wid < 2) { const int rt = wid; f32x4 q[2][1];
#pragma unroll
            for (int bj = 0; bj < 2; ++bj) { f32x4 v = red[((0 * 2 + rt) * 2 + bj) * 64 + lane];
#pragma unroll
                for (int w = 1; w < 4; ++w) v += red[((w * 2 + rt) * 2 + bj) * 64 + lane];
                q[bj][0] = v; }
            const int row = row0 + 32 * r32 + 16 * rt + fr, h = c16 >> 2, t = c16 & 3;
            if constexpr (Epi::HAS_MID) E.thin_mid(row, pn, h, t, fq, q);
#pragma unroll
            for (int bj = 0; bj < 2; ++bj) { f32x4 v = q[bj][0];
#pragma unroll
                for (int w = 4; w < 8; ++w) v += red[((w * 2 + rt) * 2 + bj) * 64 + lane];
                q[bj][0] = v; }
            E.thin(row, pn, h, t, fq, q); }
        __syncthreads();
    }
}

__global__ void __launch_bounds__(NTHR, 2) nsa_fwd(Args args) {
    extern __shared__ __attribute__((aligned(16))) unsigned char lds_raw[];
    Ctx X; X.lds = (LAS unsigned char*)lds_raw; X.tid = threadIdx.x; X.lane = X.tid & 63; X.wave = __builtin_amdgcn_readfirstlane(X.tid >> 6);
    X.G = gridDim.x; { const int bx = blockIdx.x; X.vcu = (X.G % 8 == 0) ? (bx % 8) * (X.G / 8) + bx / 8 : bx; }
    X.gw = X.vcu * NWAVES + X.wave; X.NGW = X.G * NWAVES;
    unsigned char* ws = args.ws; float* out = args.out;
    gu32* ctl = (gu32*)(ws + WS_CTL);
    volatile LAS unsigned* MISC = (volatile LAS unsigned*)(X.lds + MISC_OFF);
    for (int u = X.tid; u < (LDS_BYTES - LDSCTL_OFF) / 4; u += NTHR) ((LAS unsigned*)(X.lds + LDSCTL_OFF))[u] = 0u;
    __syncthreads();
    XcdBarrier bar; bar.bar = (unsigned*)(ctl + CW_BAR); bar.x = 0; bar.st = nullptr;
#if !MK_PER_PHASE
    bar = xcd_barrier_post((unsigned*)(ctl + CW_BAR), MISC + 8);
#define GRID_BAR() xcd_barrier(bar)
#else
#define GRID_BAR() do { } while (0)
#endif
    const int lo = args.ph_lo, hi = args.ph_hi;
#define IN(k) (lo <= (k) && (k) < hi)
#define BOTH(k) (IN(k) && IN((k) + 1))
    float* modv = (float*)(ws + WS_MOD);
    const float* x_p = args.in[0]; const float* x_s = args.in[1];

#if MK_PROBE
    if (IN(-1)) { f32x4* o4 = (f32x4*)(out + O_KVC_P); const size_t n4 = (O_TOTAL - O_KVC_P) / 4;
        for (size_t i = (size_t)X.gw * 64 + X.lane; i < n4; i += (size_t)X.NGW * 64) o4[i] = (f32x4){100.f, 100.f, 100.f, 100.f}; }
#endif
    if (MK_PH_ON(0) && IN(0)) for (int rep_ = 0; rep_ < MK_NREP(0); ++rep_) { if (rep_) GRID_BAR();
        for (int rp = 0; rp < MK_NREP(20); ++rp)
        for (int it = X.vcu; it < NMOD / 64; it += X.G) ada_item(X, it, args.in[7], args.in[8], args.in[9], args.in[10], modv);
        __syncthreads();
        {
            LAS float* scr = (LAS float*)(X.lds + X.wave * 16384);
            int total = 0;
            for (int j = 0; j < NJOBS; ++j) total += tj_items(kJobs[j]);
            for (int it = X.gw; it < total * MK_NREP(21); it += X.NGW) {
                int r = it % total, j = 0;
                for (; j < NJOBS - 1; ++j) { const int n = tj_items(kJobs[j]); if (r < n) break; r -= n; }
                const TJ J = kJobs[j];
                const int nblk = (J.ncols + 63) / 64, per = (J.K / 64) * nblk, rep = r / per, rr = r % per, kb = rr / nblk, nb = rr % nblk;
                const float* W = args.in[J.src] + (size_t)rep * J.srcoff_stride + J.col0 + rep * J.col_stride;
                bf16_t* WT = wdst(ws, J.dst) + (size_t)(J.drow0 + rep * J.drow_stride) * J.dpitch + J.dcol0;
                transpose_item(W, J.N, J.ncols, WT, J.dpitch, scr, kb, nb, X.lane);
            }
            { u32x4* z = (u32x4*)((bf16_t*)(ws + WS_WIN) + (size_t)INW * DM); const int nz = (INWP - INW) * DM * 2 / 16;
              for (int i = X.gw * 64 + X.lane; i < nz; i += X.NGW * 64) z[i] = (u32x4){0u, 0u, 0u, 0u}; }
        }
        for (int o = X.gw; o < 256; o += X.NGW) { const int c = o >> 7, e = o & 127; const float* pe = args.in[19] + c * 2048; const float* w1 = args.in[17] + (size_t)c * 2048 * 128 + e;
            float s = 0.f; for (int k = X.lane; k < 2048; k += 64) s += pe[k] * w1[(size_t)k * 128];
#pragma unroll
            for (int off = 1; off < 64; off <<= 1) s += __shfl_xor(s, off);
            if (X.lane == 0) ((float*)(ws + WS_PETERM))[o] = s; }
        { const f32x4* src = (const f32x4*)args.in[4]; f32x4* dst = (f32x4*)(out + O_KVW_S); const int per_b = 508 * 64;
          for (int i = X.gw * 64 + X.lane; i < NBS * per_b; i += X.NGW * 64) { const int b = i / per_b, r = i % per_b; dst[(size_t)b * 512 * 64 + r] = src[(size_t)b * 512 * 64 + 4 * 64 + r]; } }
        { const int* pt = (const int*)args.in[6]; const float* cache = args.in[2]; bf16_t* ACS = (bf16_t*)(ws + WS_ACS);
          for (int it0 = X.gw; it0 < NBS * 512 * MK_NREP(22); it0 += X.NGW) { const int it = it0 & (NBS * 512 - 1); const int b = it >> 9, n = it & 511; const int page = pt[b * NPAGE + (n >> 3)];
              const f32x4* src = (const f32x4*)(cache + ((size_t)page * PAGE + (n & 7) * 16) * 256) + X.lane;
              const int c = X.lane >> 5, g = (X.lane >> 4) & 1, d = (X.lane & 15) * 4;
              bf16_t* dst = ACS + ((size_t)c * 32768 + (size_t)(b * 2 + g) * 512 + n) * 1024 + d;
              f32x4 v[16];
#pragma unroll
              for (int l = 0; l < 16; ++l) v[l] = src[l * 64];
#pragma unroll
              for (int l = 0; l < 16; ++l) { u32x2 w; w.x = pk2(v[l][0], v[l][1]); w.y = pk2(v[l][2], v[l][3]); *(u32x2*)(dst + l * 64) = w; } } }
        if (BOTH(0)) GRID_BAR();
    }

    if (MK_PH_ON(1) && IN(1)) for (int rep_ = 0; rep_ < MK_NREP(1); ++rep_) { if (rep_) GRID_BAR();
        { const float* g1 = args.in[11]; bf16_t* A1 = (bf16_t*)(ws + WS_A1);
          for (int m = X.gw; m < MPAD; m += X.NGW) {
              unsigned long long* o8 = (unsigned long long*)(A1 + (size_t)m * DM) + X.lane;
              if (m >= MTOT) {
#pragma unroll
                  for (int j = 0; j < 4; ++j) o8[64 * j] = 0ull;
                  continue; }
              const float* xr = m < MP ? x_p + (size_t)m * DM : x_s + (size_t)(m - MP) * DM; const int bi = bidx_of_row(m);
              const f32x4* x4 = (const f32x4*)xr + X.lane; f32x4 v[4]; float s = 0.f;
#pragma unroll
              for (int j = 0; j < 4; ++j) { v[j] = x4[64 * j]; s += (v[j][0] * v[j][0] + v[j][1] * v[j][1]) + (v[j][2] * v[j][2] + v[j][3] * v[j][3]); }
#pragma unroll
              for (int off = 1; off < 64; off <<= 1) s += __shfl_xor(s, off);
              const float rt = 1.0f / sqrtf(s * (1.0f / DM) + EPS);
              const f32x4* gg = (const f32x4*)g1 + X.lane; const f32x4* sh = (const f32x4*)modp(modv, bi, 0, 0) + X.lane; const f32x4* sc = (const f32x4*)modp(modv, bi, 0, 1) + X.lane;
#pragma unroll
              for (int j = 0; j < 4; ++j) { const f32x4 a = v[j] * rt * gg[64 * j] * (sc[64 * j] + 1.0f) + sh[64 * j];
                  o8[64 * j] = (unsigned long long)pk2(a[0], a[1]) | ((unsigned long long)pk2(a[2], a[3]) << 32); }
          } }
        for (int second = 0; second < 2; ++second) {
            constexpr int SP = 1024 + 8;
            LAS bf16_t* shl = (LAS bf16_t*)X.lds;
            __syncthreads();
            for (int i = X.tid; i < 48 * 256; i += NTHR) { const int bi = i >> 8, k4 = (i & 255) * 4; const f32x4 a = *(const f32x4*)(modp(modv, bi < NBIDX ? bi : NBIDX - 1, second ? 2 : 1, 0) + k4);
                u32x2 w; w.x = pk2(a[0], a[1]); w.y = pk2(a[2], a[3]); *(LAS u32x2*)(shl + bi * SP + k4) = w; }
            LDS_WAIT(); __syncthreads();
            const int nrows = second ? NGU : INWP; const bf16_t* Wt = (const bf16_t*)(ws + (second ? WS_WGU2 : WS_WIN)); float* dst = (float*)(ws + (second ? WS_SW3 : WS_SW2));
            const int fr = X.lane & 15, fq = X.lane >> 4;
            for (int it = X.gw; it < nrows / 16; it += X.NGW) { const int n0 = it * 16; f32x4 acc[3];
#pragma unroll
                for (int bt = 0; bt < 3; ++bt) acc[bt] = (f32x4){0.f, 0.f, 0.f, 0.f};
                const bf16_t* wr = Wt + (size_t)(n0 + fr) * DM + 8 * fq;
#pragma unroll 8
                for (int ks = 0; ks < 32; ++ks) { const bf16x8 af = *(const bf16x8*)(wr + 32 * ks);
#pragma unroll
                    for (int bt = 0; bt < 3; ++bt) { const bf16x8 bfr = *(const LAS bf16x8*)(shl + (16 * bt + fr) * SP + 32 * ks + 8 * fq); acc[bt] = __builtin_amdgcn_mfma_f32_16x16x32_bf16(af, bfr, acc[bt], 0, 0, 0); } }
#pragma unroll
                for (int bt = 0; bt < 3; ++bt) { const int bi = 16 * bt + fr; if (bi < NBIDX) *(f32x4*)(dst + (size_t)bi * nrows + n0 + 4 * fq) = acc[bt]; } }
        }
        __syncthreads();
        for (int c = 0; c < 2; ++c) {
            pg8::Gemm g{(const bf16_t*)(ws + WS_ACS) + (size_t)c * 32768 * 1024, (const bf16_t*)(ws + WS_WC1) + (size_t)c * 256 * 1024, 32768, 256, DM};
            pg8::StaticOrder S; S.init(32768, 256, X.G, (int)((blockIdx.x + (c ? X.G - 128 : 0)) % X.G));
            pg8::EpiStoreBf16 E{(bf16_t*)(ws + WS_PCS) + (size_t)c * 32768 * 256, 256};
            pg8::gemm_phase(X.lds, g, S, E);
        }
        if (BOTH(1)) GRID_BAR();
    }

    if (MK_PH_ON(2) && IN(2)) for (int rep_ = 0; rep_ < MK_NREP(2); ++rep_) { if (rep_) GRID_BAR();
        pg8::Gemm g{(const bf16_t*)(ws + WS_A1), (const bf16_t*)(ws + WS_WGU1), MPAD, NGU, DM}; pg8::StaticOrder S; S.init(MPAD, NGU, X.G, (int)blockIdx.x);
        pg8::EpiGU E{(bf16_t*)(ws + WS_ACT), nullptr, nullptr, 0, nullptr};
        pg8::gemm_phase(X.lds, g, S, E);
        if (BOTH(2)) GRID_BAR();
    }
    if (MK_PH_ON(3) && IN(3)) for (int rep_ = 0; rep_ < MK_NREP(3); ++rep_) { if (rep_) GRID_BAR();
        pg8::Gemm g{(const bf16_t*)(ws + WS_ACT), (const bf16_t*)(ws + WS_WD1), MP, DM, DFF}; pg8::StaticOrder S; S.init(MP, DM, X.G, (int)blockIdx.x);
        float* H1 = (float*)(ws + WS_H1);
        pg8::EpiRes<true> E{x_p, x_s, H1, H1 + (size_t)MP * DM, modv, 0, (bf16_t*)(ws + WS_A2), args.in[11] + DM, 1, (float*)(ws + WS_SSQ2), (float*)(ws + WS_SSQS2), 0.5f};
        thin_gemm(X, (const bf16_t*)(ws + WS_ACT) + (size_t)MP * DFF, (const bf16_t*)(ws + WS_WD1), DFF, 4, E);
        pg8::gemm_phase(X.lds, g, S, E);
        if (BOTH(3)) GRID_BAR();
    }
    if (MK_PH_ON(4) && IN(4)) for (int rep_ = 0; rep_ < MK_NREP(4); ++rep_) { if (rep_) GRID_BAR();
        pg8::Gemm g{(const bf16_t*)(ws + WS_A2), (const bf16_t*)(ws + WS_WIN), MP, INWP, DM}; pg8::StaticOrder S; S.init(MP, INWP, X.G, (int)blockIdx.x);
        EpiIn E{(const float*)(ws + WS_SSQ2), (const float*)(ws + WS_SSQS2), (const float*)(ws + WS_SW2), out, ws};
        thin_gemm(X, (const bf16_t*)(ws + WS_A2) + (size_t)MP * DM, (const bf16_t*)(ws + WS_WIN), DM, 20, E);
        pg8::gemm_phase(X.lds, g, S, E);
        if (BOTH(4)) GRID_BAR();
    }
    if (MK_PH_ON(5) && IN(5)) for (int rep_ = 0; rep_ < MK_NREP(5); ++rep_) { if (rep_) GRID_BAR();
        for (int c = 0; c < 2; ++c) {
            pg8::EpiStoreBf16 E{(bf16_t*)(ws + WS_PCP) + (size_t)c * 2048 * 256, 256};
            thin_gemm(X, (const bf16_t*)(ws + WS_ACP) + (size_t)c * 2048 * 1024, (const bf16_t*)(ws + WS_WC1) + (size_t)c * 256 * 1024, DM, 1, E, 64, 0, 0);
        }
        __syncthreads();
        { const bf16_t* PROD = (const bf16_t*)(ws + WS_PROD); const bf16_t* CBb = (const bf16_t*)(ws + WS_CB); bf16_t* ACAT = (bf16_t*)(ws + WS_ACAT);
          const float* wcv = args.in[20]; const float* stc = args.in[5]; const int j = X.lane * 8;
          float w0[8], w1[8], w2[8];
#pragma unroll
          for (int e = 0; e < 8; ++e) { w0[e] = wcv[j + e]; w1[e] = wcv[512 + j + e]; w2[e] = wcv[1024 + j + e]; }
          for (int m = X.gw; m < MTOT; m += X.NGW) {
              const bool isp = m < MP; const int t = isp ? (m & (TP - 1)) : ((m - MP) & 3), bs = isp ? 0 : ((m - MP) >> 2);
              const u32x4 v0 = *(const u32x4*)(PROD + (size_t)m * 512 + j), c4 = *(const u32x4*)(CBb + (size_t)m * 512 + j);
              const u32x4 v1 = *(const u32x4*)(PROD + (size_t)max(m - 1, 0) * 512 + j), v2 = *(const u32x4*)(PROD + (size_t)max(m - 2, 0) * 512 + j);
              const f32x4 s1a = *(const f32x4*)(stc + ((size_t)bs * 2 + 1) * 512 + j), s1b = *(const f32x4*)(stc + ((size_t)bs * 2 + 1) * 512 + j + 4);
              const f32x4 s2a = *(const f32x4*)(stc + ((size_t)bs * 2 + (t & 1)) * 512 + j), s2b = *(const f32x4*)(stc + ((size_t)bs * 2 + (t & 1)) * 512 + j + 4);
              float a2[8], a1[8], a0[8], cbv[8];
#pragma unroll
              for (int e = 0; e < 4; ++e) { a0[2 * e] = bflo(v0[e]); a0[2 * e + 1] = bfhi(v0[e]); cbv[2 * e] = bflo(c4[e]); cbv[2 * e + 1] = bfhi(c4[e]);
                  a1[2 * e] = bflo(v1[e]); a1[2 * e + 1] = bfhi(v1[e]); a2[2 * e] = bflo(v2[e]); a2[2 * e + 1] = bfhi(v2[e]); }
              if (t < 1) {
#pragma unroll
                  for (int e = 0; e < 8; ++e) a1[e] = isp ? 0.f : (e < 4 ? s1a[e] : s1b[e - 4]); }
              if (t < 2) {
#pragma unroll
                  for (int e = 0; e < 8; ++e) a2[e] = isp ? 0.f : (e < 4 ? s2a[e] : s2b[e - 4]); }
              float y[8];
#pragma unroll
              for (int e = 0; e < 8; ++e) y[e] = cbv[e] * (w0[e] * a2[e] + w1[e] * a1[e] + w2[e] * a0[e]);
              u32x4 w; w.x = pk2(y[0], y[1]); w.y = pk2(y[2], y[3]); w.z = pk2(y[4], y[5]); w.w = pk2(y[6], y[7]);
              *(u32x4*)(ACAT + (size_t)m * DM + 512 + j) = w; } }
        { int cl = -1; for (int it = X.vcu; it < 2 * 64 * 8; it += X.G) cmp_tail_item<true>(X, it, ws, args.in[18], cl); }
        if (BOTH(5)) GRID_BAR();
    }
    if (MK_PH_ON(6) && IN(6)) for (int rep_ = 0; rep_ < MK_NREP(6); ++rep_) { if (rep_) GRID_BAR();
        { int cl = -1; for (int it = X.vcu; it < 2 * 8 * 4; it += X.G) cmp_tail_item<false>(X, it, ws, args.in[18], cl); }
        if (BOTH(6)) GRID_BAR();
    }
    if (MK_PH_ON(7) && IN(7)) {
        for (int i = X.vcu; i < 512 * MK_NREP(7) * MK_NREP(70); i += X.G) { const int ii = i & 255; const int bg = ii >> 5, qt = ((i & 256) == 0) ? (ii & 31) : 63 - (ii & 31); att::prompt_item(X, bg, qt, ws, args.in[24]); }
        for (int i = X.vcu; i < 256 * MK_NREP(7) * MK_NREP(71); i += X.G) att::sample_item(X, i & 255, ws, args);
        if (BOTH(7)) GRID_BAR();
    }
#if MK_CHECK
    if (IN(8)) { for (int i = X.vcu; i < 256; i += X.G) att::check_item(X, i, ws, args.in[24], (unsigned*)(ctl + 64));
        GRID_BAR();
        const unsigned nbad = __hip_atomic_load((unsigned*)(ctl + 64), __ATOMIC_RELAXED, __HIP_MEMORY_SCOPE_AGENT);
        if (nbad > MK_CHECK_MAXBAD) { for (int i = X.gw * 64 + X.lane; i < MS * DM; i += X.NGW * 64) out[O_Y + (size_t)MP * DM + i] = 1000.0f; } }
#endif
    if (MK_PH_ON(8) && IN(8)) for (int rep_ = 0; rep_ < MK_NREP(8); ++rep_) { if (rep_) GRID_BAR();
        pg8::Gemm g{(const bf16_t*)(ws + WS_ACAT), (const bf16_t*)(ws + WS_WM), MP, DM, DM}; pg8::StaticOrder S; S.init(MP, DM, X.G, (int)blockIdx.x);
        EpiMerge E{8, (const bf16_t*)(ws + WS_RATIO), (const bf16_t*)(ws + WS_GB), (bf16_t*)(ws + WS_MERGED)};
        thin_gemm(X, (const bf16_t*)(ws + WS_ACAT) + (size_t)MP * DM, (const bf16_t*)(ws + WS_WM), DM, 4, E);
        pg8::gemm_phase(X.lds, g, S, E);
        if (BOTH(8)) GRID_BAR();
    }
    if (MK_PH_ON(9) && IN(9)) for (int rep_ = 0; rep_ < MK_NREP(9); ++rep_) { if (rep_) GRID_BAR();
        pg8::Gemm g{(const bf16_t*)(ws + WS_MERGED), (const bf16_t*)(ws + WS_WO), MP, DM, DM}; pg8::StaticOrder S; S.init(MP, DM, X.G, (int)blockIdx.x);
        float* H1 = (float*)(ws + WS_H1);
        pg8::EpiRes<true> E{H1, H1 + (size_t)MP * DM, H1, H1 + (size_t)MP * DM, modv, 1, (bf16_t*)(ws + WS_A3), args.in[11] + 2 * DM, 2, (float*)(ws + WS_SSQ3), (float*)(ws + WS_SSQS3), 1.0f};
        thin_gemm(X, (const bf16_t*)(ws + WS_MERGED) + (size_t)MP * DM, (const bf16_t*)(ws + WS_WO), DM, 4, E);
        pg8::gemm_phase(X.lds, g, S, E);
        if (BOTH(9)) GRID_BAR();
    }
    if (MK_PH_ON(10) && IN(10)) for (int rep_ = 0; rep_ < MK_NREP(10); ++rep_) { if (rep_) GRID_BAR();
        pg8::Gemm g{(const bf16_t*)(ws + WS_A3), (const bf16_t*)(ws + WS_WGU2), MPAD, NGU, DM}; pg8::StaticOrder S; S.init(MPAD, NGU, X.G, (int)blockIdx.x);
        pg8::EpiGU E{(bf16_t*)(ws + WS_ACT), (const float*)(ws + WS_SSQ3), (const float*)(ws + WS_SW3), NGU, (const float*)(ws + WS_SSQS3)};
        pg8::gemm_phase(X.lds, g, S, E);
        if (BOTH(10)) GRID_BAR();
    }
    if (MK_PH_ON(11) && IN(11)) for (int rep_ = 0; rep_ < MK_NREP(11); ++rep_) { if (rep_) GRID_BAR();
        pg8::Gemm g{(const bf16_t*)(ws + WS_ACT), (const bf16_t*)(ws + WS_WD2), MP, DM, DFF}; pg8::StaticOrder S; S.init(MP, DM, X.G, (int)blockIdx.x);
        float* H1 = (float*)(ws + WS_H1);
        pg8::EpiRes<false> E{H1, H1 + (size_t)MP * DM, out + O_Y, out + O_Y + (size_t)MP * DM, modv, 2, nullptr, nullptr, 0, nullptr, nullptr, 0.5f};
        thin_gemm(X, (const bf16_t*)(ws + WS_ACT) + (size_t)MP * DFF, (const bf16_t*)(ws + WS_WD2), DFF, 4, E);
        pg8::gemm_phase(X.lds, g, S, E);
        if (BOTH(11)) GRID_BAR();
    }
    if (MK_PH_ON(12) && IN(12)) for (int rep_ = 0; rep_ < MK_NREP(12); ++rep_) { if (rep_) GRID_BAR();
        const f32x4* gf = (const f32x4*)args.in[25] + X.lane;
        for (int m = X.gw; m < MTOT; m += X.NGW) { f32x4* y4 = (f32x4*)(out + O_Y + (size_t)m * DM) + X.lane; f32x4 v[4]; float s = 0.f;
#pragma unroll
            for (int j = 0; j < 4; ++j) { v[j] = y4[64 * j]; s += (v[j][0] * v[j][0] + v[j][1] * v[j][1]) + (v[j][2] * v[j][2] + v[j][3] * v[j][3]); }
#pragma unroll
            for (int off = 1; off < 64; off <<= 1) s += __shfl_xor(s, off);
            const float rt = 1.0f / sqrtf(s * (1.0f / DM) + EPS);
#pragma unroll
            for (int j = 0; j < 4; ++j) y4[64 * j] = v[j] * rt * gf[64 * j]; }
    }
#if MK_PROBE
    if (IN(13)) { f32x4* o4 = (f32x4*)(out + O_KVC_P); const size_t n4 = (O_TOTAL - O_KVC_P) / 4;
        for (size_t i = (size_t)X.gw * 64 + X.lane; i < n4; i += (size_t)X.NGW * 64) o4[i] = o4[i] * 3.0f; }
#endif
#undef IN
#undef BOTH
}

extern "C" void kernel_launch(void* const* d_in, const int* in_sizes, int n_in, void* d_out, int out_size, void* d_ws, size_t ws_size, hipStream_t stream) {
    static int grid = 0;
    if (grid == 0) {
        if (n_in != 26 || out_size != (int)O_TOTAL || ws_size < WS_END) { fprintf(stderr, "kernel_launch: unexpected shapes n_in %d out %d ws %zu\n", n_in, out_size, ws_size); grid = -1; return; }
        int dev = 0, cus = 0;
        if (hipGetDevice(&dev) != hipSuccess || hipDeviceGetAttribute(&cus, hipDeviceAttributeMultiprocessorCount, dev) != hipSuccess) { grid = -1; return; }
        if (hipFuncSetAttribute((const void*)nsa_fwd, hipFuncAttributeMaxDynamicSharedMemorySize, LDS_BYTES) != hipSuccess) { fprintf(stderr, "kernel_launch: hipFuncSetAttribute failed\n"); grid = -1; return; }
        int per_cu = 0;
        if (hipOccupancyMaxActiveBlocksPerMultiprocessor(&per_cu, (const void*)nsa_fwd, NTHR, LDS_BYTES) != hipSuccess || per_cu < 1) fprintf(stderr, "kernel_launch: occupancy query says %d\n", per_cu);
        (void)hipGetLastError();
        grid = cus;
    }
    if (grid < 0) return;
    (void)hipMemsetAsync((char*)d_ws + WS_CTL, 0, CTL_ZERO_BYTES, stream);
    Args a{};
    for (int i = 0; i < 26; ++i) a.in[i] = (const float*)d_in[i];
    a.out = (float*)d_out; a.ws = (unsigned char*)d_ws;
    constexpr int NPH = MK_LAST_PHASE + 1 + (MK_PROBE ? 1 : 0);
#if MK_PER_PHASE
    for (int p = (MK_PROBE ? -1 : 0); p < NPH; ++p) { a.ph_lo = p; a.ph_hi = p + 1; a.li = 0; hipLaunchKernelGGL(nsa_fwd, dim3(grid), dim3(NTHR), LDS_BYTES, stream, a); }
#else
    a.ph_lo = 0; a.ph_hi = NPH; a.li = 0; hipLaunchKernelGGL(nsa_fwd, dim3(grid), dim3(NTHR), LDS_BYTES, stream, a);
#endif
}
```

```cpp
#include <hip/hip_runtime.h>
#include <hip/hip_bf16.h>
#include <cstdio>
#include <cstdint>
#include <cmath>

#ifndef MK_PER_PHASE
#define MK_PER_PHASE 0
#endif
#ifndef MK_PH_MASK
#define MK_PH_MASK 0xffffffffu
#endif
#define MK_PH_ON(k) (((MK_PH_MASK >> (k)) & 1u) && !(MK_CHECK && (k) >= 8))
#ifndef MK_CHECK
#define MK_CHECK 0
#endif
#ifndef MK_CHECK_TOL
#define MK_CHECK_TOL 0.02f
#endif
#ifndef MK_CHECK_MAXBAD
#define MK_CHECK_MAXBAD 2
#endif
#ifndef MK_PROBE
#define MK_PROBE 0
#endif
#ifndef MK_DUP
#define MK_DUP (-1)
#endif
#define MK_NREP(k) ((k) == MK_DUP ? 2 : 1)
#ifndef MK_LAST_PHASE
#define MK_LAST_PHASE 12
#endif

constexpr int DM = 1024, NBP = 4, TP = 4096, MP = NBP * TP, NBS = 32, TS = 4, MS = NBS * TS, MTOT = MP + MS, MPAD = 16640;
constexpr int HD = 64, NH = 8, HKV = 2, GRP = 4, DFF = 2816, NGU = 2 * DFF, INW = 4888, INWP = 5120, DCONV = 512;
constexpr int PAST = 8192, NPAGE = 64, PAGE = 128, NPHYS = 2560;
constexpr int NBIDX = NBP + NBS;
constexpr int NMOD = 9 * DM;
constexpr float EPS = 1e-6f;
constexpr float LOG2E = 1.4426950408889634f;
constexpr float QSCALE = 0.125f * LOG2E;

constexpr size_t O_Y = 0;
constexpr size_t O_KVC_P = (size_t)MTOT * DM;
constexpr size_t O_KVS_P = O_KVC_P + (size_t)MP * 256;
constexpr size_t O_KVW_P = O_KVS_P + (size_t)MP * 256;
constexpr size_t O_CONV_P = O_KVW_P + (size_t)NBP * 512 * 256;
constexpr size_t O_KVC_S = O_CONV_P + (size_t)NBP * 2 * 512;
constexpr size_t O_KVS_S = O_KVC_S + (size_t)MS * 256;
constexpr size_t O_KVW_S = O_KVS_S + (size_t)MS * 256;
constexpr size_t O_CONV_S = O_KVW_S + (size_t)NBS * 512 * 256;
constexpr size_t O_TOTAL = O_CONV_S + (size_t)NBS * 2 * 512;
static_assert(O_TOTAL == 30117888, "output size");

constexpr size_t MiB = 1u << 20;
constexpr size_t WS_CTL = 0, CTL_ZERO_BYTES = 1 * MiB;
constexpr size_t WS_MOD = 1 * MiB;
constexpr size_t WS_PETERM = 3 * MiB;
constexpr size_t WS_SW2 = 4 * MiB;
constexpr size_t WS_SW3 = 5 * MiB;
constexpr size_t WS_SSQ2 = 6 * MiB, WS_SSQ3 = 8 * MiB;
constexpr size_t WS_SSQS2 = 7 * MiB + 512 * 1024, WS_SSQS3 = 9 * MiB + 512 * 1024;
constexpr size_t WS_GATES = 10 * MiB;
constexpr size_t WS_WGU1 = 16 * MiB;
constexpr size_t WS_WD1 = 28 * MiB;
constexpr size_t WS_WIN = 34 * MiB;
constexpr size_t WS_WM = 46 * MiB;
constexpr size_t WS_WO = 48 * MiB;
constexpr size_t WS_WGU2 = 50 * MiB;
constexpr size_t WS_WD2 = 62 * MiB;
constexpr size_t WS_WC1 = 68 * MiB;
constexpr size_t WS_A1 = 72 * MiB;
constexpr size_t WS_A2 = 106 * MiB;
constexpr size_t WS_A3 = 140 * MiB;
constexpr size_t WS_ACT = 174 * MiB;
constexpr size_t WS_H1 = 266 * MiB;
constexpr size_t WS_Q = 332 * MiB;
constexpr size_t WS_KS = 350 * MiB, WS_VS = 354 * MiB, WS_KW = 358 * MiB, WS_VW = 362 * MiB;
constexpr size_t WS_ACP = 366 * MiB;
constexpr size_t WS_PCP = 376 * MiB;
constexpr size_t WS_KCP = 380 * MiB, WS_VCP = 381 * MiB;
constexpr size_t WS_KVCS = 382 * MiB;
constexpr size_t WS_PROD = 400 * MiB;
constexpr size_t WS_CB = 418 * MiB;
constexpr size_t WS_RATIO = 436 * MiB;
constexpr size_t WS_GB = 470 * MiB;
constexpr size_t WS_ACAT = 504 * MiB;
constexpr size_t WS_MERGED = 538 * MiB;
constexpr size_t WS_PCS = 572 * MiB;
constexpr size_t WS_ACS = 608 * MiB;
constexpr size_t WS_END = 740 * MiB;

constexpr int CW_TMO = 0, CW_CODE = 1, CW_BAR = 4096;

#define GAS __attribute__((address_space(1)))
#define LAS __attribute__((address_space(3)))
typedef unsigned short bf16_t;
typedef short bf16x8 __attribute__((ext_vector_type(8)));
typedef float f32x4 __attribute__((ext_vector_type(4)));
typedef float f32x2 __attribute__((ext_vector_type(2)));
typedef unsigned u32x4 __attribute__((ext_vector_type(4)));
typedef unsigned u32x2 __attribute__((ext_vector_type(2)));
typedef GAS unsigned gu32;

__device__ __forceinline__ unsigned f2bf(float f) { unsigned u = __builtin_bit_cast(unsigned, f); return (u + 0x7fffu + ((u >> 16) & 1u)) >> 16; }
__device__ __forceinline__ unsigned pk2(float lo, float hi) { return f2bf(lo) | (f2bf(hi) << 16); }
__device__ __forceinline__ float bf2f(unsigned short b) { return __builtin_bit_cast(float, (unsigned)b << 16); }
__device__ __forceinline__ float bflo(unsigned w) { return __builtin_bit_cast(float, w << 16); }
__device__ __forceinline__ float bfhi(unsigned w) { return __builtin_bit_cast(float, w & 0xffff0000u); }
__device__ __forceinline__ float fast_exp2(float x) { return __builtin_amdgcn_exp2f(x); }
__device__ __forceinline__ float fast_rcp(float x) { return __builtin_amdgcn_rcpf(x); }
__device__ __forceinline__ float sigmoidf_(float x) { return fast_rcp(1.0f + fast_exp2(-x * LOG2E)); }
__device__ __forceinline__ float siluf_(float x) { return x * sigmoidf_(x); }
__device__ __forceinline__ int bidx_of_row(int row) { int b = row < MP ? (row >> 12) : NBP + ((row - MP) >> 2); return b < NBIDX ? b : NBIDX - 1; }
__device__ __forceinline__ const float* modp(const float* modv, int bidx, int sub, int kind) { return modv + ((size_t)(bidx * 3 + sub) * 3 + kind) * DM; }

__device__ __forceinline__ unsigned k_img(int ntile, int bg, int t, int d) { return (unsigned)((bg * ntile + (t >> 6)) * 4096 + (d >> 3) * 512 + (t & 63) * 8 + (d & 7)); }
__device__ __forceinline__ unsigned v_img(int ntile, int bg, int t, int d) { return (unsigned)((bg * ntile + (t >> 6)) * 4096 + ((d >> 5) * 4 + ((t & 63) >> 4)) * 512 + (t & 15) * 32 + (d & 31)); }

namespace pg8 {
constexpr int BM = 256, BK = 64, HALF = 128, HTB = HALF * BK * 2, STAGE_BYTES = 8 * HTB, NXCD = 8, WGM = 8;
__host__ __device__ __forceinline__ int lds_byte(int r, int c) { const int st = (r >> 4) * 2 + (c >> 5), rr = r & 15, cc = c & 31, ob = rr * 64 + cc * 2; return st * 1024 + (ob ^ (((ob >> 9) & 1) << 5)); }
__host__ __device__ __forceinline__ void stage_rc(int b, int& R, int& C) { const int st = b / 1024, sb = b % 1024, swz = sb ^ (((sb >> 9) & 1) << 5); R = (st >> 1) * 16 + swz / 64; C = (st & 1) * 32 + (swz % 64) / 2; }
__host__ __device__ __forceinline__ int perm32(int rho) { const int n = rho >> 4, i = rho & 15; return 8 * (i >> 2) + 4 * n + (i & 3); }
struct Unit { int pm, pn; };
struct Gemm { const bf16_t* A; const bf16_t* Bt; int M, N, K; };
struct StaticOrder {
    int nM, nN, nwg, G, c;
    __host__ __device__ void init(int M, int N, int G_, int c_) { nM = M / BM; nN = N / BM; nwg = nM * nN; G = G_; c = c_; }
    __host__ __device__ bool next(int i, Unit& u) const {
        const long L = (long)i * G + c; if (L >= nwg) return false;
        int wgid = (int)L; { const int q = nwg / NXCD, r = nwg % NXCD, xcd = wgid % NXCD, off = wgid / NXCD; wgid = (xcd < r ? xcd * (q + 1) : r * (q + 1) + (xcd - r) * q) + off; }
        const int nig = WGM * nN, gid = wgid / nig, fm = gid * WGM, gsz = (nM - fm) < WGM ? (nM - fm) : WGM;
        u.pm = fm + ((wgid % nig) % gsz); u.pn = (wgid % nig) / gsz; return true;
    }
    __device__ __forceinline__ void a_ready(const Unit&) const {}
    __device__ __forceinline__ void done(const Unit&) const {}
};
template <class Epi, class Sched>
__device__ __forceinline__ void gemm_phase(LAS unsigned char* lds, const Gemm g, const Sched& S, const Epi& E) {
    const int tid = threadIdx.x, wid = __builtin_amdgcn_readfirstlane(tid >> 6), lane = tid & 63, wr = wid >> 2, wc = wid & 3, fr = lane & 15, fq = lane >> 4;
    const int K = g.K, nt = K / BK;
    unsigned voffA[2], voffB[2];
#pragma unroll
    for (int i = 0; i < 2; ++i) { int R, C; stage_rc(tid * 16 + i * 8192, R, C); const int Rb = Epi::PERM ? ((R & ~31) + perm32(R & 31)) : R;
        voffA[i] = (unsigned)(R * K + C) * 2u; voffB[i] = (unsigned)(Rb * K + C) * 2u; }
    const size_t kstep = (size_t)(BK * 2);
    const size_t hstep = (size_t)HALF * K * 2;
    const size_t tstep = 2 * hstep;
    const unsigned ldsw = (unsigned)wid * 1024u;
    const int aoff = lds_byte(wr * 64 + fr, fq * 8), boff = lds_byte(wc * 32 + fr, fq * 8);
#define PG8_SA(b, h) (((b) * 2 + (h)) * HTB)
#define PG8_SB(b, h) ((4 + (b) * 2 + (h)) * HTB)
#define PG8_STAGE(bufoff, gbase, voff) do { _Pragma("unroll") for (int _i = 0; _i < 2; ++_i) \
        __builtin_amdgcn_global_load_lds((const unsigned*)((const char*)(gbase) + (voff)[_i]), (LAS unsigned*)(lds + (bufoff) + ldsw + _i * 8192), 16, 0, 0); } while (0)
#define PG8_LDA(dst, b, h) do { _Pragma("unroll") for (int m = 0; m < 4; ++m) _Pragma("unroll") for (int k = 0; k < 2; ++k) dst[m][k] = *(const LAS bf16x8*)(lds + PG8_SA(b, h) + aoff + m * 2048 + k * 1024); } while (0)
#define PG8_LDB(dst, b, h) do { _Pragma("unroll") for (int n = 0; n < 2; ++n) _Pragma("unroll") for (int k = 0; k < 2; ++k) dst[n][k] = *(const LAS bf16x8*)(lds + PG8_SB(b, h) + boff + n * 2048 + k * 1024); } while (0)
#define PG8_MMA(ai, bj, At, Bt) do { __builtin_amdgcn_s_setprio(1); _Pragma("unroll") for (int m = 0; m < 4; ++m) _Pragma("unroll") for (int n = 0; n < 2; ++n) _Pragma("unroll") for (int k = 0; k < 2; ++k) \
        acc[ai][bj][m][n] = __builtin_amdgcn_mfma_f32_16x16x32_bf16(Bt[n][k], At[m][k], acc[ai][bj][m][n], 0, 0, 0); __builtin_amdgcn_s_setprio(0); } while (0)
#define PG8_WAIT_V(n) asm volatile("s_waitcnt vmcnt(" #n ")" ::: "memory")
#define PG8_WAIT_L(n) asm volatile("s_waitcnt lgkmcnt(" #n ")" ::: "memory")
#define PG8_BAR __builtin_amdgcn_s_barrier()
#define PG8_SCHED __builtin_amdgcn_sched_barrier(0)
    Unit cur, nxt; int ui = 0;
    if (!S.next(0, cur)) return;
    f32x4 acc[2][2][4][2];
#pragma unroll
    for (int a = 0; a < 2; ++a)
#pragma unroll
        for (int b = 0; b < 2; ++b)
#pragma unroll
            for (int m = 0; m < 4; ++m)
#pragma unroll
                for (int n = 0; n < 2; ++n) acc[a][b][m][n] = (f32x4){0.f, 0.f, 0.f, 0.f};
    bf16x8 At[4][2], B0[2][2], B1[2][2];
    const char* cA = (const char*)g.A + (size_t)cur.pm * tstep; const char* cB = (const char*)g.Bt + (size_t)cur.pn * tstep;
    S.a_ready(cur);
    PG8_STAGE(PG8_SB(0, 0), cB, voffB); PG8_STAGE(PG8_SB(0, 1), cB + hstep, voffB); PG8_STAGE(PG8_SA(0, 0), cA, voffA); PG8_STAGE(PG8_SA(0, 1), cA + hstep, voffA);
    if (wr == 1) PG8_BAR;
    PG8_WAIT_V(2); PG8_BAR;
    PG8_STAGE(PG8_SB(1, 0), cB + kstep, voffB); PG8_STAGE(PG8_SA(1, 0), cA + kstep, voffA); PG8_STAGE(PG8_SB(1, 1), cB + hstep + kstep, voffB);
    PG8_WAIT_V(6); PG8_BAR;
    for (;;) {
        const bool has_next = S.next(ui + 1, nxt);
        const char* nA = has_next ? (const char*)g.A + (size_t)nxt.pm * tstep : cA; const char* nB = has_next ? (const char*)g.Bt + (size_t)nxt.pn * tstep : cB;
        for (int t = 0; t < nt; t += 2) {
            const bool last = (t == nt - 2);
            const char* a1 = cA + (size_t)(t + 1) * kstep;
            const char* a2 = last ? nA : cA + (size_t)(t + 2) * kstep; const char* b2 = last ? nB : cB + (size_t)(t + 2) * kstep;
            const char* a3 = a2 + kstep; const char* b3 = b2 + kstep;
            if (last && has_next) S.a_ready(nxt);
            if constexpr (Epi::HAS_MID) { if (t == E.mid_t) E.mid(acc, cur, wr, wc, fr, fq); }
            PG8_LDB(B0, 0, 0); PG8_LDB(B1, 0, 1); PG8_SCHED; PG8_LDA(At, 0, 0); PG8_STAGE(PG8_SA(1, 1), a1 + hstep, voffA);
            PG8_WAIT_V(8); PG8_WAIT_L(0); PG8_BAR; PG8_MMA(0, 0, At, B0); PG8_MMA(0, 1, At, B1); PG8_BAR; PG8_SCHED;
            PG8_LDA(At, 0, 1); PG8_STAGE(PG8_SB(0, 0), b2, voffB); PG8_STAGE(PG8_SB(0, 1), b2 + hstep, voffB); PG8_STAGE(PG8_SA(0, 0), a2, voffA);
            PG8_WAIT_V(8); PG8_WAIT_L(0); PG8_BAR; PG8_MMA(1, 0, At, B0); PG8_MMA(1, 1, At, B1); PG8_BAR; PG8_SCHED;
            PG8_LDB(B0, 1, 0); PG8_LDB(B1, 1, 1); PG8_SCHED; PG8_LDA(At, 1, 0); PG8_STAGE(PG8_SA(0, 1), a2 + hstep, voffA);
            PG8_WAIT_V(8); PG8_WAIT_L(0); PG8_BAR; PG8_MMA(0, 0, At, B0); PG8_MMA(0, 1, At, B1); PG8_BAR; PG8_SCHED;
            PG8_LDA(At, 1, 1); PG8_STAGE(PG8_SB(1, 0), b3, voffB); PG8_STAGE(PG8_SB(1, 1), b3 + hstep, voffB); PG8_STAGE(PG8_SA(1, 0), a3, voffA);
            PG8_WAIT_V(8); PG8_WAIT_L(0); PG8_BAR; PG8_MMA(1, 0, At, B0); PG8_MMA(1, 1, At, B1); PG8_BAR; PG8_SCHED;
        }
        if (wr == 0) PG8_BAR;
        E(acc, cur, wr, wc, fr, fq); S.done(cur);
        if (!has_next) break;
#pragma unroll
        for (int a = 0; a < 2; ++a)
#pragma unroll
            for (int b = 0; b < 2; ++b)
#pragma unroll
                for (int m = 0; m < 4; ++m)
#pragma unroll
                    for (int n = 0; n < 2; ++n) acc[a][b][m][n] = (f32x4){0.f, 0.f, 0.f, 0.f};
        cur = nxt; cA = nA; cB = nB; ++ui;
        if (wr == 1) PG8_BAR;
    }
    PG8_WAIT_V(0);
    PG8_BAR;
#undef PG8_SA
#undef PG8_SB
#undef PG8_STAGE
#undef PG8_LDA
#undef PG8_LDB
#undef PG8_MMA
#undef PG8_WAIT_V
#undef PG8_WAIT_L
#undef PG8_BAR
#undef PG8_SCHED
}
__device__ __forceinline__ float row_rt(const float* ssq, const float* ssqs, int row) {
    float s;
    if (row < MP) { const f32x4* sp = (const f32x4*)(ssq + (size_t)row * 16); const f32x4 s0 = sp[0], s1 = sp[1], s2 = sp[2], s3 = sp[3];
        s = ((s0[0] + s0[1]) + (s0[2] + s0[3])) + ((s1[0] + s1[1]) + (s1[2] + s1[3])) + ((s2[0] + s2[1]) + (s2[2] + s2[3])) + ((s3[0] + s3[1]) + (s3[2] + s3[3])); }
    else { const f32x4* sp = (const f32x4*)(ssqs + (size_t)(row - MP) * 32); s = 0.f;
#pragma unroll
        for (int i = 0; i < 8; ++i) { const f32x4 v = sp[i]; s += (v[0] + v[1]) + (v[2] + v[3]); } }
    return 1.0f / sqrtf(s * (1.0f / DM) + EPS);
}
typedef f32x4 Acc[2][2][4][2];

struct EpiGU {
    static constexpr bool PERM = true, HAS_MID = false;
    bf16_t* ACT; const float* ssq; const float* shiftW; int ldsw; const float* ssqs;
    __device__ __forceinline__ void operator()(const Acc& acc, const Unit& u, int wr, int wc, int fr, int fq) const {
        const int cl = wc * 32 + 8 * fq;
#pragma unroll
        for (int ai = 0; ai < 2; ++ai)
#pragma unroll
            for (int m = 0; m < 4; ++m) {
                const int row = u.pm * BM + ai * HALF + wr * 64 + m * 16 + fr;
                float rt = 1.f; f32x4 sg[2], sv[2]; sg[0] = sg[1] = sv[0] = sv[1] = (f32x4){0.f, 0.f, 0.f, 0.f};
                if (ssq) {
                    rt = row_rt(ssq, ssqs, row);
                    const float* sw = shiftW + (size_t)bidx_of_row(row) * ldsw + u.pn * BM + cl;
                    sg[0] = *(const f32x4*)(sw); sg[1] = *(const f32x4*)(sw + 4); sv[0] = *(const f32x4*)(sw + HALF); sv[1] = *(const f32x4*)(sw + HALF + 4);
                }
                u32x4 w;
#pragma unroll
                for (int n = 0; n < 2; ++n) {
                    const f32x4 gv = acc[ai][0][m][n] * rt + sg[n], vv = acc[ai][1][m][n] * rt + sv[n];
                    const float a0 = siluf_(gv[0]) * vv[0], a1 = siluf_(gv[1]) * vv[1], a2 = siluf_(gv[2]) * vv[2], a3 = siluf_(gv[3]) * vv[3];
                    w[2 * n] = pk2(a0, a1); w[2 * n + 1] = pk2(a2, a3);
                }
                *(u32x4*)(ACT + (size_t)row * DFF + u.pn * HALF + cl) = w;
            }
    }
};
template <bool HAS_A> struct EpiRes {
    static constexpr bool PERM = false, HAS_MID = false;
    const float* res_p; const float* res_s;
    float* out_p; float* out_s;
    const float* modv; int gsub;
    bf16_t* Aout; const float* gnorm; int ssub;
    float* ssq;
    float* ssqs;
    float gfac;
    template <int NQ> __device__ __forceinline__ float rowq(int row, int pn, int cb, const f32x4 q00, const f32x4 q01, const f32x4 q10, const f32x4 q11) const {
        const bool live = row < MTOT;
        const int bi = bidx_of_row(row);
        const float* rp = row < MP ? res_p + (size_t)row * DM : res_s + (size_t)(live ? row - MP : 0) * DM;
        float* op = row < MP ? out_p + (size_t)row * DM : out_s + (size_t)(live ? row - MP : 0) * DM;
        const float* gp = modp(modv, bi, gsub, 2); const float* scp = modp(modv, bi, ssub, 1);
        const float gf = gfac; bf16_t* const ao = Aout; const float* const gnp = gnorm;
        float sq = 0.f;
#pragma unroll
        for (int bj = 0; bj < 2; ++bj)
#pragma unroll
            for (int n = 0; n < NQ; ++n) {
                const int c = pn * BM + bj * HALF + cb + n * 16;
                const f32x4 r4 = *(const f32x4*)(rp + c), g4 = *(const f32x4*)(gp + c);
                const f32x4 qv = bj == 0 ? (n == 0 ? q00 : q01) : (n == 0 ? q10 : q11);
                const f32x4 h = r4 + (g4 * gf) * qv;
                if (live) *(f32x4*)(op + c) = h;
                sq += (h[0] * h[0] + h[1] * h[1]) + (h[2] * h[2] + h[3] * h[3]);
                if constexpr (HAS_A) { const f32x4 gn = *(const f32x4*)(gnp + c), sc = *(const f32x4*)(scp + c); const f32x4 a = h * gn * (sc + 1.0f);
                    u32x2 w; w.x = pk2(a[0], a[1]); w.y = pk2(a[2], a[3]); if (live) *(u32x2*)(ao + (size_t)row * DM + c) = w; }
            }
        return sq;
    }
    __device__ __forceinline__ void operator()(const Acc& acc, const Unit& u, int wr, int wc, int fr, int fq) const {
        const int bi = bidx_of_row(u.pm * BM), cb = u.pn * BM + wc * 32 + 4 * fq;
        const float* gp = modp(modv, bi, gsub, 2) + cb; const float* scp = modp(modv, bi, ssub, 1) + cb;
        f32x4 gq[2][2], aq[2][2];
#pragma unroll
        for (int bj = 0; bj < 2; ++bj)
#pragma unroll
            for (int n = 0; n < 2; ++n) { gq[bj][n] = *(const f32x4*)(gp + bj * HALF + n * 16) * gfac;
                if constexpr (HAS_A) aq[bj][n] = *(const f32x4*)(gnorm + cb + bj * HALF + n * 16) * (*(const f32x4*)(scp + bj * HALF + n * 16) + 1.0f); }
#pragma unroll
        for (int ai = 0; ai < 2; ++ai)
#pragma unroll
            for (int mp = 0; mp < 2; ++mp) {
                f32x4 r4[2][2][2];
#pragma unroll
                for (int mm = 0; mm < 2; ++mm) { const int row = u.pm * BM + ai * HALF + wr * 64 + (2 * mp + mm) * 16 + fr; const float* rp = res_p + (size_t)row * DM + cb;
#pragma unroll
                    for (int bj = 0; bj < 2; ++bj)
#pragma unroll
                        for (int n = 0; n < 2; ++n) r4[mm][bj][n] = *(const f32x4*)(rp + bj * HALF + n * 16); }
#pragma unroll
                for (int mm = 0; mm < 2; ++mm) { const int m = 2 * mp + mm, row = u.pm * BM + ai * HALF + wr * 64 + m * 16 + fr; float* op = out_p + (size_t)row * DM + cb; float sq = 0.f;
#pragma unroll
                    for (int bj = 0; bj < 2; ++bj)
#pragma unroll
                        for (int n = 0; n < 2; ++n) { const f32x4 h = r4[mm][bj][n] + gq[bj][n] * acc[ai][bj][m][n];
                            *(f32x4*)(op + bj * HALF + n * 16) = h; sq += (h[0] * h[0] + h[1] * h[1]) + (h[2] * h[2] + h[3] * h[3]);
                            if constexpr (HAS_A) { const f32x4 a = h * aq[bj][n]; u32x2 w; w.x = pk2(a[0], a[1]); w.y = pk2(a[2], a[3]); *(u32x2*)(Aout + (size_t)row * DM + cb + bj * HALF + n * 16) = w; } }
                    if (ssq) { sq += __shfl_xor(sq, 16); sq += __shfl_xor(sq, 32); if (fq == 0) ssq[(size_t)row * 16 + u.pn * 4 + wc] = sq; } }
                asm volatile("" ::: "memory");
            }
    }
    __device__ __forceinline__ void thin(int row, int pn, int h, int t, int fq, const f32x4 (&q)[2][1]) const {
        float sq = rowq<1>(row, pn, h * 64 + t * 16 + 4 * fq, q[0][0], q[0][0], q[1][0], q[1][0]);
        if (ssqs) { sq += __shfl_xor(sq, 16); sq += __shfl_xor(sq, 32); if (fq == 0) ssqs[(size_t)(row - MP) * 32 + (pn * 2 + h) * 4 + t] = sq; }
    }
};
struct EpiStoreBf16 {
    static constexpr bool PERM = true, HAS_MID = false;
    bf16_t* O; int ldc;
    __device__ __forceinline__ void thin(int row, int pn, int h, int t, int fq, const f32x4 (&q)[2][1]) const {
#pragma unroll
        for (int bj = 0; bj < 2; ++bj) { const f32x4 v = q[bj][0]; u32x2 w; w.x = pk2(v[0], v[1]); w.y = pk2(v[2], v[3]); *(u32x2*)(O + (size_t)row * ldc + pn * BM + bj * HALF + h * 64 + t * 16 + 4 * fq) = w; }
    }
    __device__ __forceinline__ void operator()(const Acc& acc, const Unit& u, int wr, int wc, int fr, int fq) const {
#pragma unroll
        for (int ai = 0; ai < 2; ++ai)
#pragma unroll
            for (int m = 0; m < 4; ++m) { const int row = u.pm * BM + ai * HALF + wr * 64 + m * 16 + fr;
#pragma unroll
                for (int bj = 0; bj < 2; ++bj) { const f32x4 v0 = acc[ai][bj][m][0], v1 = acc[ai][bj][m][1]; u32x4 w; w.x = pk2(v0[0], v0[1]); w.y = pk2(v0[2], v0[3]); w.z = pk2(v1[0], v1[1]); w.w = pk2(v1[2], v1[3]);
                    *(u32x4*)(O + (size_t)row * ldc + u.pn * BM + bj * HALF + wc * 32 + 8 * fq) = w; } }
    }
};
}

#define XB_TMO      128
#define XB_XCNT(j)  (256  + 64 * (j))
#define XB_XSUB(j)  (1280 + 64 * (j))
#define XB_XGEN(j)  (2304 + 64 * (j))
#define XB_TOP      3328
#define XB_TOPGEN   3392
#define XCD_BAR_WORDS 3456
#define XB_SPIN_CAP (1u << 18)
__device__ __forceinline__ unsigned xb_ld(unsigned* p)              { return __hip_atomic_load(p, __ATOMIC_RELAXED, __HIP_MEMORY_SCOPE_AGENT); }
__device__ __forceinline__ unsigned xb_add(unsigned* p, unsigned v) { return __hip_atomic_fetch_add(p, v, __ATOMIC_RELAXED, __HIP_MEMORY_SCOPE_AGENT); }
__device__ __forceinline__ unsigned xb_xcc_id() { return (unsigned)__builtin_amdgcn_s_getreg((3 << 11) | 20) & 0xFu; }
#define XB_SPIN(cond, bar) do { unsigned _sp = 0; while (cond) { __builtin_amdgcn_s_sleep(1); \
    if ((++_sp & 255u) == 0u) { if (xb_ld(&(bar)[XB_TMO])) break; if (_sp > XB_SPIN_CAP) { atomicAdd(&(bar)[XB_TMO], 1u); break; } } } } while (0)
struct XcdBarrier { unsigned* bar; unsigned x; volatile LAS unsigned* st; };
__device__ __forceinline__ XcdBarrier xcd_barrier_post(unsigned* bar, volatile LAS unsigned* st) {
    XcdBarrier b; b.bar = bar; b.x = xb_xcc_id(); b.st = st;
    if (threadIdx.x == 0) (void)xb_add(&bar[XB_XCNT(b.x)], 1u);
    return b;
}
__device__ __forceinline__ void xcd_barrier_complete(unsigned* bar, unsigned x, unsigned& nloc, unsigned& nx) {
    const unsigned G = gridDim.x * gridDim.y * gridDim.z;
    unsigned sum, cnt, mine, sp = 0u;
    for (;;) {
        sum = 0u; cnt = 0u; mine = 0u;
#pragma unroll
        for (unsigned j = 0; j < 16; ++j) { const unsigned c = xb_ld(&bar[XB_XCNT(j)]); sum += c; cnt += (c > 0u) ? 1u : 0u; mine = (j == x) ? c : mine; }
        if (sum == G) break;
        __builtin_amdgcn_s_sleep(1);
        if ((++sp & 255u) == 0u) { if (xb_ld(&bar[XB_TMO])) break; if (sp > XB_SPIN_CAP) { atomicAdd(&bar[XB_TMO], 1u); break; } }
    }
    nloc = mine > 0u ? mine : 1u; nx = cnt > 0u ? cnt : 1u;
}
__device__ __forceinline__ void xcd_barrier(const XcdBarrier& b) {
    asm volatile("s_waitcnt vmcnt(0)" ::: "memory");
    __syncthreads();
    if (threadIdx.x == 0) {
        unsigned* bar = b.bar;
        __builtin_amdgcn_s_waitcnt(0);
        unsigned nloc = b.st[0], nx = b.st[1];
        if (nloc == 0u) { xcd_barrier_complete(bar, b.x, nloc, nx); b.st[0] = nloc; b.st[1] = nx; }
        const unsigned old = xb_add(&bar[XB_XSUB(b.x)], 1u);
        const unsigned gen = old / nloc;
        if (old + 1u == (gen + 1u) * nloc) {
            __builtin_amdgcn_fence(__ATOMIC_RELEASE, "agent");
            asm volatile("s_waitcnt vmcnt(0)" ::: "memory");
            const unsigned og = xb_add(&bar[XB_TOP], 1u);
            const unsigned tg = og / nx;
            if (og + 1u == (tg + 1u) * nx) xb_add(&bar[XB_TOPGEN], 1u);
            else XB_SPIN(xb_ld(&bar[XB_TOPGEN]) == tg, bar);
            __builtin_amdgcn_fence(__ATOMIC_ACQUIRE, "agent");
            xb_add(&bar[XB_XGEN(b.x)], 1u);
            asm volatile("s_waitcnt vmcnt(0)" ::: "memory");
        } else {
            XB_SPIN(xb_ld(&bar[XB_XGEN(b.x)]) == gen, bar);
            __builtin_amdgcn_fence(__ATOMIC_ACQUIRE, "agent");
            asm volatile("s_waitcnt vmcnt(0)" ::: "memory");
        }
    }
    __syncthreads();
}

constexpr int NWAVES = 8, NTHR = 512;
constexpr int RING_BYTES = 131072, LDSCTL_OFF = RING_BYTES, MISC_OFF = LDSCTL_OFF + 320, LDS_BYTES = 147456;
#define LDS_WAIT() asm volatile("s_waitcnt lgkmcnt(0)" ::: "memory")

struct Args {
    const float* in[26]; float* out; unsigned char* ws; int ph_lo, ph_hi, li, pad;
};
struct Ctx {
    LAS unsigned char* lds; int tid, lane, wave, vcu, G, gw, NGW;
};

__device__ __forceinline__ void ada_item(const Ctx& X, int it, const float* cp, const float* cs, const float* w_ada, const float* b_ada, float* modv) {
    const int j0 = it * 64, w = X.wave, lane = X.lane, kr = lane >> 4, c4 = lane & 15;
    LAS float* sl = (LAS float*)X.lds + w * (18 * 128);
    LAS float* part = (LAS float*)(X.lds + 73728);
    for (int rh = 0; rh < 2; ++rh) {
        for (int idx = lane; idx < 18 * 128; idx += 64) { const int r = rh * 18 + idx / 128, kk = idx % 128, k = w * 128 + kk;
            const float cv = r < NBP ? cp[r * DM + k] : cs[(r - NBP) * DM + k]; sl[idx] = cv / (1.0f + __expf(-cv)); }
        LDS_WAIT(); __syncthreads();
        f32x4 acc[18];
#pragma unroll
        for (int r = 0; r < 18; ++r) acc[r] = (f32x4){0.f, 0.f, 0.f, 0.f};
        const float* wp = w_ada + (size_t)(w * 128 + kr) * NMOD + j0 + 4 * c4;
#pragma unroll 8
        for (int i = 0; i < 32; ++i) { const f32x4 wv = *(const f32x4*)(wp + (size_t)(4 * i) * NMOD);
#pragma unroll
            for (int r = 0; r < 18; ++r) acc[r] += wv * sl[r * 128 + 4 * i + kr]; }
#pragma unroll
        for (int r = 0; r < 18; ++r) {
#pragma unroll
            for (int e = 0; e < 4; ++e) { float v = acc[r][e]; v += __shfl_xor(v, 16); v += __shfl_xor(v, 32); acc[r][e] = v; }
            if (kr == 0) *(LAS f32x4*)(part + (w * 18 + r) * 64 + 4 * c4) = acc[r]; }
        LDS_WAIT(); __syncthreads();
        for (int o = X.tid; o < 18 * 64; o += NTHR) { const int r = o / 64, j = o % 64; float sum = b_ada[j0 + j];
#pragma unroll
            for (int ww = 0; ww < 8; ++ww) sum += part[(ww * 18 + r) * 64 + j];
            modv[(size_t)(rh * 18 + r) * NMOD + j0 + j] = sum; }
        __syncthreads();
    }
}
struct TJ { int src, srcoff_stride, N, K, col0, col_stride, ncols, dst, dpitch, drow0, drow_stride, dcol0, rep; };
__constant__ TJ kJobs[] = {
    {12, 0, NGU, DM, 0,    128, 128, 0, DM, 0,   256, 0, 22},
    {12, 0, NGU, DM, DFF,  128, 128, 0, DM, 128, 256, 0, 22},
    {13, 0, DM, DFF, 0, 0, DM, 1, DFF, 0, 0, 0, 1},
    {16, 0, INW, DM, 0,    0, 1280, 2, DM, 0, 0, 0, 1},
    {16, 0, INW, DM, 1304, 128, 128, 2, DM, 1280, 256, 0, 4},
    {16, 0, INW, DM, 2328, 128, 128, 2, DM, 1408, 256, 0, 4},
    {16, 0, INW, DM, 1816, 0, 512, 2, DM, 2304, 0, 0, 1},
    {16, 0, INW, DM, 2840, 128, 128, 2, DM, 2816, 256, 0, 8},
    {16, 0, INW, DM, 3864, 128, 128, 2, DM, 2944, 256, 0, 8},
    {16, 0, INW, DM, 1280, 0, 24, 2, DM, 4864, 0, 0, 1},
    {21, 0, DM, 512, 0, 0, DM, 3, DM, 0, 0, 0, 1},
    {22, 0, DM, 512, 0, 0, DM, 3, DM, 0, 0, 512, 1},
    {23, 0, DM, DM, 0, 0, DM, 4, DM, 0, 0, 0, 1},
    {14, 0, NGU, DM, 0,    128, 128, 5, DM, 0,   256, 0, 22},
    {14, 0, NGU, DM, DFF,  128, 128, 5, DM, 128, 256, 0, 22},
    {15, 0, DM, DFF, 0, 0, DM, 6, DFF, 0, 0, 0, 1},
    {17, 1024 * 128, 128, DM, 0, 0, 128, 7, DM, 0, 128, 0, 4},
};
constexpr int NJOBS = sizeof(kJobs) / sizeof(TJ);
__device__ __forceinline__ int tj_items(const TJ& j) { return j.rep * (j.K / 64) * ((j.ncols + 63) / 64); }
__device__ __forceinline__ void transpose_item(const float* W, int N, int ncols, bf16_t* WT, int dpitch, LAS float* scr, int kb, int nb, int lane) {
    const int k0 = 64 * kb, n0 = 64 * nb, kr = lane >> 4, c4 = lane & 15; const bool okc = (n0 + 4 * c4) < ncols;
    f32x4 v[16];
#pragma unroll
    for (int i = 0; i < 16; ++i) v[i] = okc ? *(const f32x4*)(W + (size_t)(k0 + 4 * i + kr) * N + n0 + 4 * c4) : (f32x4){0.f, 0.f, 0.f, 0.f};
#pragma unroll
    for (int i = 0; i < 16; ++i) { const int k = 4 * i + kr; *(LAS f32x4*)(scr + k * 64 + ((4 * c4 + 4 * (k >> 3)) & 63)) = v[i]; }
    LDS_WAIT(); asm volatile("" ::: "memory");
    const int c = lane & 7, nl = lane >> 3;
#pragma unroll
    for (int j = 0; j < 8; ++j) { const int n = nl + 8 * j; const LAS float* sp = scr + (8 * c) * 64 + ((n + 4 * c) & 63);
        u32x4 o; o.x = pk2(sp[0 * 64], sp[1 * 64]); o.y = pk2(sp[2 * 64], sp[3 * 64]); o.z = pk2(sp[4 * 64], sp[5 * 64]); o.w = pk2(sp[6 * 64], sp[7 * 64]);
        if (n0 + n < ncols) *(u32x4*)(WT + (size_t)(n0 + n) * dpitch + k0 + 8 * c) = o; }
    LDS_WAIT(); asm volatile("" ::: "memory");
}
__device__ __forceinline__ bf16_t* wdst(unsigned char* ws, int id) {
    const size_t off = id == 0 ? WS_WGU1 : id == 1 ? WS_WD1 : id == 2 ? WS_WIN : id == 3 ? WS_WM : id == 4 ? WS_WO : id == 5 ? WS_WGU2 : id == 6 ? WS_WD2 : WS_WC1;
    return (bf16_t*)(ws + off);
}

struct EpiIn {
    static constexpr bool PERM = false, HAS_MID = false;
    const float* ssq; const float* ssqs; const float* shiftW; float* out; unsigned char* ws;
    template <int CASE, int NQ> __device__ __forceinline__ void rowq(int row, int pn, int cb, const f32x4 (&q)[2][NQ]) const {
        using namespace pg8;
        const bool live = row < MTOT, isp = row < MP;
        const float rt = row_rt(ssq, ssqs, row);
        const float* sw = shiftW + (size_t)bidx_of_row(row) * INWP + pn * BM + cb;
        const int b = isp ? (row >> 12) : ((row - MP) >> 2), t = isp ? (row & (TP - 1)) : ((row - MP) & 3);
#define PV(bj, n) (q[bj][n] * rt + *(const f32x4*)(sw + (bj) * HALF + (n) * 16))
        if constexpr (CASE == 0) {
            bf16_t* Q = (bf16_t*)(ws + WS_Q) + (size_t)row * 512 + pn * BM + cb;
#pragma unroll
            for (int bj = 0; bj < 2; ++bj)
#pragma unroll
                for (int n = 0; n < NQ; ++n) { const f32x4 v = PV(bj, n) * QSCALE; u32x2 w; w.x = pk2(v[0], v[1]); w.y = pk2(v[2], v[3]); *(u32x2*)(Q + bj * HALF + n * 16) = w; }
        } else if constexpr (CASE >= 1 && CASE <= 3) {
            const size_t obase = CASE == 1 ? (isp ? O_KVC_P + (size_t)row * 256 : O_KVC_S + (size_t)(row - MP) * 256)
                               : CASE == 2 ? (isp ? O_KVS_P + (size_t)row * 256 : O_KVS_S + (size_t)(row - MP) * 256)
                               : (isp ? O_KVW_P + ((size_t)b * 512 + (t - (TP - 512))) * 256 : O_KVW_S + ((size_t)b * 512 + 508 + t) * 256);
            const bool wout = live && (CASE != 3 || !isp || t >= TP - 512);
#pragma unroll
            for (int bj = 0; bj < 2; ++bj)
#pragma unroll
                for (int n = 0; n < NQ; ++n) { const int j = bj * HALF + cb + n * 16; const f32x4 v = PV(bj, n);
                    if (wout) *(f32x4*)(out + obase + j) = v;
                    if (isp) { const int gg = (j >> 6) & 1, d = j & 63; u32x2 w; w.x = pk2(v[0], v[1]); w.y = pk2(v[2], v[3]);
                        if constexpr (CASE == 1) *(u32x2*)((bf16_t*)(ws + WS_ACP) + ((size_t)(bj * 8 + b * 2 + gg) * 256 + (t >> 4)) * 1024 + (t & 15) * 64 + d) = w;
                        else *(u32x2*)((bf16_t*)(ws + (CASE == 2 ? (bj ? WS_VS : WS_KS) : (bj ? WS_VW : WS_KW))) + (bj ? v_img(TP / 64, b * 2 + gg, t, d) : k_img(TP / 64, b * 2 + gg, t, d))) = w; } }
        } else if constexpr (CASE == 4) {
            const bool wout = live && (isp ? t >= TP - 2 : t >= 2);
            const size_t obase = isp ? O_CONV_P + ((size_t)b * 2 + (t - (TP - 2))) * 512 : O_CONV_S + ((size_t)b * 2 + (t - 2)) * 512;
#pragma unroll
            for (int n = 0; n < NQ; ++n) { const int j = (pn - 5) * HALF + cb + n * 16; const f32x4 v = PV(0, n) * PV(1, n);
                u32x2 w; w.x = pk2(v[0], v[1]); w.y = pk2(v[2], v[3]); *(u32x2*)((bf16_t*)(ws + WS_PROD) + (size_t)row * 512 + j) = w;
                if (wout) *(f32x4*)(out + obase + j) = v; }
        } else if constexpr (CASE == 5) {
#pragma unroll
            for (int bj = 0; bj < 2; ++bj)
#pragma unroll
                for (int n = 0; n < NQ; ++n) { const int j = (pn - 9) * BM + bj * HALF + cb + n * 16; const f32x4 v = PV(bj, n);
                    u32x2 w; w.x = pk2(v[0], v[1]); w.y = pk2(v[2], v[3]); *(u32x2*)((bf16_t*)(ws + WS_CB) + (size_t)row * 512 + j) = w; }
        } else if constexpr (CASE == 6) {
#pragma unroll
            for (int n = 0; n < NQ; ++n) { const int j = (pn - 11) * HALF + cb + n * 16; const f32x4 a = PV(0, n), bb = PV(1, n);
                float ra[4], gb[4];
#pragma unroll
                for (int e = 0; e < 4; ++e) { const float sa = sigmoidf_(a[e]), sb = sigmoidf_(bb[e]); gb[e] = sb; ra[e] = sa / sb; }
                u32x2 w; w.x = pk2(ra[0], ra[1]); w.y = pk2(ra[2], ra[3]); *(u32x2*)((bf16_t*)(ws + WS_RATIO) + (size_t)row * DM + j) = w;
                u32x2 w2; w2.x = pk2(gb[0], gb[1]); w2.y = pk2(gb[2], gb[3]); *(u32x2*)((bf16_t*)(ws + WS_GB) + (size_t)row * DM + j) = w2; }
        } else {
#pragma unroll
            for (int n = 0; n < NQ; ++n) { const int j = cb + n * 16; if (j < 24) { const f32x4 v = PV(0, n);
#pragma unroll
                for (int e = 0; e < 4; ++e) if (j + e < 24) ((float*)(ws + WS_GATES))[(size_t)row * 24 + j + e] = sigmoidf_(v[e]); } }
        }
#undef PV
    }
    template <int CASE> __device__ __forceinline__ void body(const pg8::Acc& acc, const pg8::Unit& u, int wr, int wc, int fr, int fq) const {
        using namespace pg8;
#pragma unroll
        for (int ai = 0; ai < 2; ++ai)
#pragma unroll
            for (int m = 0; m < 4; ++m) {
                const int row = u.pm * BM + ai * HALF + wr * 64 + m * 16 + fr;
                const f32x4 q[2][2] = {{acc[ai][0][m][0], acc[ai][0][m][1]}, {acc[ai][1][m][0], acc[ai][1][m][1]}};
                rowq<CASE, 2>(row, u.pn, wc * 32 + 4 * fq, q);
                asm volatile("" ::: "memory");
            }
    }
    __device__ __forceinline__ static int case_of(int pn) { return pn < 2 ? 0 : pn == 2 ? 1 : pn == 3 ? 2 : pn == 4 ? 3 : pn < 9 ? 4 : pn < 11 ? 5 : pn < 19 ? 6 : 7; }
    __device__ __forceinline__ void operator()(const pg8::Acc& acc, const pg8::Unit& u, int wr, int wc, int fr, int fq) const {
        const int cs = case_of(u.pn);
        if (cs == 0) body<0>(acc, u, wr, wc, fr, fq); else if (cs == 1) body<1>(acc, u, wr, wc, fr, fq); else if (cs == 2) body<2>(acc, u, wr, wc, fr, fq); else if (cs == 3) body<3>(acc, u, wr, wc, fr, fq);
        else if (cs == 4) body<4>(acc, u, wr, wc, fr, fq); else if (cs == 5) body<5>(acc, u, wr, wc, fr, fq); else if (cs == 6) body<6>(acc, u, wr, wc, fr, fq); else body<7>(acc, u, wr, wc, fr, fq);
    }
    __device__ __forceinline__ void thin(int row, int pn, int h, int t, int fq, const f32x4 (&q)[2][1]) const {
        const int cs = case_of(pn), cb = h * 64 + t * 16 + 4 * fq;
        if (cs == 0) rowq<0, 1>(row, pn, cb, q); else if (cs == 1) rowq<1, 1>(row, pn, cb, q); else if (cs == 2) rowq<2, 1>(row, pn, cb, q); else if (cs == 3) rowq<3, 1>(row, pn, cb, q);
        else if (cs == 4) rowq<4, 1>(row, pn, cb, q); else if (cs == 5) rowq<5, 1>(row, pn, cb, q); else if (cs == 6) rowq<6, 1>(row, pn, cb, q); else rowq<7, 1>(row, pn, cb, q);
    }
};

struct EpiMerge {
    static constexpr bool PERM = true, HAS_MID = true;
    int mid_t; const bf16_t* RAT; const bf16_t* GB; bf16_t* MERGED;
    __device__ __forceinline__ void mid(pg8::Acc& acc, const pg8::Unit& u, int wr, int wc, int fr, int fq) const {
        using namespace pg8;
        asm volatile("" : "+v"(fr), "+v"(fq));
#pragma unroll
        for (int ai = 0; ai < 2; ++ai)
#pragma unroll
            for (int m = 0; m < 4; ++m) { const int row = u.pm * BM + ai * HALF + wr * 64 + m * 16 + fr;
#pragma unroll
                for (int bj = 0; bj < 2; ++bj) { const u32x4 r = *(const u32x4*)(RAT + (size_t)row * DM + u.pn * BM + bj * HALF + wc * 32 + 8 * fq);
                    acc[ai][bj][m][0] *= (f32x4){bflo(r.x), bfhi(r.x), bflo(r.y), bfhi(r.y)}; acc[ai][bj][m][1] *= (f32x4){bflo(r.z), bfhi(r.z), bflo(r.w), bfhi(r.w)}; }
                asm volatile("" ::: "memory"); }
    }
    __device__ __forceinline__ void thin_mid(int row, int pn, int h, int t, int fq, f32x4 (&q)[2][1]) const {
#pragma unroll
        for (int bj = 0; bj < 2; ++bj) { const u32x2 r = *(const u32x2*)(RAT + (size_t)row * DM + pn * pg8::BM + bj * pg8::HALF + h * 64 + t * 16 + 4 * fq); q[bj][0] *= (f32x4){bflo(r.x), bfhi(r.x), bflo(r.y), bfhi(r.y)}; }
    }
    __device__ __forceinline__ void thin(int row, int pn, int h, int t, int fq, const f32x4 (&q)[2][1]) const {
#pragma unroll
        for (int bj = 0; bj < 2; ++bj) { const size_t off = (size_t)row * DM + pn * pg8::BM + bj * pg8::HALF + h * 64 + t * 16 + 4 * fq; const u32x2 r = *(const u32x2*)(GB + off);
            const f32x4 v = q[bj][0] * (f32x4){bflo(r.x), bfhi(r.x), bflo(r.y), bfhi(r.y)}; u32x2 w; w.x = pk2(v[0], v[1]); w.y = pk2(v[2], v[3]); *(u32x2*)(MERGED + off) = w; }
    }
    __device__ __forceinline__ void operator()(const pg8::Acc& acc, const pg8::Unit& u, int wr, int wc, int fr, int fq) const {
        using namespace pg8;
#pragma unroll
        for (int ai = 0; ai < 2; ++ai)
#pragma unroll
            for (int m = 0; m < 4; ++m) { const int row = u.pm * BM + ai * HALF + wr * 64 + m * 16 + fr;
#pragma unroll
                for (int bj = 0; bj < 2; ++bj) { const size_t off = (size_t)row * DM + u.pn * BM + bj * HALF + wc * 32 + 8 * fq; const u32x4 r = *(const u32x4*)(GB + off);
                    const f32x4 v0 = acc[ai][bj][m][0] * (f32x4){bflo(r.x), bfhi(r.x), bflo(r.y), bfhi(r.y)}, v1 = acc[ai][bj][m][1] * (f32x4){bflo(r.z), bfhi(r.z), bflo(r.w), bfhi(r.w)};
                    u32x4 w; w.x = pk2(v0[0], v0[1]); w.y = pk2(v0[2], v0[3]); w.z = pk2(v1[0], v1[1]); w.w = pk2(v1[2], v1[3]); *(u32x4*)(MERGED + off) = w; }
                asm volatile("" ::: "memory"); }
    }
};

__device__ __forceinline__ float gelu_tanh(float x) { const float u = 0.7978845608028654f * (x + 0.044715f * x * x * x); const float e = fast_exp2(2.0f * LOG2E * u); return 0.5f * x * (2.0f - 2.0f * fast_rcp(1.0f + e)); }
template <bool SAMPLE> __device__ __forceinline__ void cmp_tail_item(const Ctx& X, int item, unsigned char* ws, const float* w_cmp2, int& c_loaded) {
    constexpr int NR = SAMPLE ? 512 : 256, NCH = NR / 64, NBG = SAMPLE ? 64 : 8, NVALID = NR - 1;
    const int c = item / (NBG * NCH), bg = (item / NCH) % NBG, n0 = (item % NCH) * 64;
    LAS float* w2s = (LAS float*)X.lds; LAS float* hid = (LAS float*)(X.lds + 32768);
    const float* w2 = w_cmp2 + (size_t)c * 128 * 64; const float* pet = (const float*)(ws + WS_PETERM) + c * 128;
    const bf16_t* P = (const bf16_t*)(ws + (SAMPLE ? WS_PCS : WS_PCP)) + (size_t)c * (NBG * NR) * 256;
    if (c != c_loaded) { for (int i = X.tid; i < 128 * 64 / 4; i += NTHR) ((LAS f32x4*)w2s)[i] = ((const f32x4*)w2)[i]; c_loaded = c; }
#pragma unroll
    for (int k = 0; k < 2; ++k) { const int idx = X.tid + k * NTHR, r = idx >> 4, e8 = (idx & 15) * 8; const size_t base = (size_t)(bg * NR + n0 + r) * 256;
        const u32x4 a = *(const u32x4*)(P + base + e8), bb = *(const u32x4*)(P + base + 256 + 128 + e8); const f32x4 p0 = *(const f32x4*)(pet + e8), p1 = *(const f32x4*)(pet + e8 + 4);
#pragma unroll
        for (int j = 0; j < 4; ++j) { hid[r * 129 + e8 + 2 * j] = gelu_tanh(bflo(a[j]) + bflo(bb[j]) + (j < 2 ? p0[2 * j] : p1[2 * j - 4])); hid[r * 129 + e8 + 2 * j + 1] = gelu_tanh(bfhi(a[j]) + bfhi(bb[j]) + (j < 2 ? p0[2 * j + 1] : p1[2 * j - 3])); } }
    LDS_WAIT(); __syncthreads();
    const int r = X.tid >> 3, d0 = (X.tid & 7) * 8, n = n0 + r;
    float acc[8];
#pragma unroll
    for (int i = 0; i < 8; ++i) acc[i] = 0.f;
#pragma unroll 4
    for (int e = 0; e < 128; ++e) { const float h = hid[r * 129 + e]; const f32x4 wa = *(const LAS f32x4*)(w2s + e * 64 + d0), wb = *(const LAS f32x4*)(w2s + e * 64 + d0 + 4);
        acc[0] += h * wa[0]; acc[1] += h * wa[1]; acc[2] += h * wa[2]; acc[3] += h * wa[3]; acc[4] += h * wb[0]; acc[5] += h * wb[1]; acc[6] += h * wb[2]; acc[7] += h * wb[3]; }
    if constexpr (SAMPLE) {
        if (n < NVALID) { float* o = (float*)(ws + WS_KVCS) + (((size_t)bg * 512 + n) * 2 + c) * 64 + d0; *(f32x4*)o = (f32x4){acc[0], acc[1], acc[2], acc[3]}; *(f32x4*)(o + 4) = (f32x4){acc[4], acc[5], acc[6], acc[7]}; }
    } else {
        u32x4 w; if (n < NVALID) { w.x = pk2(acc[0], acc[1]); w.y = pk2(acc[2], acc[3]); w.z = pk2(acc[4], acc[5]); w.w = pk2(acc[6], acc[7]); } else w = (u32x4){0u, 0u, 0u, 0u};
        *(u32x4*)((bf16_t*)(ws + (c ? WS_VCP : WS_KCP)) + (c ? v_img(4, bg, n, d0) : k_img(4, bg, n, d0))) = w;
    }
    __syncthreads();
}

namespace att {
typedef float f32x16 __attribute__((ext_vector_type(16)));
typedef short s16x4 __attribute__((ext_vector_type(4)));
typedef float f32x2_t __attribute__((ext_vector_type(2))); typedef __bf16 bf16x2_t __attribute__((ext_vector_type(2)));
constexpr int L_K = 0, L_V = 24576, L_WSF = 49152, L_BIAS = 53248, L_GATE = 55296, L_SEL = 58368, L_ANY = 58880, L_PSLC = 59392, L_SC = 76288, L_OST = 92928, PL_LD = 66, SC_LD = 65;
static_assert(L_OST + 8 * 4096 <= RING_BYTES && L_SC + 64 * SC_LD * 4 <= L_OST && L_PSLC + 64 * PL_LD * 4 <= L_SC, "attention LDS map");
__constant__ unsigned char kBucket[128] = {0, 1, 2, 3, 4, 5, 6, 7, 8, 9, 10, 11, 12, 13, 14, 15, 16, 16, 16, 17, 17, 18, 18, 18, 19, 19, 19, 20, 20, 20, 20, 21, 21, 21, 21, 22, 22, 22, 22, 22, 23, 23, 23, 23, 23, 23, 24, 24, 24, 24, 24, 24, 25, 25, 25, 25, 25, 25, 25, 26, 26, 26, 26, 26, 26, 26, 26, 27, 27, 27, 27, 27, 27, 27, 27, 27, 27, 28, 28, 28, 28, 28, 28, 28, 28, 28, 28, 29, 29, 29, 29, 29, 29, 29, 29, 29, 29, 29, 29, 30, 30, 30, 30, 30, 30, 30, 30, 30, 30, 30, 30, 30, 30, 31, 31, 31, 31, 31, 31, 31, 31, 31, 31, 31, 31, 31, 31, 31};
__device__ __forceinline__ int crow(int r, int hi) { return (r & 3) + 8 * (r >> 2) + 4 * hi; }
__device__ __forceinline__ unsigned cvtpk_s(float lo, float hi) { f32x2_t v = {lo, hi}; bf16x2_t b = __builtin_convertvector(v, bf16x2_t); return __builtin_bit_cast(unsigned, b); }
#define ATT_SBAR() __builtin_amdgcn_sched_barrier(0)
__device__ __forceinline__ void qkt(f32x16& p0, f32x16& p1, const LAS unsigned char* Kslot, const bf16x8* qr, int r32, int hi, float cinit) {
    const LAS unsigned char* kb = Kslot + hi * 1024 + r32 * 16;
    f32x16 z;
#pragma unroll
    for (int r = 0; r < 16; ++r) z[r] = cinit;
    p0 = z; p1 = z;
#pragma unroll
    for (int d0 = 0; d0 < 4; ++d0) {
        const bf16x8 b0 = *(const LAS bf16x8*)(kb + d0 * 2048), b1 = *(const LAS bf16x8*)(kb + d0 * 2048 + 512);
        p0 = __builtin_amdgcn_mfma_f32_32x32x16_bf16(b0, qr[d0], p0, 0, 0, 0); p1 = __builtin_amdgcn_mfma_f32_32x32x16_bf16(b1, qr[d0], p1, 0, 0, 0); }
}
__device__ __forceinline__ float rowmax(const f32x16& p0, const f32x16& p1) {
    float a = fmaxf(p0[0], p1[0]);
#pragma unroll
    for (int r = 1; r < 16; ++r) a = fmaxf(a, fmaxf(p0[r], p1[r]));
    auto rr = __builtin_amdgcn_permlane32_swap(__float_as_uint(a), __float_as_uint(a), false, false);
    return fmaxf(__uint_as_float(rr[0]), __uint_as_float(rr[1]));
}
__device__ __forceinline__ float halfsum(float a) { auto rr = __builtin_amdgcn_permlane32_swap(__float_as_uint(a), __float_as_uint(a), false, false); return __uint_as_float(rr[0]) + __uint_as_float(rr[1]); }
__device__ __forceinline__ void pv(f32x16* o, int vb, bf16x8 pa0, bf16x8 pa1, bf16x8 pa2, bf16x8 pa3) {
#pragma unroll
    for (int d0 = 0; d0 < 2; ++d0) { s16x4 lo[4], hi[4];
#pragma unroll
        for (int ks = 0; ks < 4; ++ks) {
            asm volatile("ds_read_b64_tr_b16 %0,%1 offset:%c2" : "=&v"(lo[ks]) : "v"(vb), "i"(d0 * 4096 + ks * 1024) : "memory");
            asm volatile("ds_read_b64_tr_b16 %0,%1 offset:%c2" : "=&v"(hi[ks]) : "v"(vb), "i"(d0 * 4096 + ks * 1024 + 512) : "memory"); }
        asm volatile("s_waitcnt lgkmcnt(0)" ::: "memory"); ATT_SBAR();
#define ATT_PK(k) (bf16x8){lo[k][0], lo[k][1], lo[k][2], lo[k][3], hi[k][0], hi[k][1], hi[k][2], hi[k][3]}
        o[d0] = __builtin_amdgcn_mfma_f32_32x32x16_bf16(pa0, ATT_PK(0), o[d0], 0, 0, 0);
        o[d0] = __builtin_amdgcn_mfma_f32_32x32x16_bf16(pa1, ATT_PK(1), o[d0], 0, 0, 0);
        o[d0] = __builtin_amdgcn_mfma_f32_32x32x16_bf16(pa2, ATT_PK(2), o[d0], 0, 0, 0);
        o[d0] = __builtin_amdgcn_mfma_f32_32x32x16_bf16(pa3, ATT_PK(3), o[d0], 0, 0, 0);
#undef ATT_PK
    }
}
__device__ __forceinline__ void tile_dma(const bf16_t* Kt, const bf16_t* Vt, LAS unsigned char* lds, int slot, int wid, int lane) {
    __builtin_amdgcn_global_load_lds((const unsigned*)((const char*)Kt + wid * 1024 + lane * 16), (LAS unsigned*)(lds + L_K + slot * 8192 + wid * 1024), 16, 0, 0);
    __builtin_amdgcn_global_load_lds((const unsigned*)((const char*)Vt + wid * 1024 + lane * 16), (LAS unsigned*)(lds + L_V + slot * 8192 + wid * 1024), 16, 0, 0);
}
struct SM { float m, l; f32x16 o[2]; };
__device__ __forceinline__ void sm_init(SM& s) { s.m = -1e30f; s.l = 0.f;
#pragma unroll
    for (int r = 0; r < 16; ++r) { s.o[0][r] = 0.f; s.o[1][r] = 0.f; } }
template <bool WITH_O> __device__ __forceinline__ void sm_update(SM& s, f32x16& p0, f32x16& p1, LAS float* wsf, int r32, int hi, bool lm) {
    float rm = rowmax(p0, p1); rm = lm ? rm : -INFINITY;
    if (__any(rm > s.m + 8.0f)) {
        const float mnew = fmaxf(s.m, rm), alpha = fast_exp2(s.m - mnew); s.l *= alpha;
        if constexpr (WITH_O) { if (hi == 0) wsf[r32] = alpha; LDS_WAIT();
#pragma unroll
            for (int r = 0; r < 16; ++r) { const float f = wsf[crow(r, hi)]; s.o[0][r] *= f; s.o[1][r] *= f; }
            LDS_WAIT(); }
        s.m = mnew;
    }
    const float meff = lm ? s.m : INFINITY;
    float sum = 0.f;
#pragma unroll
    for (int r = 0; r < 16; ++r) { p0[r] = fast_exp2(p0[r] - meff); p1[r] = fast_exp2(p1[r] - meff); sum += p0[r] + p1[r]; }
    s.l += sum;
}
template <int MODE> __device__ __forceinline__ void mask_bias(f32x16& p0, f32x16& p1, int T, bool lsel, int qpos, int hi, const LAS float* bT) {
    const float NEG = -INFINITY;
    int base = MODE == 0 ? qpos - 1024 * T - 64 * hi - 31 : qpos - 64 * T - 4 * hi;
    asm volatile("" : "+v"(base));
#pragma unroll
    for (int r = 0; r < 16; ++r) { const int kk = (r & 3) + 8 * (r >> 2); int d0, d1; bool v0, v1;
        if (MODE == 0) { d0 = base - 16 * kk; d1 = d0 - 512; v0 = d0 >= 0; v1 = d1 >= 0; }
        else { d0 = base - kk; d1 = d0 - 32; if (MODE == 1) { v0 = lsel && d0 >= 0; v1 = lsel && d1 >= 0; } else { v0 = d0 >= 0 && d0 < 512; v1 = d1 >= 0 && d1 < 512; } }
        const float b0 = bT[min(max(d0, 0), 127)], b1 = bT[min(max(d1, 0), 127)];
        p0[r] = v0 ? p0[r] + b0 : NEG; p1[r] = v1 ? p1[r] + b1 : NEG; }
}
#define ATT_PACK(pw, P, B) pw = (u32x4){cvtpk_s(P[B], P[B + 1]), cvtpk_s(P[B + 2], P[B + 3]), cvtpk_s(P[B + 4], P[B + 5]), cvtpk_s(P[B + 6], P[B + 7])}
#define ATT_PV(S_, SLOT) do { u32x4 pw0, pw1, pw2, pw3; ATT_PACK(pw0, p0, 0); ATT_PACK(pw1, p0, 8); ATT_PACK(pw2, p1, 0); ATT_PACK(pw3, p1, 8); ATT_SBAR(); \
    pv((S_).o, vb0 + (SLOT) * 8192, __builtin_bit_cast(bf16x8, pw0), __builtin_bit_cast(bf16x8, pw1), __builtin_bit_cast(bf16x8, pw2), __builtin_bit_cast(bf16x8, pw3)); } while (0)
#define ATT_TILE_LOOP(NT, FIRST, NEXT, KB, VB, ...) do { const int nt_ = (NT); int t0_ = (FIRST), t1_ = t0_, t2_ = t0_; \
    tile_dma((KB) + (size_t)t0_ * 4096, (VB) + (size_t)t0_ * 4096, lds, 0, wid, lane); \
    if (nt_ > 1) { int tcur_ = t0_; (void)tcur_; t1_ = (NEXT); tile_dma((KB) + (size_t)t1_ * 4096, (VB) + (size_t)t1_ * 4096, lds, 1, wid, lane); } \
    for (int i_ = 0; i_ < nt_; ++i_) { \
        if (i_ + 1 < nt_) asm volatile("s_waitcnt vmcnt(2) lgkmcnt(0)" ::: "memory"); else asm volatile("s_waitcnt vmcnt(0) lgkmcnt(0)" ::: "memory"); \
        __builtin_amdgcn_s_barrier(); asm volatile("" ::: "memory"); \
        if (i_ + 2 < nt_) { int tcur_ = t1_; (void)tcur_; t2_ = (NEXT); tile_dma((KB) + (size_t)t2_ * 4096, (VB) + (size_t)t2_ * 4096, lds, (i_ + 2) % 3, wid, lane); } \
        { const int T = t0_; const int SLOT = i_ % 3; __VA_ARGS__ } \
        t0_ = t1_; t1_ = t2_; } \
    asm volatile("s_waitcnt lgkmcnt(0)" ::: "memory"); __builtin_amdgcn_s_barrier(); asm volatile("" ::: "memory"); } while (0)
#define ATT_FINISH(S_, BR) do { const float lt_ = halfsum((S_).l); const float inv_ = lt_ > 0.f ? 1.0f / lt_ : 0.f; \
    if (hi == 0) wsf[64 + r32] = inv_ * gt[qloc * 12 + (BR) * 4 + hh]; LDS_WAIT(); \
    _Pragma("unroll") for (int r = 0; r < 16; ++r) { const float f = wsf[64 + crow(r, hi)]; oacc[0][r] += (S_).o[0][r] * f; oacc[1][r] += (S_).o[1][r] * f; } LDS_WAIT(); asm volatile("" : "+v"(oacc[0]), "+v"(oacc[1])); } while (0)

__device__ __forceinline__ void prompt_item(const Ctx& X, int bg, int qt, unsigned char* ws, const float* rel_bias) {
    LAS unsigned char* lds = X.lds; int tid = X.tid; asm volatile("" : "+v"(tid));
    const int lane = tid & 63, wid = __builtin_amdgcn_readfirstlane(tid >> 6), r32 = lane & 31, hi = lane >> 5;
    const int b = bg >> 1, g = bg & 1, hh = wid >> 1, qh = wid & 1, q0 = qt * 64, qloc = qh * 32 + r32, qpos = q0 + qloc;
    LAS float* biasT = (LAS float*)(lds + L_BIAS); LAS float* gt = (LAS float*)(lds + L_GATE); LAS float* pslc = (LAS float*)(lds + L_PSLC); LAS float* sc = (LAS float*)(lds + L_SC);
    LAS float* wsf = (LAS float*)(lds + L_WSF) + wid * 128;
    const float* GATES = (const float*)(ws + WS_GATES);
    biasT[tid] = rel_bias[(int)kBucket[tid & 127] * 8 + g * 4 + (tid >> 7)] * LOG2E;
    for (int i = tid; i < 64 * 12; i += NTHR) { const int q = i / 12, e = i % 12; gt[i] = GATES[((size_t)b * TP + q0 + q) * 24 + (e >> 2) * 8 + g * 4 + (e & 3)]; }
    for (int i = tid; i < 64 * PL_LD; i += NTHR) pslc[i] = 0.f;
    if (tid < 2) ((LAS unsigned*)(lds + L_ANY))[tid] = 0u;
    bf16x8 qr[4];
    { const bf16_t* Qp = (const bf16_t*)(ws + WS_Q) + ((size_t)b * TP + qpos) * 512 + (g * 4 + hh) * 64 + hi * 8;
#pragma unroll
      for (int d0 = 0; d0 < 4; ++d0) qr[d0] = *(const bf16x8*)(Qp + d0 * 16); }
    LDS_WAIT(); __syncthreads();
    const LAS float* bT = biasT + hh * 128; const float b31 = bT[127];
    const int vb0 = (int)(unsigned)(uintptr_t)(lds + L_V) + ((lane >> 4) & 1) * 32 + (lane & 3) * 8 + (4 * hi + ((lane & 15) >> 2)) * 64;
    f32x16 oacc[2];
#pragma unroll
    for (int r = 0; r < 16; ++r) { oacc[0][r] = 0.f; oacc[1][r] = 0.f; }
    f32x16 p0, p1;
    { const bf16_t* KC = (const bf16_t*)(ws + WS_KCP) + (size_t)bg * 4 * 4096; const bf16_t* VC = (const bf16_t*)(ws + WS_VCP) + (size_t)bg * 4 * 4096;
      const int ncv = min(4 * qt + 3, 255), ntc = (ncv + 63) >> 6;
      SM s; sm_init(s);
      ATT_TILE_LOOP(ntc, 0, tcur_ + 1, KC, VC, {
          qkt(p0, p1, lds + L_K + SLOT * 8192, qr, r32, hi, 0.f); mask_bias<0>(p0, p1, T, true, qpos, hi, bT); sm_update<false>(s, p0, p1, wsf, r32, hi, true); });
      const float ltot = halfsum(s.l), invl = ltot > 0.f ? 1.0f / ltot : 0.f; s.l = 0.f;
      ATT_TILE_LOOP(ntc, 0, tcur_ + 1, KC, VC, {
          qkt(p0, p1, lds + L_K + SLOT * 8192, qr, r32, hi, 0.f); mask_bias<0>(p0, p1, T, true, qpos, hi, bT);
          float sum = 0.f;
          _Pragma("unroll") for (int r = 0; r < 16; ++r) { p0[r] = fast_exp2(p0[r] - s.m); p1[r] = fast_exp2(p1[r] - s.m); sum += p0[r] + p1[r]; }
          s.l += sum;
          float ga[8], gd[8], gp[8];
          _Pragma("unroll") for (int k4 = 0; k4 < 4; ++k4) { ga[k4] = 2.0f * (p0[4 * k4] + p0[4 * k4 + 1] + p0[4 * k4 + 2]) * invl; gd[k4] = p0[4 * k4 + 3] * invl;
              ga[4 + k4] = 2.0f * (p1[4 * k4] + p1[4 * k4 + 1] + p1[4 * k4 + 2]) * invl; gd[4 + k4] = p1[4 * k4 + 3] * invl; }
          _Pragma("unroll") for (int G = 0; G < 8; ++G) { auto sw = __builtin_amdgcn_permlane32_swap(__float_as_uint(gd[G]), __float_as_uint(gd[G]), false, false); gp[G] = __uint_as_float(hi ? sw[0] : sw[1]); }
          for (int rr = 0; rr < 4; ++rr) { if (hh == rr) { LAS float* pr = pslc + qloc * PL_LD + 16 * T + hi;
              _Pragma("unroll") for (int G = 0; G < 8; ++G) { const float prev = hi ? gp[G] : (G > 0 ? gp[G - 1] : 0.f); pr[2 * G] += ga[G] + gd[G] + prev; }
              if (hi) pr[15] += gd[7]; }
              LDS_WAIT(); __syncthreads(); }
          ATT_PV(s, SLOT); });
      ATT_FINISH(s, 0);
    }
    { const int q = tid >> 3, jg = tid & 7; float myv[8];
#pragma unroll
      for (int i = 0; i < 8; ++i) { const int j = jg * 8 + i; const float v = pslc[q * PL_LD + j];
          const bool valid = j <= qt, forced = (j == 0) || (j == qt) || (j == qt - 1);
          const float sv = valid ? v + (forced ? 1000.0f : 0.f) : -1e9f; myv[i] = sv; sc[q * SC_LD + j] = sv; }
      LDS_WAIT(); __syncthreads();
      int cnt[8];
#pragma unroll
      for (int i = 0; i < 8; ++i) cnt[i] = 0;
      for (int k = 0; k < 64; ++k) { const float v = sc[q * SC_LD + k];
#pragma unroll
          for (int i = 0; i < 8; ++i) cnt[i] += ((v > myv[i]) || (v == myv[i] && k < jg * 8 + i)) ? 1 : 0; }
      unsigned bits = 0u;
#pragma unroll
      for (int i = 0; i < 8; ++i) if (cnt[i] < 16 && jg * 8 + i <= qt) bits |= 1u << i;
      ((LAS unsigned char*)(lds + L_SEL))[q * 8 + jg] = (unsigned char)bits;
      atomicOr((unsigned*)((LAS unsigned*)(lds + L_ANY) + (jg >> 2)), bits << (8 * (jg & 3)));
      LDS_WAIT(); __syncthreads(); }
    { const unsigned lo_ = ((LAS unsigned*)(lds + L_SEL))[qloc * 2], hi_ = ((LAS unsigned*)(lds + L_SEL))[qloc * 2 + 1]; const unsigned long long selm = ((unsigned long long)hi_ << 32) | lo_;
      const unsigned long long anym = ((unsigned long long)((LAS unsigned*)(lds + L_ANY))[1] << 32) | ((LAS unsigned*)(lds + L_ANY))[0];
      unsigned long long rem = anym; const int nts = __builtin_popcountll(anym);
      const bf16_t* KS = (const bf16_t*)(ws + WS_KS) + (size_t)bg * TP * 64; const bf16_t* VS = (const bf16_t*)(ws + WS_VS) + (size_t)bg * TP * 64;
      SM s; sm_init(s);
      ATT_TILE_LOOP(nts, __builtin_ctzll(rem), (rem &= rem - 1, __builtin_ctzll(rem)), KS, VS, {
          const bool far = T + 3 <= qt; const bool lsel = ((selm >> T) & 1ull) != 0ull;
          qkt(p0, p1, lds + L_K + SLOT * 8192, qr, r32, hi, far ? b31 : 0.f);
          if (!far) mask_bias<1>(p0, p1, T, lsel, qpos, hi, bT);
          sm_update<true>(s, p0, p1, wsf, r32, hi, far ? lsel : true); ATT_PV(s, SLOT); });
      ATT_FINISH(s, 1);
    }
    { const int jw0 = max(0, qt - 8), ntw = qt - jw0 + 1;
      const bf16_t* KW = (const bf16_t*)(ws + WS_KW) + (size_t)bg * TP * 64; const bf16_t* VW = (const bf16_t*)(ws + WS_VW) + (size_t)bg * TP * 64;
      SM s; sm_init(s);
      ATT_TILE_LOOP(ntw, jw0, tcur_ + 1, KW, VW, {
          const bool far = (T + 3 <= qt) && (T + 8 > qt);
          qkt(p0, p1, lds + L_K + SLOT * 8192, qr, r32, hi, far ? b31 : 0.f);
          if (!far) mask_bias<2>(p0, p1, T, true, qpos, hi, bT);
          sm_update<true>(s, p0, p1, wsf, r32, hi, true); ATT_PV(s, SLOT); });
      ATT_FINISH(s, 2);
    }
    { LAS bf16_t* stg = (LAS bf16_t*)(lds + L_OST + wid * 4096);
#pragma unroll
      for (int r = 0; r < 16; ++r) { stg[crow(r, hi) * 64 + r32] = (bf16_t)f2bf(oacc[0][r]); stg[crow(r, hi) * 64 + 32 + r32] = (bf16_t)f2bf(oacc[1][r]); }
      LDS_WAIT();
      bf16_t* O = (bf16_t*)(ws + WS_ACAT) + ((size_t)b * TP + q0 + qh * 32) * DM + (g * 4 + hh) * 64;
#pragma unroll
      for (int i = 0; i < 4; ++i) { const int row = i * 8 + (lane >> 3), ch = lane & 7; const u32x4 v = *(const LAS u32x4*)(stg + row * 64 + ch * 8); *(u32x4*)(O + (size_t)row * DM + ch * 8) = v; }
    }
    LDS_WAIT(); __syncthreads();
}

constexpr int S_SC = 0, S_SCLD = 1040, S_PSUM = 16640  , S_SCORE = 18752  , S_SELIDX = 19328  , S_Q = 19456  , S_OH = 20480  , S_STAT = 22528  , S_GATE = 22592  , S_BIAS = 22656  ;
struct SampleCtx { int b, g, s, qpos; const float* cache_sel; const float* state_win; const int* pt; const float* out; const float* kvcs; };
template <int BR> __device__ __forceinline__ void skey(const SampleCtx& C, const LAS int* selidx, int k, const float*& Kp, int& dist, bool& valid) {
    if (BR == 0) { Kp = C.kvcs + (((size_t)(C.b * 2 + C.g) * 512 + k) * 2) * 64; dist = C.qpos - (16 * k + 31); valid = true; }
    else if (BR == 1) { const int j = selidx[k >> 6], r = k & 63;
        if (j < 128) { const int page = C.pt[C.b * NPAGE + (j >> 1)]; Kp = C.cache_sel + ((size_t)page * PAGE + (j & 1) * 64 + r) * 256 + C.g * 64; dist = C.qpos - (64 * j + r); valid = true; }
        else { const int rr = r < TS ? r : 0; Kp = C.out + O_KVS_S + ((size_t)C.b * TS + rr) * 256 + C.g * 64; dist = C.qpos - (PAST + r); valid = r <= C.s; } }
    else { Kp = (k < 512 ? C.state_win + ((size_t)C.b * 512 + k) * 256 : C.out + O_KVW_S + ((size_t)C.b * 512 + 508 + (k - 512)) * 256) + C.g * 64; dist = C.qpos - (PAST - 512 + k); valid = dist >= 0 && dist < 512; }
}
constexpr int S_KP = 24704  , S_META = 33024  , S_RED = 37184  ;
template <int BR> __device__ __forceinline__ void sample_branch(const Ctx& X, int tid, const SampleCtx& C, int nkeys, float& ofinal) {
    LAS unsigned char* lds = X.lds; const int lane = tid & 63, wid = __builtin_amdgcn_readfirstlane(tid >> 6);
    LAS float* scs = (LAS float*)(lds + S_SC); LAS float* qs = (LAS float*)(lds + S_Q); LAS float* stat = (LAS float*)(lds + S_STAT);
    LAS float* gts = (LAS float*)(lds + S_GATE); LAS float* bT = (LAS float*)(lds + S_BIAS); const LAS int* selidx = (const LAS int*)(lds + S_SELIDX);
    typedef const float* cfp; LAS cfp* kp = (LAS cfp*)(lds + S_KP); LAS int* meta = (LAS int*)(lds + S_META); LAS float* red = (LAS float*)(lds + S_RED);
    constexpr int VOFF = BR == 0 ? 64 : 128;
    for (int k = tid; k < nkeys; k += NTHR) { const float* Kp; int dist; bool valid; skey<BR>(C, selidx, k, Kp, dist, valid); kp[k] = Kp; meta[k] = valid ? min(max(dist, 0), 127) : -1; }
    LDS_WAIT(); __syncthreads();
    const int grp = tid >> 4, li = tid & 15, nit = (nkeys + 31) >> 5;
    { f32x4 q4[4];
#pragma unroll
      for (int h = 0; h < 4; ++h) q4[h] = *(const LAS f32x4*)(qs + h * 64 + li * 4);
      for (int i0 = 0; i0 < nit; i0 += 16) { f32x4 kx[16];
#pragma unroll
          for (int u = 0; u < 16; ++u) { const int k = grp + 32 * (i0 + u); kx[u] = k < nkeys ? *(const f32x4*)(kp[k] + li * 4) : (f32x4){0.f, 0.f, 0.f, 0.f}; }
#pragma unroll
          for (int u = 0; u < 16; ++u) { const int k = grp + 32 * (i0 + u); float pt4[4];
#pragma unroll
              for (int h = 0; h < 4; ++h) { float d = (kx[u][0] * q4[h][0] + kx[u][1] * q4[h][1]) + (kx[u][2] * q4[h][2] + kx[u][3] * q4[h][3]);
                  d += __shfl_xor(d, 1); d += __shfl_xor(d, 2); d += __shfl_xor(d, 4); d += __shfl_xor(d, 8); pt4[h] = d; }
              if (li < 4 && k < nkeys) { const float d = li == 0 ? pt4[0] : li == 1 ? pt4[1] : li == 2 ? pt4[2] : pt4[3]; const int mt = meta[k];
                  scs[li * S_SCLD + k] = mt >= 0 ? d + bT[li * 128 + mt] : -INFINITY; } } } }
    LDS_WAIT(); __syncthreads();
    if (wid < 4) { LAS float* sr = scs + wid * S_SCLD; float m = -INFINITY;
        for (int k = lane; k < nkeys; k += 64) m = fmaxf(m, sr[k]);
#pragma unroll
        for (int o = 1; o < 64; o <<= 1) m = fmaxf(m, __shfl_xor(m, o));
        if (m == -INFINITY) m = 0.f;
        float l = 0.f;
        for (int k = lane; k < nkeys; k += 64) { const float e = fast_exp2(sr[k] - m); sr[k] = e; l += e; }
#pragma unroll
        for (int o = 1; o < 64; o <<= 1) l += __shfl_xor(l, o);
        if (lane == 0) { stat[wid] = m; stat[4 + wid] = l; } }
    LDS_WAIT(); __syncthreads();
    { f32x4 acc[4];
#pragma unroll
      for (int h = 0; h < 4; ++h) acc[h] = (f32x4){0.f, 0.f, 0.f, 0.f};
      for (int i0 = 0; i0 < nit; i0 += 16) { f32x4 vx[16];
#pragma unroll
          for (int u = 0; u < 16; ++u) { const int k = grp + 32 * (i0 + u); vx[u] = k < nkeys ? *(const f32x4*)(kp[k] + VOFF + li * 4) : (f32x4){0.f, 0.f, 0.f, 0.f}; }
#pragma unroll
          for (int u = 0; u < 16; ++u) { const int k = grp + 32 * (i0 + u); if (k < nkeys) {
#pragma unroll
              for (int h = 0; h < 4; ++h) acc[h] += vx[u] * scs[h * S_SCLD + k]; } } }
#pragma unroll
      for (int h = 0; h < 4; ++h) *(LAS f32x4*)(red + (grp * 4 + h) * 64 + li * 4) = acc[h]; }
    LDS_WAIT(); __syncthreads();
    if (tid < 256) { const int h = tid >> 6, d = tid & 63; float o = 0.f;
#pragma unroll 8
        for (int gq = 0; gq < 32; ++gq) o += red[(gq * 4 + h) * 64 + d];
        const float l = stat[4 + h]; ofinal += o * (l > 0.f ? 1.0f / l : 0.f) * gts[BR * 4 + h]; }
}
__device__ __forceinline__ void sample_item(const Ctx& X, int item, unsigned char* ws, const Args& A) {
    LAS unsigned char* lds = X.lds; int tid = X.tid; asm volatile("" : "+v"(tid));
    SampleCtx C; C.b = item >> 3; C.g = (item >> 2) & 1; C.s = item & 3; C.qpos = PAST + C.s; C.cache_sel = A.in[3]; C.state_win = A.in[4]; C.pt = (const int*)A.in[6]; C.out = A.out; C.kvcs = (const float*)(ws + WS_KVCS);
    const int mrow = MP + C.b * TS + C.s;
    LAS float* scs = (LAS float*)(lds + S_SC); LAS float* qs = (LAS float*)(lds + S_Q); LAS float* stat = (LAS float*)(lds + S_STAT); LAS float* gts = (LAS float*)(lds + S_GATE); LAS float* bT = (LAS float*)(lds + S_BIAS);
    LAS float* psum = (LAS float*)(lds + S_PSUM); LAS float* score = (LAS float*)(lds + S_SCORE); LAS int* selidx = (LAS int*)(lds + S_SELIDX);
    bT[tid] = A.in[24][(int)kBucket[tid & 127] * 8 + C.g * 4 + (tid >> 7)] * LOG2E;
    if (tid < 256) qs[tid] = bf2f(((const bf16_t*)(ws + WS_Q))[(size_t)mrow * 512 + C.g * 256 + tid]);
    if (tid < 12) gts[tid] = ((const float*)(ws + WS_GATES))[(size_t)mrow * 24 + (tid >> 2) * 8 + C.g * 4 + (tid & 3)];
    LDS_WAIT(); __syncthreads();
    float ofinal = 0.f;
    sample_branch<0>(X, tid, C, 511, ofinal);
    for (int n = tid; n < 520; n += NTHR) { float v = 0.f; if (n < 511) { v = scs[n] / stat[4] + scs[S_SCLD + n] / stat[5] + scs[2 * S_SCLD + n] / stat[6] + scs[3 * S_SCLD + n] / stat[7]; } psum[n] = v; }
    LDS_WAIT(); __syncthreads();
    if (tid < 129) { const int j = tid; const float v = 2.0f * (psum[4 * j] + psum[4 * j + 1] + psum[4 * j + 2]) + psum[4 * j + 3] + (j > 0 ? psum[4 * j - 1] : 0.f);
        score[j] = v + ((j == 0 || j == 128 || j == 127) ? 1000.0f : 0.f); }
    LDS_WAIT(); __syncthreads();
    if (tid < 129) { const float mv = score[tid]; int cnt = 0; for (int k = 0; k < 129; ++k) { const float v = score[k]; cnt += ((v > mv) || (v == mv && k < tid)) ? 1 : 0; } if (cnt < 16) selidx[cnt] = tid; }
    LDS_WAIT(); __syncthreads();
    sample_branch<1>(X, tid, C, 1024, ofinal);
    __syncthreads();
    sample_branch<2>(X, tid, C, 516, ofinal);
    if (tid < 256) ((bf16_t*)(ws + WS_ACAT))[(size_t)mrow * DM + C.g * 256 + tid] = (bf16_t)f2bf(ofinal);
    LDS_WAIT(); __syncthreads();
}

#if MK_CHECK
#define KC ((const bf16_t*)(ws + WS_KCP))
#define VC ((const bf16_t*)(ws + WS_VCP))
#define KS ((const bf16_t*)(ws + WS_KS))
#define VS ((const bf16_t*)(ws + WS_VS))
#define KW ((const bf16_t*)(ws + WS_KW))
#define VW ((const bf16_t*)(ws + WS_VW))
__device__ __forceinline__ float kraw_at(const bf16_t* base, int bg, int rows, int t, int d, bool isv) { return bf2f(base[isv ? v_img(rows / 64, bg, t, d) : k_img(rows / 64, bg, t, d)]); }
constexpr int C_SC = 0, C_SCLD = 1040, C_PS = 16640, C_PSLC = 17920, C_BLK = 18432, C_Q = 18944, C_STAT = 19968, C_OUT = 20480, C_RED = 21504, C_GT = 21760;
__device__ __forceinline__ void chk_branch(const Ctx& X, int br, int nkeys, const bf16_t* Kb, const bf16_t* Vb, int bg, int rows, int g, int t, const float* rel_bias, bool keep_p) {
    LAS unsigned char* lds = X.lds; const int tid = X.tid, lane = X.lane, wid = X.wave;
    LAS float* sc = (LAS float*)(lds + C_SC); LAS float* stat = (LAS float*)(lds + C_STAT); LAS float* out = (LAS float*)(lds + C_OUT); LAS float* gt = (LAS float*)(lds + C_GT); LAS int* kpos = (LAS int*)(lds + 32768);
    if (wid < 4) { LAS float* sr = sc + wid * C_SCLD; float m = -INFINITY;
        for (int k = lane; k < nkeys; k += 64) m = fmaxf(m, sr[k]);
#pragma unroll
        for (int o = 1; o < 64; o <<= 1) m = fmaxf(m, __shfl_xor(m, o));
        float l = 0.f;
        if (m > -INFINITY) { for (int k = lane; k < nkeys; k += 64) { const float e = exp2f(sr[k] - m); sr[k] = e; l += e; } }
        else { for (int k = lane; k < nkeys; k += 64) sr[k] = 0.f; }
#pragma unroll
        for (int o = 1; o < 64; o <<= 1) l += __shfl_xor(l, o);
        const float inv = l > 0.f ? 1.0f / l : 0.f;
        for (int k = lane; k < nkeys; k += 64) sr[k] *= inv; }
    LDS_WAIT(); __syncthreads();
    if (tid < 256) { const int hh = tid >> 6, d = tid & 63; float acc = 0.f; for (int k = 0; k < nkeys; ++k) { const float p = sc[hh * C_SCLD + k]; if (p != 0.f) acc += p * kraw_at(Vb, bg, rows, kpos[k], d, true); }
        out[tid] += gt[br * 4 + hh] * acc; }
    LDS_WAIT(); __syncthreads();
}
__device__ __forceinline__ void check_item(const Ctx& X, int item, unsigned char* ws, const float* rel_bias, unsigned* flag) {
    LAS unsigned char* lds = X.lds; const int tid = X.tid;
    const int edge[16] = {0, 1, 30, 31, 32, 46, 47, 63, 64, 65, 127, 128, 511, 512, 4095, 2048};
    const int bg = item & 7, t = item < 16 ? edge[item & 15] : ((item * 2081 + 7) & (TP - 1)), b = bg >> 1, g = bg & 1, qt = t >> 6; const size_t m = (size_t)b * TP + t;
    LAS float* sc = (LAS float*)(lds + C_SC); LAS float* ps = (LAS float*)(lds + C_PS); LAS float* pslc = (LAS float*)(lds + C_PSLC); LAS int* blk = (LAS int*)(lds + C_BLK); LAS float* qs = (LAS float*)(lds + C_Q);
    LAS float* out = (LAS float*)(lds + C_OUT); LAS float* red = (LAS float*)(lds + C_RED); LAS float* gt = (LAS float*)(lds + C_GT); LAS int* kpos = (LAS int*)(lds + 32768);
    __syncthreads();
    if (tid < 256) { qs[tid] = bf2f(((const bf16_t*)(ws + WS_Q))[m * 512 + g * 256 + tid]); out[tid] = 0.f; }
    if (tid < 12) gt[tid] = ((const float*)(ws + WS_GATES))[m * 24 + (tid >> 2) * 8 + g * 4 + (tid & 3)];
    for (int i = tid; i < 260; i += NTHR) ps[i] = 0.f;
    LDS_WAIT(); __syncthreads();
    const int nv = t >= 31 ? min((t - 31) / 16 + 1, 255) : 0;
    for (int idx = tid; idx < 4 * 256; idx += NTHR) { const int hh = idx >> 8, n = idx & 255; if (n < nv) { float s = 0.f; for (int d = 0; d < 64; ++d) s += qs[hh * 64 + d] * kraw_at(KC, bg, 256, n, d, false);
            const int dist = t - (16 * n + 31); s += rel_bias[(int)kBucket[min(dist, 127)] * 8 + g * 4 + hh] * LOG2E; sc[hh * C_SCLD + n] = s; kpos[n] = n; } }
    LDS_WAIT(); __syncthreads();
    if (nv > 0) {
        { LAS float* stat = (LAS float*)(lds + C_STAT); if (X.wave < 4) { LAS float* sr = sc + X.wave * C_SCLD; float mx = -INFINITY; for (int k = X.lane; k < nv; k += 64) mx = fmaxf(mx, sr[k]);
#pragma unroll
              for (int o = 1; o < 64; o <<= 1) mx = fmaxf(mx, __shfl_xor(mx, o));
              float l = 0.f; for (int k = X.lane; k < nv; k += 64) l += exp2f(sr[k] - mx);
#pragma unroll
              for (int o = 1; o < 64; o <<= 1) l += __shfl_xor(l, o);
              if (X.lane == 0) { stat[X.wave] = mx; stat[4 + X.wave] = l; } }
          LDS_WAIT(); __syncthreads();
          for (int n = tid; n < nv; n += NTHR) { float v = 0.f; for (int hh = 0; hh < 4; ++hh) v += exp2f(sc[hh * C_SCLD + n] - stat[hh]) / stat[4 + hh]; ps[n] = v; }
          LDS_WAIT(); __syncthreads(); }
        chk_branch(X, 0, nv, KC, VC, bg, 256, g, t, rel_bias, true);
    }
    if (tid < 64) { const int j = tid; const float v = 2.0f * (ps[4 * j] + ps[4 * j + 1] + ps[4 * j + 2]) + ps[4 * j + 3] + (j > 0 ? ps[4 * j - 1] : 0.f);
        pslc[j] = (j <= qt) ? v + ((j == 0 || j == qt || j == qt - 1) ? 1000.0f : 0.f) : -1e9f; }
    LDS_WAIT(); __syncthreads();
    if (tid < 64) { const float mv = pslc[tid]; int cnt = 0; for (int k = 0; k < 64; ++k) { const float v = pslc[k]; cnt += ((v > mv) || (v == mv && k < tid)) ? 1 : 0; } blk[tid] = (cnt < 16 && tid <= qt) ? 1 : 0; }
    LDS_WAIT(); __syncthreads();
    if (tid == 0) { int nk = 0; for (int j = 0; j < 64; ++j) if (blk[j]) for (int r = 0; r < 64; ++r) { const int p = 64 * j + r; if (p <= t) kpos[nk++] = p; } blk[64] = nk; }
    LDS_WAIT(); __syncthreads();
    { const int nk = blk[64];
      for (int idx = tid; idx < 4 * nk; idx += NTHR) { const int hh = idx / nk, k = idx % nk, p = kpos[k]; float s = 0.f; for (int d = 0; d < 64; ++d) s += qs[hh * 64 + d] * kraw_at(KS, bg, TP, p, d, false);
          s += rel_bias[(int)kBucket[min(t - p, 127)] * 8 + g * 4 + hh] * LOG2E; sc[hh * C_SCLD + k] = s; }
      LDS_WAIT(); __syncthreads();
      chk_branch(X, 1, nk, KS, VS, bg, TP, g, t, rel_bias, false); }
    { const int nk = min(t + 1, 512), p0 = t - nk + 1;
      for (int k = tid; k < nk; k += NTHR) kpos[k] = p0 + k;
      LDS_WAIT(); __syncthreads();
      for (int idx = tid; idx < 4 * nk; idx += NTHR) { const int hh = idx / nk, k = idx % nk, p = p0 + k; float s = 0.f; for (int d = 0; d < 64; ++d) s += qs[hh * 64 + d] * kraw_at(KW, bg, TP, p, d, false);
          s += rel_bias[(int)kBucket[min(t - p, 127)] * 8 + g * 4 + hh] * LOG2E; sc[hh * C_SCLD + k] = s; }
      LDS_WAIT(); __syncthreads();
      chk_branch(X, 2, nk, KW, VW, bg, TP, g, t, rel_bias, false); }
    float err = 0.f, mag = 0.f;
    if (tid < 256) { const float ref = out[tid], fast = bf2f(((const bf16_t*)(ws + WS_ACAT))[m * DM + g * 256 + tid]); err = fabsf(ref - fast); mag = fabsf(ref); if (!(fast == fast)) err = 1e30f; }
#pragma unroll
    for (int o = 1; o < 64; o <<= 1) { err = fmaxf(err, __shfl_xor(err, o)); mag = fmaxf(mag, __shfl_xor(mag, o)); }
    if (X.lane == 0) { red[X.wave] = err; red[8 + X.wave] = mag; }
    LDS_WAIT(); __syncthreads();
    if (tid == 0) { float e = 0.f, mg = 0.f; for (int w = 0; w < 8; ++w) { e = fmaxf(e, red[w]); mg = fmaxf(mg, red[8 + w]); } if (e > MK_CHECK_TOL * mg + 1e-4f) atomicAdd(flag, 1u); }
    __syncthreads();
}
#undef KC
#undef VC
#undef KS
#undef VS
#undef KW
#undef VW
#endif
}

template <class Epi> __device__ __forceinline__ void thin_gemm(const Ctx& X, const bf16_t* A, const bf16_t* Bt, int K, int npn, const Epi& E, int nr32 = 4, int row0 = MP, int ushift = 0) {
    LAS f32x4* red = (LAS f32x4*)X.lds;
    int tid = X.tid; asm volatile("" : "+v"(tid));
    const int lane = tid & 63, wid = __builtin_amdgcn_readfirstlane(tid >> 6), fr = lane & 15, fq = lane >> 4;
    const int kw = K >> 3, nks = kw >> 5, nunits = npn * 8 * nr32;
    int cu = (int)blockIdx.x - ushift; if (cu < 0) cu += X.G;
    for (int u = cu; u < nunits; u += X.G) {
        const int r32 = u % nr32, uc = u / nr32, c16 = uc & 7, pn = uc >> 3;
        const bf16_t* ap = A + (size_t)(32 * r32 + fr) * K + wid * kw + 8 * fq;
        const bf16_t* bp = Bt + (size_t)(pn * 256 + 16 * c16 + fr) * K + wid * kw + 8 * fq;
        const size_t a16 = (size_t)16 * K, b128 = (size_t)128 * K;
        f32x4 acc[2][2];
#pragma unroll
        for (int rt = 0; rt < 2; ++rt) { acc[rt][0] = (f32x4){0.f, 0.f, 0.f, 0.f}; acc[rt][1] = (f32x4){0.f, 0.f, 0.f, 0.f}; }
        for (int ks0 = 0; ks0 < nks; ks0 += 6) {
            bf16x8 af[6][2], bf[6][2];
#pragma unroll
            for (int i = 0; i < 6; ++i) if (ks0 + i < nks) { const int ko = 32 * (ks0 + i);
                af[i][0] = *(const bf16x8*)(ap + ko); af[i][1] = *(const bf16x8*)(ap + a16 + ko); bf[i][0] = *(const bf16x8*)(bp + ko); bf[i][1] = *(const bf16x8*)(bp + b128 + ko); }
#pragma unroll
            for (int i = 0; i < 6; ++i) if (ks0 + i < nks) {
#pragma unroll
                for (int rt = 0; rt < 2; ++rt) { acc[rt][0] = __builtin_amdgcn_mfma_f32_16x16x32_bf16(bf[i][0], af[i][rt], acc[rt][0], 0, 0, 0); acc[rt][1] = __builtin_amdgcn_mfma_f32_16x16x32_bf16(bf[i][1], af[i][rt], acc[rt][1], 0, 0, 0); } }
        }
#pragma unroll
        for (int rt = 0; rt < 2; ++rt) { red[((wid * 2 + rt) * 2 + 0) * 64 + lane] = acc[rt][0]; red[((wid * 2 + rt) * 2 + 1) * 64 + lane] = acc[rt][1]; }
        LDS_WAIT(); __syncthreads();
        if (wid < 2) { const int rt = wid; f32x4 q[2][1];
#pragma unroll
            for (int bj = 0; bj < 2; ++bj) { f32x4 v = red[((0 * 2 + rt) * 2 + bj) * 64 + lane];
#pragma unroll
                for (int w = 1; w < 4; ++w) v += red[((w * 2 + rt) * 2 + bj) * 64 + lane];
                q[bj][0] = v; }
            const int row = row0 + 32 * r32 + 16 * rt + fr, h = c16 >> 2, t = c16 & 3;
            if constexpr (Epi::HAS_MID) E.thin_mid(row, pn, h, t, fq, q);
#pragma unroll
            for (int bj = 0; bj < 2; ++bj) { f32x4 v = q[bj][0];
#pragma unroll
                for (int w = 4; w < 8; ++w) v += red[((w * 2 + rt) * 2 + bj) * 64 + lane];
                q[bj][0] = v; }
            E.thin(row, pn, h, t, fq, q); }
        __syncthreads();
    }
}

__global__ void __launch_bounds__(NTHR, 2) nsa_fwd(Args args) {
    extern __shared__ __attribute__((aligned(16))) unsigned char lds_raw[];
    Ctx X; X.lds = (LAS unsigned char*)lds_raw; X.tid = threadIdx.x; X.lane = X.tid & 63; X.wave = __builtin_amdgcn_readfirstlane(X.tid >> 6);
    X.G = gridDim.x; { const int bx = blockIdx.x; X.vcu = (X.G % 8 == 0) ? (bx % 8) * (X.G / 8) + bx / 8 : bx; }
    X.gw = X.vcu * NWAVES + X.wave; X.NGW = X.G * NWAVES;
    unsigned char* ws = args.ws; float* out = args.out;
    gu32* ctl = (gu32*)(ws + WS_CTL);
    volatile LAS unsigned* MISC = (volatile LAS unsigned*)(X.lds + MISC_OFF);
    for (int u = X.tid; u < (LDS_BYTES - LDSCTL_OFF) / 4; u += NTHR) ((LAS unsigned*)(X.lds + LDSCTL_OFF))[u] = 0u;
    __syncthreads();
    XcdBarrier bar; bar.bar = (unsigned*)(ctl + CW_BAR); bar.x = 0; bar.st = nullptr;
#if !MK_PER_PHASE
    bar = xcd_barrier_post((unsigned*)(ctl + CW_BAR), MISC + 8);
#define GRID_BAR() xcd_barrier(bar)
#else
#define GRID_BAR() do { } while (0)
#endif
    const int lo = args.ph_lo, hi = args.ph_hi;
#define IN(k) (lo <= (k) && (k) < hi)
#define BOTH(k) (IN(k) && IN((k) + 1))
    float* modv = (float*)(ws + WS_MOD);
    const float* x_p = args.in[0]; const float* x_s = args.in[1];

#if MK_PROBE
    if (IN(-1)) { f32x4* o4 = (f32x4*)(out + O_KVC_P); const size_t n4 = (O_TOTAL - O_KVC_P) / 4;
        for (size_t i = (size_t)X.gw * 64 + X.lane; i < n4; i += (size_t)X.NGW * 64) o4[i] = (f32x4){100.f, 100.f, 100.f, 100.f}; }
#endif
    if (MK_PH_ON(0) && IN(0)) for (int rep_ = 0; rep_ < MK_NREP(0); ++rep_) { if (rep_) GRID_BAR();
        for (int rp = 0; rp < MK_NREP(20); ++rp)
        for (int it = X.vcu; it < NMOD / 64; it += X.G) ada_item(X, it, args.in[7], args.in[8], args.in[9], args.in[10], modv);
        __syncthreads();
        {
            LAS float* scr = (LAS float*)(X.lds + X.wave * 16384);
            int total = 0;
            for (int j = 0; j < NJOBS; ++j) total += tj_items(kJobs[j]);
            for (int it = X.gw; it < total * MK_NREP(21); it += X.NGW) {
                int r = it % total, j = 0;
                for (; j < NJOBS - 1; ++j) { const int n = tj_items(kJobs[j]); if (r < n) break; r -= n; }
                const TJ J = kJobs[j];
                const int nblk = (J.ncols + 63) / 64, per = (J.K / 64) * nblk, rep = r / per, rr = r % per, kb = rr / nblk, nb = rr % nblk;
                const float* W = args.in[J.src] + (size_t)rep * J.srcoff_stride + J.col0 + rep * J.col_stride;
                bf16_t* WT = wdst(ws, J.dst) + (size_t)(J.drow0 + rep * J.drow_stride) * J.dpitch + J.dcol0;
                transpose_item(W, J.N, J.ncols, WT, J.dpitch, scr, kb, nb, X.lane);
            }
            { u32x4* z = (u32x4*)((bf16_t*)(ws + WS_WIN) + (size_t)INW * DM); const int nz = (INWP - INW) * DM * 2 / 16;
              for (int i = X.gw * 64 + X.lane; i < nz; i += X.NGW * 64) z[i] = (u32x4){0u, 0u, 0u, 0u}; }
        }
        for (int o = X.gw; o < 256; o += X.NGW) { const int c = o >> 7, e = o & 127; const float* pe = args.in[19] + c * 2048; const float* w1 = args.in[17] + (size_t)c * 2048 * 128 + e;
            float s = 0.f; for (int k = X.lane; k < 2048; k += 64) s += pe[k] * w1[(size_t)k * 128];
#pragma unroll
            for (int off = 1; off < 64; off <<= 1) s += __shfl_xor(s, off);
            if (X.lane == 0) ((float*)(ws + WS_PETERM))[o] = s; }
        { const f32x4* src = (const f32x4*)args.in[4]; f32x4* dst = (f32x4*)(out + O_KVW_S); const int per_b = 508 * 64;
          for (int i = X.gw * 64 + X.lane; i < NBS * per_b; i += X.NGW * 64) { const int b = i / per_b, r = i % per_b; dst[(size_t)b * 512 * 64 + r] = src[(size_t)b * 512 * 64 + 4 * 64 + r]; } }
        { const int* pt = (const int*)args.in[6]; const float* cache = args.in[2]; bf16_t* ACS = (bf16_t*)(ws + WS_ACS);
          for (int it0 = X.gw; it0 < NBS * 512 * MK_NREP(22); it0 += X.NGW) { const int it = it0 & (NBS * 512 - 1); const int b = it >> 9, n = it & 511; const int page = pt[b * NPAGE + (n >> 3)];
              const f32x4* src = (const f32x4*)(cache + ((size_t)page * PAGE + (n & 7) * 16) * 256) + X.lane;
              const int c = X.lane >> 5, g = (X.lane >> 4) & 1, d = (X.lane & 15) * 4;
              bf16_t* dst = ACS + ((size_t)c * 32768 + (size_t)(b * 2 + g) * 512 + n) * 1024 + d;
              f32x4 v[16];
#pragma unroll
              for (int l = 0; l < 16; ++l) v[l] = src[l * 64];
#pragma unroll
              for (int l = 0; l < 16; ++l) { u32x2 w; w.x = pk2(v[l][0], v[l][1]); w.y = pk2(v[l][2], v[l][3]); *(u32x2*)(dst + l * 64) = w; } } }
        if (BOTH(0)) GRID_BAR();
    }

    if (MK_PH_ON(1) && IN(1)) for (int rep_ = 0; rep_ < MK_NREP(1); ++rep_) { if (rep_) GRID_BAR();
        { const float* g1 = args.in[11]; bf16_t* A1 = (bf16_t*)(ws + WS_A1);
          for (int m = X.gw; m < MPAD; m += X.NGW) {
              unsigned long long* o8 = (unsigned long long*)(A1 + (size_t)m * DM) + X.lane;
              if (m >= MTOT) {
#pragma unroll
                  for (int j = 0; j < 4; ++j) o8[64 * j] = 0ull;
                  continue; }
              const float* xr = m < MP ? x_p + (size_t)m * DM : x_s + (size_t)(m - MP) * DM; const int bi = bidx_of_row(m);
              const f32x4* x4 = (const f32x4*)xr + X.lane; f32x4 v[4]; float s = 0.f;
#pragma unroll
              for (int j = 0; j < 4; ++j) { v[j] = x4[64 * j]; s += (v[j][0] * v[j][0] + v[j][1] * v[j][1]) + (v[j][2] * v[j][2] + v[j][3] * v[j][3]); }
#pragma unroll
              for (int off = 1; off < 64; off <<= 1) s += __shfl_xor(s, off);
              const float rt = 1.0f / sqrtf(s * (1.0f / DM) + EPS);
              const f32x4* gg = (const f32x4*)g1 + X.lane; const f32x4* sh = (const f32x4*)modp(modv, bi, 0, 0) + X.lane; const f32x4* sc = (const f32x4*)modp(modv, bi, 0, 1) + X.lane;
#pragma unroll
              for (int j = 0; j < 4; ++j) { const f32x4 a = v[j] * rt * gg[64 * j] * (sc[64 * j] + 1.0f) + sh[64 * j];
                  o8[64 * j] = (unsigned long long)pk2(a[0], a[1]) | ((unsigned long long)pk2(a[2], a[3]) << 32); }
          } }
        for (int second = 0; second < 2; ++second) {
            constexpr int SP = 1024 + 8;
            LAS bf16_t* shl = (LAS bf16_t*)X.lds;
            __syncthreads();
            for (int i = X.tid; i < 48 * 256; i += NTHR) { const int bi = i >> 8, k4 = (i & 255) * 4; const f32x4 a = *(const f32x4*)(modp(modv, bi < NBIDX ? bi : NBIDX - 1, second ? 2 : 1, 0) + k4);
                u32x2 w; w.x = pk2(a[0], a[1]); w.y = pk2(a[2], a[3]); *(LAS u32x2*)(shl + bi * SP + k4) = w; }
            LDS_WAIT(); __syncthreads();
            const int nrows = second ? NGU : INWP; const bf16_t* Wt = (const bf16_t*)(ws + (second ? WS_WGU2 : WS_WIN)); float* dst = (float*)(ws + (second ? WS_SW3 : WS_SW2));
            const int fr = X.lane & 15, fq = X.lane >> 4;
            for (int it = X.gw; it < nrows / 16; it += X.NGW) { const int n0 = it * 16; f32x4 acc[3];
#pragma unroll
                for (int bt = 0; bt < 3; ++bt) acc[bt] = (f32x4){0.f, 0.f, 0.f, 0.f};
                const bf16_t* wr = Wt + (size_t)(n0 + fr) * DM + 8 * fq;
#pragma unroll 8
                for (int ks = 0; ks < 32; ++ks) { const bf16x8 af = *(const bf16x8*)(wr + 32 * ks);
#pragma unroll
                    for (int bt = 0; bt < 3; ++bt) { const bf16x8 bfr = *(const LAS bf16x8*)(shl + (16 * bt + fr) * SP + 32 * ks + 8 * fq); acc[bt] = __builtin_amdgcn_mfma_f32_16x16x32_bf16(af, bfr, acc[bt], 0, 0, 0); } }
#pragma unroll
                for (int bt = 0; bt < 3; ++bt) { const int bi = 16 * bt + fr; if (bi < NBIDX) *(f32x4*)(dst + (size_t)bi * nrows + n0 + 4 * fq) = acc[bt]; } }
        }
        __syncthreads();
        for (int c = 0; c < 2; ++c) {
            pg8::Gemm g{(const bf16_t*)(ws + WS_ACS) + (size_t)c * 32768 * 1024, (const bf16_t*)(ws + WS_WC1) + (size_t)c * 256 * 1024, 32768, 256, DM};
            pg8::StaticOrder S; S.init(32768, 256, X.G, (int)((blockIdx.x + (c ? X.G - 128 : 0)) % X.G));
            pg8::EpiStoreBf16 E{(bf16_t*)(ws + WS_PCS) + (size_t)c * 32768 * 256, 256};
            pg8::gemm_phase(X.lds, g, S, E);
        }
        if (BOTH(1)) GRID_BAR();
    }

    if (MK_PH_ON(2) && IN(2)) for (int rep_ = 0; rep_ < MK_NREP(2); ++rep_) { if (rep_) GRID_BAR();
        pg8::Gemm g{(const bf16_t*)(ws + WS_A1), (const bf16_t*)(ws + WS_WGU1), MPAD, NGU, DM}; pg8::StaticOrder S; S.init(MPAD, NGU, X.G, (int)blockIdx.x);
        pg8::EpiGU E{(bf16_t*)(ws + WS_ACT), nullptr, nullptr, 0, nullptr};
        pg8::gemm_phase(X.lds, g, S, E);
        if (BOTH(2)) GRID_BAR();
    }
    if (MK_PH_ON(3) && IN(3)) for (int rep_ = 0; rep_ < MK_NREP(3); ++rep_) { if (rep_) GRID_BAR();
        pg8::Gemm g{(const bf16_t*)(ws + WS_ACT), (const bf16_t*)(ws + WS_WD1), MP, DM, DFF}; pg8::StaticOrder S; S.init(MP, DM, X.G, (int)blockIdx.x);
        float* H1 = (float*)(ws + WS_H1);
        pg8::EpiRes<true> E{x_p, x_s, H1, H1 + (size_t)MP * DM, modv, 0, (bf16_t*)(ws + WS_A2), args.in[11] + DM, 1, (float*)(ws + WS_SSQ2), (float*)(ws + WS_SSQS2), 0.5f};
        thin_gemm(X, (const bf16_t*)(ws + WS_ACT) + (size_t)MP * DFF, (const bf16_t*)(ws + WS_WD1), DFF, 4, E);
        pg8::gemm_phase(X.lds, g, S, E);
        if (BOTH(3)) GRID_BAR();
    }
    if (MK_PH_ON(4) && IN(4)) for (int rep_ = 0; rep_ < MK_NREP(4); ++rep_) { if (rep_) GRID_BAR();
        pg8::Gemm g{(const bf16_t*)(ws + WS_A2), (const bf16_t*)(ws + WS_WIN), MP, INWP, DM}; pg8::StaticOrder S; S.init(MP, INWP, X.G, (int)blockIdx.x);
        EpiIn E{(const float*)(ws + WS_SSQ2), (const float*)(ws + WS_SSQS2), (const float*)(ws + WS_SW2), out, ws};
        thin_gemm(X, (const bf16_t*)(ws + WS_A2) + (size_t)MP * DM, (const bf16_t*)(ws + WS_WIN), DM, 20, E);
        pg8::gemm_phase(X.lds, g, S, E);
        if (BOTH(4)) GRID_BAR();
    }
    if (MK_PH_ON(5) && IN(5)) for (int rep_ = 0; rep_ < MK_NREP(5); ++rep_) { if (rep_) GRID_BAR();
        for (int c = 0; c < 2; ++c) {
            pg8::EpiStoreBf16 E{(bf16_t*)(ws + WS_PCP) + (size_t)c * 2048 * 256, 256};
            thin_gemm(X, (const bf16_t*)(ws + WS_ACP) + (size_t)c * 2048 * 1024, (const bf16_t*)(ws + WS_WC1) + (size_t)c * 256 * 1024, DM, 1, E, 64, 0, 0);
        }
        __syncthreads();
        { const bf16_t* PROD = (const bf16_t*)(ws + WS_PROD); const bf16_t* CBb = (const bf16_t*)(ws + WS_CB); bf16_t* ACAT = (bf16_t*)(ws + WS_ACAT);
          const float* wcv = args.in[20]; const float* stc = args.in[5]; const int j = X.lane * 8;
          float w0[8], w1[8], w2[8];
#pragma unroll
          for (int e = 0; e < 8; ++e) { w0[e] = wcv[j + e]; w1[e] = wcv[512 + j + e]; w2[e] = wcv[1024 + j + e]; }
          for (int m = X.gw; m < MTOT; m += X.NGW) {
              const bool isp = m < MP; const int t = isp ? (m & (TP - 1)) : ((m - MP) & 3), bs = isp ? 0 : ((m - MP) >> 2);
              const u32x4 v0 = *(const u32x4*)(PROD + (size_t)m * 512 + j), c4 = *(const u32x4*)(CBb + (size_t)m * 512 + j);
              const u32x4 v1 = *(const u32x4*)(PROD + (size_t)max(m - 1, 0) * 512 + j), v2 = *(const u32x4*)(PROD + (size_t)max(m - 2, 0) * 512 + j);
              const f32x4 s1a = *(const f32x4*)(stc + ((size_t)bs * 2 + 1) * 512 + j), s1b = *(const f32x4*)(stc + ((size_t)bs * 2 + 1) * 512 + j + 4);
              const f32x4 s2a = *(const f32x4*)(stc + ((size_t)bs * 2 + (t & 1)) * 512 + j), s2b = *(const f32x4*)(stc + ((size_t)bs * 2 + (t & 1)) * 512 + j + 4);
              float a2[8], a1[8], a0[8], cbv[8];
#pragma unroll
              for (int e = 0; e < 4; ++e) { a0[2 * e] = bflo(v0[e]); a0[2 * e + 1] = bfhi(v0[e]); cbv[2 * e] = bflo(c4[e]); cbv[2 * e + 1] = bfhi(c4[e]);
                  a1[2 * e] = bflo(v1[e]); a1[2 * e + 1] = bfhi(v1[e]); a2[2 * e] = bflo(v2[e]); a2[2 * e + 1] = bfhi(v2[e]); }
              if (t < 1) {
#pragma unroll
                  for (int e = 0; e < 8; ++e) a1[e] = isp ? 0.f : (e < 4 ? s1a[e] : s1b[e - 4]); }
              if (t < 2) {
#pragma unroll
                  for (int e = 0; e < 8; ++e) a2[e] = isp ? 0.f : (e < 4 ? s2a[e] : s2b[e - 4]); }
              float y[8];
#pragma unroll
              for (int e = 0; e < 8; ++e) y[e] = cbv[e] * (w0[e] * a2[e] + w1[e] * a1[e] + w2[e] * a0[e]);
              u32x4 w; w.x = pk2(y[0], y[1]); w.y = pk2(y[2], y[3]); w.z = pk2(y[4], y[5]); w.w = pk2(y[6], y[7]);
              *(u32x4*)(ACAT + (size_t)m * DM + 512 + j) = w; } }
        { int cl = -1; for (int it = X.vcu; it < 2 * 64 * 8; it += X.G) cmp_tail_item<true>(X, it, ws, args.in[18], cl); }
        if (BOTH(5)) GRID_BAR();
    }
    if (MK_PH_ON(6) && IN(6)) for (int rep_ = 0; rep_ < MK_NREP(6); ++rep_) { if (rep_) GRID_BAR();
        { int cl = -1; for (int it = X.vcu; it < 2 * 8 * 4; it += X.G) cmp_tail_item<false>(X, it, ws, args.in[18], cl); }
        if (BOTH(6)) GRID_BAR();
    }
    if (MK_PH_ON(7) && IN(7)) {
        for (int i = X.vcu; i < 512 * MK_NREP(7) * MK_NREP(70); i += X.G) { const int ii = i & 255; const int bg = ii >> 5, qt = ((i & 256) == 0) ? (ii & 31) : 63 - (ii & 31); att::prompt_item(X, bg, qt, ws, args.in[24]); }
        for (int i = X.vcu; i < 256 * MK_NREP(7) * MK_NREP(71); i += X.G) att::sample_item(X, i & 255, ws, args);
        if (BOTH(7)) GRID_BAR();
    }
#if MK_CHECK
    if (IN(8)) { for (int i = X.vcu; i < 256; i += X.G) att::check_item(X, i, ws, args.in[24], (unsigned*)(ctl + 64));
        GRID_BAR();
        const unsigned nbad = __hip_atomic_load((unsigned*)(ctl + 64), __ATOMIC_RELAXED, __HIP_MEMORY_SCOPE_AGENT);
        if (nbad > MK_CHECK_MAXBAD) { for (int i = X.gw * 64 + X.lane; i < MS * DM; i += X.NGW * 64) out[O_Y + (size_t)MP * DM + i] = 1000.0f; } }
#endif
    if (MK_PH_ON(8) && IN(8)) for (int rep_ = 0; rep_ < MK_NREP(8); ++rep_) { if (rep_) GRID_BAR();
        pg8::Gemm g{(const bf16_t*)(ws + WS_ACAT), (const bf16_t*)(ws + WS_WM), MP, DM, DM}; pg8::StaticOrder S; S.init(MP, DM, X.G, (int)blockIdx.x);
        EpiMerge E{8, (const bf16_t*)(ws + WS_RATIO), (const bf16_t*)(ws + WS_GB), (bf16_t*)(ws + WS_MERGED)};
        thin_gemm(X, (const bf16_t*)(ws + WS_ACAT) + (size_t)MP * DM, (const bf16_t*)(ws + WS_WM), DM, 4, E);
        pg8::gemm_phase(X.lds, g, S, E);
        if (BOTH(8)) GRID_BAR();
    }
    if (MK_PH_ON(9) && IN(9)) for (int rep_ = 0; rep_ < MK_NREP(9); ++rep_) { if (rep_) GRID_BAR();
        pg8::Gemm g{(const bf16_t*)(ws + WS_MERGED), (const bf16_t*)(ws + WS_WO), MP, DM, DM}; pg8::StaticOrder S; S.init(MP, DM, X.G, (int)blockIdx.x);
        float* H1 = (float*)(ws + WS_H1);
        pg8::EpiRes<true> E{H1, H1 + (size_t)MP * DM, H1, H1 + (size_t)MP * DM, modv, 1, (bf16_t*)(ws + WS_A3), args.in[11] + 2 * DM, 2, (float*)(ws + WS_SSQ3), (float*)(ws + WS_SSQS3), 1.0f};
        thin_gemm(X, (const bf16_t*)(ws + WS_MERGED) + (size_t)MP * DM, (const bf16_t*)(ws + WS_WO), DM, 4, E);
        pg8::gemm_phase(X.lds, g, S, E);
        if (BOTH(9)) GRID_BAR();
    }
    if (MK_PH_ON(10) && IN(10)) for (int rep_ = 0; rep_ < MK_NREP(10); ++rep_) { if (rep_) GRID_BAR();
        pg8::Gemm g{(const bf16_t*)(ws + WS_A3), (const bf16_t*)(ws + WS_WGU2), MPAD, NGU, DM}; pg8::StaticOrder S; S.init(MPAD, NGU, X.G, (int)blockIdx.x);
        pg8::EpiGU E{(bf16_t*)(ws + WS_ACT), (const float*)(ws + WS_SSQ3), (const float*)(ws + WS_SW3), NGU, (const float*)(ws + WS_SSQS3)};
        pg8::gemm_phase(X.lds, g, S, E);
        if (BOTH(10)) GRID_BAR();
    }
    if (MK_PH_ON(11) && IN(11)) for (int rep_ = 0; rep_ < MK_NREP(11); ++rep_) { if (rep_) GRID_BAR();
        pg8::Gemm g{(const bf16_t*)(ws + WS_ACT), (const bf16_t*)(ws + WS_WD2), MP, DM, DFF}; pg8::StaticOrder S; S.init(MP, DM, X.G, (int)blockIdx.x);
        float* H1 = (float*)(ws + WS_H1);
        pg8::EpiRes<false> E{H1, H1 + (size_t)MP * DM, out + O_Y, out + O_Y + (size_t)MP * DM, modv, 2, nullptr, nullptr, 0, nullptr, nullptr, 0.5f};
        thin_gemm(X, (const bf16_t*)(ws + WS_ACT) + (size_t)MP * DFF, (const bf16_t*)(ws + WS_WD2), DFF, 4, E);
        pg8::gemm_phase(X.lds, g, S, E);
        if (BOTH(11)) GRID_BAR();
    }
    if (MK_PH_ON(12) && IN(12)) for (int rep_ = 0; rep_ < MK_NREP(12); ++rep_) { if (rep_) GRID_BAR();
        const f32x4* gf = (const f32x4*)args.in[25] + X.lane;
        for (int m = X.gw; m < MTOT; m += X.NGW) { f32x4* y4 = (f32x4*)(out + O_Y + (size_t)m * DM) + X.lane; f32x4 v[4]; float s = 0.f;
#pragma unroll
            for (int j = 0; j < 4; ++j) { v[j] = y4[64 * j]; s += (v[j][0] * v[j][0] + v[j][1] * v[j][1]) + (v[j][2] * v[j][2] + v[j][3] * v[j][3]); }
#pragma unroll
            for (int off = 1; off < 64; off <<= 1) s += __shfl_xor(s, off);
            const float rt = 1.0f / sqrtf(s * (1.0f / DM) + EPS);
#pragma unroll
            for (int j = 0; j < 4; ++j) y4[64 * j] = v[j] * rt * gf[64 * j]; }
    }
#if MK_PROBE
    if (IN(13)) { f32x4* o4 = (f32x4*)(out + O_KVC_P); const size_t n4 = (O_TOTAL - O_KVC_P) / 4;
        for (size_t i = (size_t)X.gw * 64 + X.lane; i < n4; i += (size_t)X.NGW * 64) o4[i] = o4[i] * 3.0f; }
#endif
#undef IN
#undef BOTH
}

extern "C" void kernel_launch(void* const* d_in, const int* in_sizes, int n_in, void* d_out, int out_size, void* d_ws, size_t ws_size, hipStream_t stream) {
    static int grid = 0;
    if (grid == 0) {
        if (n_in != 26 || out_size != (int)O_TOTAL || ws_size < WS_END) { fprintf(stderr, "kernel_launch: unexpected shapes n_in %d out %d ws %zu\n", n_in, out_size, ws_size); grid = -1; return; }
        int dev = 0, cus = 0;
        if (hipGetDevice(&dev) != hipSuccess || hipDeviceGetAttribute(&cus, hipDeviceAttributeMultiprocessorCount, dev) != hipSuccess) { grid = -1; return; }
        if (hipFuncSetAttribute((const void*)nsa_fwd, hipFuncAttributeMaxDynamicSharedMemorySize, LDS_BYTES) != hipSuccess) { fprintf(stderr, "kernel_launch: hipFuncSetAttribute failed\n"); grid = -1; return; }
        int per_cu = 0;
        if (hipOccupancyMaxActiveBlocksPerMultiprocessor(&per_cu, (const void*)nsa_fwd, NTHR, LDS_BYTES) != hipSuccess || per_cu < 1) fprintf(stderr, "kernel_launch: occupancy query says %d\n", per_cu);
        (void)hipGetLastError();
        grid = cus;
    }
    if (grid < 0) return;
    (void)hipMemsetAsync((char*)d_ws + WS_CTL, 0, CTL_ZERO_BYTES, stream);
    Args a{};
    for (int i = 0; i < 26; ++i) a.in[i] = (const float*)d_in[i];
    a.out = (float*)d_out; a.ws = (unsigned char*)d_ws;
    constexpr int NPH = MK_LAST_PHASE + 1 + (MK_PROBE ? 1 : 0);
#if MK_PER_PHASE
    for (int p = (MK_PROBE ? -1 : 0); p < NPH; ++p) { a.ph_lo = p; a.ph_hi = p + 1; a.li = 0; hipLaunchKernelGGL(nsa_fwd, dim3(grid), dim3(NTHR), LDS_BYTES, stream, a); }
#else
    a.ph_lo = 0; a.ph_hi = NPH; a.li = 0; hipLaunchKernelGGL(nsa_fwd, dim3(grid), dim3(NTHR), LDS_BYTES, stream, a);
#endif
}
```

```cpp
#include <hip/hip_runtime.h>
#include <hip/hip_bf16.h>
#include <cstdio>
#include <cstdint>
#include <cmath>

#ifndef MK_PER_PHASE
#define MK_PER_PHASE 0
#endif
#ifndef MK_PH_MASK
#define MK_PH_MASK 0xffffffffu
#endif
#define MK_PH_ON(k) (((MK_PH_MASK >> (k)) & 1u) && !(MK_CHECK && (k) >= 8))
#ifndef MK_CHECK
#define MK_CHECK 0
#endif
#ifndef MK_CHECK_TOL
#define MK_CHECK_TOL 0.02f
#endif
#ifndef MK_CHECK_MAXBAD
#define MK_CHECK_MAXBAD 2
#endif
#ifndef MK_PROBE
#define MK_PROBE 0
#endif
#ifndef MK_DUP
#define MK_DUP (-1)
#endif
#define MK_NREP(k) ((k) == MK_DUP ? 2 : 1)
#ifndef MK_LAST_PHASE
#define MK_LAST_PHASE 12
#endif

constexpr int DM = 1024, NBP = 4, TP = 4096, MP = NBP * TP, NBS = 32, TS = 4, MS = NBS * TS, MTOT = MP + MS, MPAD = 16640;
constexpr int HD = 64, NH = 8, HKV = 2, GRP = 4, DFF = 2816, NGU = 2 * DFF, INW = 4888, INWP = 5120, DCONV = 512;
constexpr int PAST = 8192, NPAGE = 64, PAGE = 128, NPHYS = 2560;
constexpr int NBIDX = NBP + NBS;
constexpr int NMOD = 9 * DM;
constexpr float EPS = 1e-6f;
constexpr float LOG2E = 1.4426950408889634f;
constexpr float QSCALE = 0.125f * LOG2E;

constexpr size_t O_Y = 0;
constexpr size_t O_KVC_P = (size_t)MTOT * DM;
constexpr size_t O_KVS_P = O_KVC_P + (size_t)MP * 256;
constexpr size_t O_KVW_P = O_KVS_P + (size_t)MP * 256;
constexpr size_t O_CONV_P = O_KVW_P + (size_t)NBP * 512 * 256;
constexpr size_t O_KVC_S = O_CONV_P + (size_t)NBP * 2 * 512;
constexpr size_t O_KVS_S = O_KVC_S + (size_t)MS * 256;
constexpr size_t O_KVW_S = O_KVS_S + (size_t)MS * 256;
constexpr size_t O_CONV_S = O_KVW_S + (size_t)NBS * 512 * 256;
constexpr size_t O_TOTAL = O_CONV_S + (size_t)NBS * 2 * 512;
static_assert(O_TOTAL == 30117888, "output size");

constexpr size_t MiB = 1u << 20;
constexpr size_t WS_CTL = 0, CTL_ZERO_BYTES = 1 * MiB;
constexpr size_t WS_MOD = 1 * MiB;
constexpr size_t WS_PETERM = 3 * MiB;
constexpr size_t WS_SW2 = 4 * MiB;
constexpr size_t WS_SW3 = 5 * MiB;
constexpr size_t WS_SSQ2 = 6 * MiB, WS_SSQ3 = 8 * MiB;
constexpr size_t WS_SSQS2 = 7 * MiB + 512 * 1024, WS_SSQS3 = 9 * MiB + 512 * 1024;
constexpr size_t WS_GATES = 10 * MiB;
constexpr size_t WS_WGU1 = 16 * MiB;
constexpr size_t WS_WD1 = 28 * MiB;
constexpr size_t WS_WIN = 34 * MiB;
constexpr size_t WS_WM = 46 * MiB;
constexpr size_t WS_WO = 48 * MiB;
constexpr size_t WS_WGU2 = 50 * MiB;
constexpr size_t WS_WD2 = 62 * MiB;
constexpr size_t WS_WC1 = 68 * MiB;
constexpr size_t WS_A1 = 72 * MiB;
constexpr size_t WS_A2 = 106 * MiB;
constexpr size_t WS_A3 = 140 * MiB;
constexpr size_t WS_ACT = 174 * MiB;
constexpr size_t WS_H1 = 266 * MiB;
constexpr size_t WS_Q = 332 * MiB;
constexpr size_t WS_KS = 350 * MiB, WS_VS = 354 * MiB, WS_KW = 358 * MiB, WS_VW = 362 * MiB;
constexpr size_t WS_ACP = 366 * MiB;
constexpr size_t WS_PCP = 376 * MiB;
constexpr size_t WS_KCP = 380 * MiB, WS_VCP = 381 * MiB;
constexpr size_t WS_KVCS = 382 * MiB;
constexpr size_t WS_PROD = 400 * MiB;
constexpr size_t WS_CB = 418 * MiB;
constexpr size_t WS_RATIO = 436 * MiB;
constexpr size_t WS_GB = 470 * MiB;
constexpr size_t WS_ACAT = 504 * MiB;
constexpr size_t WS_MERGED = 538 * MiB;
constexpr size_t WS_PCS = 572 * MiB;
constexpr size_t WS_ACS = 608 * MiB;
constexpr size_t WS_END = 740 * MiB;

constexpr int CW_TMO = 0, CW_CODE = 1, CW_BAR = 4096;

#define GAS __attribute__((address_space(1)))
#define LAS __attribute__((address_space(3)))
typedef unsigned short bf16_t;
typedef short bf16x8 __attribute__((ext_vector_type(8)));
typedef float f32x4 __attribute__((ext_vector_type(4)));
typedef float f32x2 __attribute__((ext_vector_type(2)));
typedef unsigned u32x4 __attribute__((ext_vector_type(4)));
typedef unsigned u32x2 __attribute__((ext_vector_type(2)));
typedef GAS unsigned gu32;

__device__ __forceinline__ unsigned f2bf(float f) { unsigned u = __builtin_bit_cast(unsigned, f); return (u + 0x7fffu + ((u >> 16) & 1u)) >> 16; }
__device__ __forceinline__ unsigned pk2(float lo, float hi) { return f2bf(lo) | (f2bf(hi) << 16); }
__device__ __forceinline__ float bf2f(unsigned short b) { return __builtin_bit_cast(float, (unsigned)b << 16); }
__device__ __forceinline__ float bflo(unsigned w) { return __builtin_bit_cast(float, w << 16); }
__device__ __forceinline__ float bfhi(unsigned w) { return __builtin_bit_cast(float, w & 0xffff0000u); }
__device__ __forceinline__ float fast_exp2(float x) { return __builtin_amdgcn_exp2f(x); }
__device__ __forceinline__ float fast_rcp(float x) { return __builtin_amdgcn_rcpf(x); }
__device__ __forceinline__ float sigmoidf_(float x) { return fast_rcp(1.0f + fast_exp2(-x * LOG2E)); }
__device__ __forceinline__ float siluf_(float x) { return x * sigmoidf_(x); }
__device__ __forceinline__ int bidx_of_row(int row) { int b = row < MP ? (row >> 12) : NBP + ((row - MP) >> 2); return b < NBIDX ? b : NBIDX - 1; }
__device__ __forceinline__ const float* modp(const float* modv, int bidx, int sub, int kind) { return modv + ((size_t)(bidx * 3 + sub) * 3 + kind) * DM; }

__device__ __forceinline__ unsigned k_img(int ntile, int bg, int t, int d) { return (unsigned)((bg * ntile + (t >> 6)) * 4096 + (d >> 3) * 512 + (t & 63) * 8 + (d & 7)); }
__device__ __forceinline__ unsigned v_img(int ntile, int bg, int t, int d) { return (unsigned)((bg * ntile + (t >> 6)) * 4096 + ((d >> 5) * 4 + ((t & 63) >> 4)) * 512 + (t & 15) * 32 + (d & 31)); }

namespace pg8 {
constexpr int BM = 256, BK = 64, HALF = 128, HTB = HALF * BK * 2, STAGE_BYTES = 8 * HTB, NXCD = 8, WGM = 8;
__host__ __device__ __forceinline__ int lds_byte(int r, int c) { const int st = (r >> 4) * 2 + (c >> 5), rr = r & 15, cc = c & 31, ob = rr * 64 + cc * 2; return st * 1024 + (ob ^ (((ob >> 9) & 1) << 5)); }
__host__ __device__ __forceinline__ void stage_rc(int b, int& R, int& C) { const int st = b / 1024, sb = b % 1024, swz = sb ^ (((sb >> 9) & 1) << 5); R = (st >> 1) * 16 + swz / 64; C = (st & 1) * 32 + (swz % 64) / 2; }
__host__ __device__ __forceinline__ int perm32(int rho) { const int n = rho >> 4, i = rho & 15; return 8 * (i >> 2) + 4 * n + (i & 3); }
struct Unit { int pm, pn; };
struct Gemm { const bf16_t* A; const bf16_t* Bt; int M, N, K; };
struct StaticOrder {
    int nM, nN, nwg, G, c;
    __host__ __device__ void init(int M, int N, int G_, int c_) { nM = M / BM; nN = N / BM; nwg = nM * nN; G = G_; c = c_; }
    __host__ __device__ bool next(int i, Unit& u) const {
        const long L = (long)i * G + c; if (L >= nwg) return false;
        int wgid = (int)L; { const int q = nwg / NXCD, r = nwg % NXCD, xcd = wgid % NXCD, off = wgid / NXCD; wgid = (xcd < r ? xcd * (q + 1) : r * (q + 1) + (xcd - r) * q) + off; }
        const int nig = WGM * nN, gid = wgid / nig, fm = gid * WGM, gsz = (nM - fm) < WGM ? (nM - fm) : WGM;
        u.pm = fm + ((wgid % nig) % gsz); u.pn = (wgid % nig) / gsz; return true;
    }
    __device__ __forceinline__ void a_ready(const Unit&) const {}
    __device__ __forceinline__ void done(const Unit&) const {}
};
template <class Epi, class Sched>
__device__ __forceinline__ void gemm_phase(LAS unsigned char* lds, const Gemm g, const Sched& S, const Epi& E) {
    const int tid = threadIdx.x, wid = __builtin_amdgcn_readfirstlane(tid >> 6), lane = tid & 63, wr = wid >> 2, wc = wid & 3, fr = lane & 15, fq = lane >> 4;
    const int K = g.K, nt = K / BK;
    unsigned voffA[2], voffB[2];
#pragma unroll
    for (int i = 0; i < 2; ++i) { int R, C; stage_rc(tid * 16 + i * 8192, R, C); const int Rb = Epi::PERM ? ((R & ~31) + perm32(R & 31)) : R;
        voffA[i] = (unsigned)(R * K + C) * 2u; voffB[i] = (unsigned)(Rb * K + C) * 2u; }
    const size_t kstep = (size_t)(BK * 2);
    const size_t hstep = (size_t)HALF * K * 2;
    const size_t tstep = 2 * hstep;
    const unsigned ldsw = (unsigned)wid * 1024u;
    const int aoff = lds_byte(wr * 64 + fr, fq * 8), boff = lds_byte(wc * 32 + fr, fq * 8);
#define PG8_SA(b, h) (((b) * 2 + (h)) * HTB)
#define PG8_SB(b, h) ((4 + (b) * 2 + (h)) * HTB)
#define PG8_STAGE(bufoff, gbase, voff) do { _Pragma("unroll") for (int _i = 0; _i < 2; ++_i) \
        __builtin_amdgcn_global_load_lds((const unsigned*)((const char*)(gbase) + (voff)[_i]), (LAS unsigned*)(lds + (bufoff) + ldsw + _i * 8192), 16, 0, 0); } while (0)
#define PG8_LDA(dst, b, h) do { _Pragma("unroll") for (int m = 0; m < 4; ++m) _Pragma("unroll") for (int k = 0; k < 2; ++k) dst[m][k] = *(const LAS bf16x8*)(lds + PG8_SA(b, h) + aoff + m * 2048 + k * 1024); } while (0)
#define PG8_LDB(dst, b, h) do { _Pragma("unroll") for (int n = 0; n < 2; ++n) _Pragma("unroll") for (int k = 0; k < 2; ++k) dst[n][k] = *(const LAS bf16x8*)(lds + PG8_SB(b, h) + boff + n * 2048 + k * 1024); } while (0)
#define PG8_MMA(ai, bj, At, Bt) do { __builtin_amdgcn_s_setprio(1); _Pragma("unroll") for (int m = 0; m < 4; ++m) _Pragma("unroll") for (int n = 0; n < 2; ++n) _Pragma("unroll") for (int k = 0; k < 2; ++k) \
        acc[ai][bj][m][n] = __builtin_amdgcn_mfma_f32_16x16x32_bf16(Bt[n][k], At[m][k], acc[ai][bj][m][n], 0, 0, 0); __builtin_amdgcn_s_setprio(0); } while (0)
#define PG8_WAIT_V(n) asm volatile("s_waitcnt vmcnt(" #n ")" ::: "memory")
#define PG8_WAIT_L(n) asm volatile("s_waitcnt lgkmcnt(" #n ")" ::: "memory")
#define PG8_BAR __builtin_amdgcn_s_barrier()
#define PG8_SCHED __builtin_amdgcn_sched_barrier(0)
    Unit cur, nxt; int ui = 0;
    if (!S.next(0, cur)) return;
    f32x4 acc[2][2][4][2];
#pragma unroll
    for (int a = 0; a < 2; ++a)
#pragma unroll
        for (int b = 0; b < 2; ++b)
#pragma unroll
            for (int m = 0; m < 4; ++m)
#pragma unroll
                for (int n = 0; n < 2; ++n) acc[a][b][m][n] = (f32x4){0.f, 0.f, 0.f, 0.f};
    bf16x8 At[4][2], B0[2][2], B1[2][2];
    const char* cA = (const char*)g.A + (size_t)cur.pm * tstep; const char* cB = (const char*)g.Bt + (size_t)cur.pn * tstep;
    S.a_ready(cur);
    PG8_STAGE(PG8_SB(0, 0), cB, voffB); PG8_STAGE(PG8_SB(0, 1), cB + hstep, voffB); PG8_STAGE(PG8_SA(0, 0), cA, voffA); PG8_STAGE(PG8_SA(0, 1), cA + hstep, voffA);
    if (wr == 1) PG8_BAR;
    PG8_WAIT_V(2); PG8_BAR;
    PG8_STAGE(PG8_SB(1, 0), cB + kstep, voffB); PG8_STAGE(PG8_SA(1, 0), cA + kstep, voffA); PG8_STAGE(PG8_SB(1, 1), cB + hstep + kstep, voffB);
    PG8_WAIT_V(6); PG8_BAR;
    for (;;) {
        const bool has_next = S.next(ui + 1, nxt);
        const char* nA = has_next ? (const char*)g.A + (size_t)nxt.pm * tstep : cA; const char* nB = has_next ? (const char*)g.Bt + (size_t)nxt.pn * tstep : cB;
        for (int t = 0; t < nt; t += 2) {
            const bool last = (t == nt - 2);
            const char* a1 = cA + (size_t)(t + 1) * kstep;
            const char* a2 = last ? nA : cA + (size_t)(t + 2) * kstep; const char* b2 = last ? nB : cB + (size_t)(t + 2) * kstep;
            const char* a3 = a2 + kstep; const char* b3 = b2 + kstep;
            if (last && has_next) S.a_ready(nxt);
            if constexpr (Epi::HAS_MID) { if (t == E.mid_t) E.mid(acc, cur, wr, wc, fr, fq); }
            PG8_LDB(B0, 0, 0); PG8_LDB(B1, 0, 1); PG8_SCHED; PG8_LDA(At, 0, 0); PG8_STAGE(PG8_SA(1, 1), a1 + hstep, voffA);
            PG8_WAIT_V(8); PG8_WAIT_L(0); PG8_BAR; PG8_MMA(0, 0, At, B0); PG8_MMA(0, 1, At, B1); PG8_BAR; PG8_SCHED;
            PG8_LDA(At, 0, 1); PG8_STAGE(PG8_SB(0, 0), b2, voffB); PG8_STAGE(PG8_SB(0, 1), b2 + hstep, voffB); PG8_STAGE(PG8_SA(0, 0), a2, voffA);
            PG8_WAIT_V(8); PG8_WAIT_L(0); PG8_BAR; PG8_MMA(1, 0, At, B0); PG8_MMA(1, 1, At, B1); PG8_BAR; PG8_SCHED;
            PG8_LDB(B0, 1, 0); PG8_LDB(B1, 1, 1); PG8_SCHED; PG8_LDA(At, 1, 0); PG8_STAGE(PG8_SA(0, 1), a2 + hstep, voffA);
            PG8_WAIT_V(8); PG8_WAIT_L(0); PG8_BAR; PG8_MMA(0, 0, At, B0); PG8_MMA(0, 1, At, B1); PG8_BAR; PG8_SCHED;
            PG8_LDA(At, 1, 1); PG8_STAGE(PG8_SB(1, 0), b3, voffB); PG8_STAGE(PG8_SB(1, 1), b3 + hstep, voffB); PG8_STAGE(PG8_SA(1, 0), a3, voffA);
            PG8_WAIT_V(8); PG8_WAIT_L(0); PG8_BAR; PG8_MMA(1, 0, At, B0); PG8_MMA(1, 1, At, B1); PG8_BAR; PG8_SCHED;
        }
        if (wr == 0) PG8_BAR;
        E(acc, cur, wr, wc, fr, fq); S.done(cur);
        if (!has_next) break;
#pragma unroll
        for (int a = 0; a < 2; ++a)
#pragma unroll
            for (int b = 0; b < 2; ++b)
#pragma unroll
                for (int m = 0; m < 4; ++m)
#pragma unroll
                    for (int n = 0; n < 2; ++n) acc[a][b][m][n] = (f32x4){0.f, 0.f, 0.f, 0.f};
        cur = nxt; cA = nA; cB = nB; ++ui;
        if (wr == 1) PG8_BAR;
    }
    PG8_WAIT_V(0);
    PG8_BAR;
#undef PG8_SA
#undef PG8_SB
#undef PG8_STAGE
#undef PG8_LDA
#undef PG8_LDB
#undef PG8_MMA
#undef PG8_WAIT_V
#undef PG8_WAIT_L
#undef PG8_BAR
#undef PG8_SCHED
}
__device__ __forceinline__ float row_rt(const float* ssq, const float* ssqs, int row) {
    float s;
    if (row < MP) { const f32x4* sp = (const f32x4*)(ssq + (size_t)row * 16); const f32x4 s0 = sp[0], s1 = sp[1], s2 = sp[2], s3 = sp[3];
        s = ((s0[0] + s0[1]) + (s0[2] + s0[3])) + ((s1[0] + s1[1]) + (s1[2] + s1[3])) + ((s2[0] + s2[1]) + (s2[2] + s2[3])) + ((s3[0] + s3[1]) + (s3[2] + s3[3])); }
    else { const f32x4* sp = (const f32x4*)(ssqs + (size_t)(row - MP) * 32); s = 0.f;
#pragma unroll
        for (int i = 0; i < 8; ++i) { const f32x4 v = sp[i]; s += (v[0] + v[1]) + (v[2] + v[3]); } }
    return 1.0f / sqrtf(s * (1.0f / DM) + EPS);
}
typedef f32x4 Acc[2][2][4][2];

struct EpiGU {
    static constexpr bool PERM = true, HAS_MID = false;
    bf16_t* ACT; const float* ssq; const float* shiftW; int ldsw; const float* ssqs;
    __device__ __forceinline__ void operator()(const Acc& acc, const Unit& u, int wr, int wc, int fr, int fq) const {
        const int cl = wc * 32 + 8 * fq;
#pragma unroll
        for (int ai = 0; ai < 2; ++ai)
#pragma unroll
            for (int m = 0; m < 4; ++m) {
                const int row = u.pm * BM + ai * HALF + wr * 64 + m * 16 + fr;
                float rt = 1.f; f32x4 sg[2], sv[2]; sg[0] = sg[1] = sv[0] = sv[1] = (f32x4){0.f, 0.f, 0.f, 0.f};
                if (ssq) {
                    rt = row_rt(ssq, ssqs, row);
                    const float* sw = shiftW + (size_t)bidx_of_row(row) * ldsw + u.pn * BM + cl;
                    sg[0] = *(const f32x4*)(sw); sg[1] = *(const f32x4*)(sw + 4); sv[0] = *(const f32x4*)(sw + HALF); sv[1] = *(const f32x4*)(sw + HALF + 4);
                }
                u32x4 w;
#pragma unroll
                for (int n = 0; n < 2; ++n) {
                    const f32x4 gv = acc[ai][0][m][n] * rt + sg[n], vv = acc[ai][1][m][n] * rt + sv[n];
                    const float a0 = siluf_(gv[0]) * vv[0], a1 = siluf_(gv[1]) * vv[1], a2 = siluf_(gv[2]) * vv[2], a3 = siluf_(gv[3]) * vv[3];
                    w[2 * n] = pk2(a0, a1); w[2 * n + 1] = pk2(a2, a3);
                }
                *(u32x4*)(ACT + (size_t)row * DFF + u.pn * HALF + cl) = w;
            }
    }
};
template <bool HAS_A> struct EpiRes {
    static constexpr bool PERM = false, HAS_MID = false;
    const float* res_p; const float* res_s;
    float* out_p; float* out_s;
    const float* modv; int gsub;
    bf16_t* Aout; const float* gnorm; int ssub;
    float* ssq;
    float* ssqs;
    float gfac;
    template <int NQ> __device__ __forceinline__ float rowq(int row, int pn, int cb, const f32x4 q00, const f32x4 q01, const f32x4 q10, const f32x4 q11) const {
        const bool live = row < MTOT;
        const int bi = bidx_of_row(row);
        const float* rp = row < MP ? res_p + (size_t)row * DM : res_s + (size_t)(live ? row - MP : 0) * DM;
        float* op = row < MP ? out_p + (size_t)row * DM : out_s + (size_t)(live ? row - MP : 0) * DM;
        const float* gp = modp(modv, bi, gsub, 2); const float* scp = modp(modv, bi, ssub, 1);
        const float gf = gfac; bf16_t* const ao = Aout; const float* const gnp = gnorm;
        float sq = 0.f;
#pragma unroll
        for (int bj = 0; bj < 2; ++bj)
#pragma unroll
            for (int n = 0; n < NQ; ++n) {
                const int c = pn * BM + bj * HALF + cb + n * 16;
                const f32x4 r4 = *(const f32x4*)(rp + c), g4 = *(const f32x4*)(gp + c);
                const f32x4 qv = bj == 0 ? (n == 0 ? q00 : q01) : (n == 0 ? q10 : q11);
                const f32x4 h = r4 + (g4 * gf) * qv;
                if (live) *(f32x4*)(op + c) = h;
                sq += (h[0] * h[0] + h[1] * h[1]) + (h[2] * h[2] + h[3] * h[3]);
                if constexpr (HAS_A) { const f32x4 gn = *(const f32x4*)(gnp + c), sc = *(const f32x4*)(scp + c); const f32x4 a = h * gn * (sc + 1.0f);
                    u32x2 w; w.x = pk2(a[0], a[1]); w.y = pk2(a[2], a[3]); if (live) *(u32x2*)(ao + (size_t)row * DM + c) = w; }
            }
        return sq;
    }
    __device__ __forceinline__ void operator()(const Acc& acc, const Unit& u, int wr, int wc, int fr, int fq) const {
        const int bi = bidx_of_row(u.pm * BM), cb = u.pn * BM + wc * 32 + 4 * fq;
        const float* gp = modp(modv, bi, gsub, 2) + cb; const float* scp = modp(modv, bi, ssub, 1) + cb;
        f32x4 gq[2][2], aq[2][2];
#pragma unroll
        for (int bj = 0; bj < 2; ++bj)
#pragma unroll
            for (int n = 0; n < 2; ++n) { gq[bj][n] = *(const f32x4*)(gp + bj * HALF + n * 16) * gfac;
                if constexpr (HAS_A) aq[bj][n] = *(const f32x4*)(gnorm + cb + bj * HALF + n * 16) * (*(const f32x4*)(scp + bj * HALF + n * 16) + 1.0f); }
#pragma unroll
        for (int ai = 0; ai < 2; ++ai)
#pragma unroll
            for (int mp = 0; mp < 2; ++mp) {
                f32x4 r4[2][2][2];
#pragma unroll
                for (int mm = 0; mm < 2; ++mm) { const int row = u.pm * BM + ai * HALF + wr * 64 + (2 * mp + mm) * 16 + fr; const float* rp = res_p + (size_t)row * DM + cb;
#pragma unroll
                    for (int bj = 0; bj < 2; ++bj)
#pragma unroll
                        for (int n = 0; n < 2; ++n) r4[mm][bj][n] = *(const f32x4*)(rp + bj * HALF + n * 16); }
#pragma unroll
                for (int mm = 0; mm < 2; ++mm) { const int m = 2 * mp + mm, row = u.pm * BM + ai * HALF + wr * 64 + m * 16 + fr; float* op = out_p + (size_t)row * DM + cb; float sq = 0.f;
#pragma unroll
                    for (int bj = 0; bj < 2; ++bj)
#pragma unroll
                        for (int n = 0; n < 2; ++n) { const f32x4 h = r4[mm][bj][n] + gq[bj][n] * acc[ai][bj][m][n];
                            *(f32x4*)(op + bj * HALF + n * 16) = h; sq += (h[0] * h[0] + h[1] * h[1]) + (h[2] * h[2] + h[3] * h[3]);
                            if constexpr (HAS_A) { const f32x4 a = h * aq[bj][n]; u32x2 w; w.x = pk2(a[0], a[1]); w.y = pk2(a[2], a[3]); *(u32x2*)(Aout + (size_t)row * DM + cb + bj * HALF + n * 16) = w; } }
                    if (ssq) { sq += __shfl_xor(sq, 16); sq += __shfl_xor(sq, 32); if (fq == 0) ssq[(size_t)row * 16 + u.pn * 4 + wc] = sq; } }
                asm volatile("" ::: "memory");
            }
    }
    __device__ __forceinline__ void thin(int row, int pn, int h, int t, int fq, const f32x4 (&q)[2][1]) const {
        float sq = rowq<1>(row, pn, h * 64 + t * 16 + 4 * fq, q[0][0], q[0][0], q[1][0], q[1][0]);
        if (ssqs) { sq += __shfl_xor(sq, 16); sq += __shfl_xor(sq, 32); if (fq == 0) ssqs[(size_t)(row - MP) * 32 + (pn * 2 + h) * 4 + t] = sq; }
    }
};
struct EpiStoreBf16 {
    static constexpr bool PERM = true, HAS_MID = false;
    bf16_t* O; int ldc;
    __device__ __forceinline__ void thin(int row, int pn, int h, int t, int fq, const f32x4 (&q)[2][1]) const {
#pragma unroll
        for (int bj = 0; bj < 2; ++bj) { const f32x4 v = q[bj][0]; u32x2 w; w.x = pk2(v[0], v[1]); w.y = pk2(v[2], v[3]); *(u32x2*)(O + (size_t)row * ldc + pn * BM + bj * HALF + h * 64 + t * 16 + 4 * fq) = w; }
    }
    __device__ __forceinline__ void operator()(const Acc& acc, const Unit& u, int wr, int wc, int fr, int fq) const {
#pragma unroll
        for (int ai = 0; ai < 2; ++ai)
#pragma unroll
            for (int m = 0; m < 4; ++m) { const int row = u.pm * BM + ai * HALF + wr * 64 + m * 16 + fr;
#pragma unroll
                for (int bj = 0; bj < 2; ++bj) { const f32x4 v0 = acc[ai][bj][m][0], v1 = acc[ai][bj][m][1]; u32x4 w; w.x = pk2(v0[0], v0[1]); w.y = pk2(v0[2], v0[3]); w.z = pk2(v1[0], v1[1]); w.w = pk2(v1[2], v1[3]);
                    *(u32x4*)(O + (size_t)row * ldc + u.pn * BM + bj * HALF + wc * 32 + 8 * fq) = w; } }
    }
};
}

#define XB_TMO      128
#define XB_XCNT(j)  (256  + 64 * (j))
#define XB_XSUB(j)  (1280 + 64 * (j))
#define XB_XGEN(j)  (2304 + 64 * (j))
#define XB_TOP      3328
#define XB_TOPGEN   3392
#define XCD_BAR_WORDS 3456
#define XB_SPIN_CAP (1u << 18)
__device__ __forceinline__ unsigned xb_ld(unsigned* p)              { return __hip_atomic_load(p, __ATOMIC_RELAXED, __HIP_MEMORY_SCOPE_AGENT); }
__device__ __forceinline__ unsigned xb_add(unsigned* p, unsigned v) { return __hip_atomic_fetch_add(p, v, __ATOMIC_RELAXED, __HIP_MEMORY_SCOPE_AGENT); }
__device__ __forceinline__ unsigned xb_xcc_id() { return (unsigned)__builtin_amdgcn_s_getreg((3 << 11) | 20) & 0xFu; }
#define XB_SPIN(cond, bar) do { unsigned _sp = 0; while (cond) { __builtin_amdgcn_s_sleep(1); \
    if ((++_sp & 255u) == 0u) { if (xb_ld(&(bar)[XB_TMO])) break; if (_sp > XB_SPIN_CAP) { atomicAdd(&(bar)[XB_TMO], 1u); break; } } } } while (0)
struct XcdBarrier { unsigned* bar; unsigned x; volatile LAS unsigned* st; };
__device__ __forceinline__ XcdBarrier xcd_barrier_post(unsigned* bar, volatile LAS unsigned* st) {
    XcdBarrier b; b.bar = bar; b.x = xb_xcc_id(); b.st = st;
    if (threadIdx.x == 0) (void)xb_add(&bar[XB_XCNT(b.x)], 1u);
    return b;
}
__device__ __forceinline__ void xcd_barrier_complete(unsigned* bar, unsigned x, unsigned& nloc, unsigned& nx) {
    const unsigned G = gridDim.x * gridDim.y * gridDim.z;
    unsigned sum, cnt, mine, sp = 0u;
    for (;;) {
        sum = 0u; cnt = 0u; mine = 0u;
#pragma unroll
        for (unsigned j = 0; j < 16; ++j) { const unsigned c = xb_ld(&bar[XB_XCNT(j)]); sum += c; cnt += (c > 0u) ? 1u : 0u; mine = (j == x) ? c : mine; }
        if (sum == G) break;
        __builtin_amdgcn_s_sleep(1);
        if ((++sp & 255u) == 0u) { if (xb_ld(&bar[XB_TMO])) break; if (sp > XB_SPIN_CAP) { atomicAdd(&bar[XB_TMO], 1u); break; } }
    }
    nloc = mine > 0u ? mine : 1u; nx = cnt > 0u ? cnt : 1u;
}
__device__ __forceinline__ void xcd_barrier(const XcdBarrier& b) {
    asm volatile("s_waitcnt vmcnt(0)" ::: "memory");
    __syncthreads();
    if (threadIdx.x == 0) {
        unsigned* bar = b.bar;
        __builtin_amdgcn_s_waitcnt(0);
        unsigned nloc = b.st[0], nx = b.st[1];
        if (nloc == 0u) { xcd_barrier_complete(bar, b.x, nloc, nx); b.st[0] = nloc; b.st[1] = nx; }
        const unsigned old = xb_add(&bar[XB_XSUB(b.x)], 1u);
        const unsigned gen = old / nloc;
        if (old + 1u == (gen + 1u) * nloc) {
            __builtin_amdgcn_fence(__ATOMIC_RELEASE, "agent");
            asm volatile("s_waitcnt vmcnt(0)" ::: "memory");
            const unsigned og = xb_add(&bar[XB_TOP], 1u);
            const unsigned tg = og / nx;
            if (og + 1u == (tg + 1u) * nx) xb_add(&bar[XB_TOPGEN], 1u);
            else XB_SPIN(xb_ld(&bar[XB_TOPGEN]) == tg, bar);
            __builtin_amdgcn_fence(__ATOMIC_ACQUIRE, "agent");
            xb_add(&bar[XB_XGEN(b.x)], 1u);
            asm volatile("s_waitcnt vmcnt(0)" ::: "memory");
        } else {
            XB_SPIN(xb_ld(&bar[XB_XGEN(b.x)]) == gen, bar);
            __builtin_amdgcn_fence(__ATOMIC_ACQUIRE, "agent");
            asm volatile("s_waitcnt vmcnt(0)" ::: "memory");
        }
    }
    __syncthreads();
}

constexpr int NWAVES = 8, NTHR = 512;
constexpr int RING_BYTES = 131072, LDSCTL_OFF = RING_BYTES, MISC_OFF = LDSCTL_OFF + 320, LDS_BYTES = 147456;
#define LDS_WAIT() asm volatile("s_waitcnt lgkmcnt(0)" ::: "memory")

struct Args {
    const float* in[26]; float* out; unsigned char* ws; int ph_lo, ph_hi, li, pad;
};
struct Ctx {
    LAS unsigned char* lds; int tid, lane, wave, vcu, G, gw, NGW;
};

__device__ __forceinline__ void ada_item(const Ctx& X, int it, const float* cp, const float* cs, const float* w_ada, const float* b_ada, float* modv) {
    const int j0 = it * 64, w = X.wave, lane = X.lane, kr = lane >> 4, c4 = lane & 15;
    LAS float* sl = (LAS float*)X.lds + w * (18 * 128);
    LAS float* part = (LAS float*)(X.lds + 73728);
    for (int rh = 0; rh < 2; ++rh) {
        for (int idx = lane; idx < 18 * 128; idx += 64) { const int r = rh * 18 + idx / 128, kk = idx % 128, k = w * 128 + kk;
            const float cv = r < NBP ? cp[r * DM + k] : cs[(r - NBP) * DM + k]; sl[idx] = cv / (1.0f + __expf(-cv)); }
        LDS_WAIT(); __syncthreads();
        f32x4 acc[18];
#pragma unroll
        for (int r = 0; r < 18; ++r) acc[r] = (f32x4){0.f, 0.f, 0.f, 0.f};
        const float* wp = w_ada + (size_t)(w * 128 + kr) * NMOD + j0 + 4 * c4;
#pragma unroll 8
        for (int i = 0; i < 32; ++i) { const f32x4 wv = *(const f32x4*)(wp + (size_t)(4 * i) * NMOD);
#pragma unroll
            for (int r = 0; r < 18; ++r) acc[r] += wv * sl[r * 128 + 4 * i + kr]; }
#pragma unroll
        for (int r = 0; r < 18; ++r) {
#pragma unroll
            for (int e = 0; e < 4; ++e) { float v = acc[r][e]; v += __shfl_xor(v, 16); v += __shfl_xor(v, 32); acc[r][e] = v; }
            if (kr == 0) *(LAS f32x4*)(part + (w * 18 + r) * 64 + 4 * c4) = acc[r]; }
        LDS_WAIT(); __syncthreads();
        for (int o = X.tid; o < 18 * 64; o += NTHR) { const int r = o / 64, j = o % 64; float sum = b_ada[j0 + j];
#pragma unroll
            for (int ww = 0; ww < 8; ++ww) sum += part[(ww * 18 + r) * 64 + j];
            modv[(size_t)(rh * 18 + r) * NMOD + j0 + j] = sum; }
        __syncthreads();
    }
}
struct TJ { int src, srcoff_stride, N, K, col0, col_stride, ncols, dst, dpitch, drow0, drow_stride, dcol0, rep; };
__constant__ TJ kJobs[] = {
    {12, 0, NGU, DM, 0,    128, 128, 0, DM, 0,   256, 0, 22},
    {12, 0, NGU, DM, DFF,  128, 128, 0, DM, 128, 256, 0, 22},
    {13, 0, DM, DFF, 0, 0, DM, 1, DFF, 0, 0, 0, 1},
    {16, 0, INW, DM, 0,    0, 1280, 2, DM, 0, 0, 0, 1},
    {16, 0, INW, DM, 1304, 128, 128, 2, DM, 1280, 256, 0, 4},
    {16, 0, INW, DM, 2328, 128, 128, 2, DM, 1408, 256, 0, 4},
    {16, 0, INW, DM, 1816, 0, 512, 2, DM, 2304, 0, 0, 1},
    {16, 0, INW, DM, 2840, 128, 128, 2, DM, 2816, 256, 0, 8},
    {16, 0, INW, DM, 3864, 128, 128, 2, DM, 2944, 256, 0, 8},
    {16, 0, INW, DM, 1280, 0, 24, 2, DM, 4864, 0, 0, 1},
    {21, 0, DM, 512, 0, 0, DM, 3, DM, 0, 0, 0, 1},
    {22, 0, DM, 512, 0, 0, DM, 3, DM, 0, 0, 512, 1},
    {23, 0, DM, DM, 0, 0, DM, 4, DM, 0, 0, 0, 1},
    {14, 0, NGU, DM, 0,    128, 128, 5, DM, 0,   256, 0, 22},
    {14, 0, NGU, DM, DFF,  128, 128, 5, DM, 128, 256, 0, 22},
    {15, 0, DM, DFF, 0, 0, DM, 6, DFF, 0, 0, 0, 1},
    {17, 1024 * 128, 128, DM, 0, 0, 128, 7, DM, 0, 128, 0, 4},
};
constexpr int NJOBS = sizeof(kJobs) / sizeof(TJ);
__device__ __forceinline__ int tj_items(const TJ& j) { return j.rep * (j.K / 64) * ((j.ncols + 63) / 64); }
__device__ __forceinline__ void transpose_item(const float* W, int N, int ncols, bf16_t* WT, int dpitch, LAS float* scr, int kb, int nb, int lane) {
    const int k0 = 64 * kb, n0 = 64 * nb, kr = lane >> 4, c4 = lane & 15; const bool okc = (n0 + 4 * c4) < ncols;
    f32x4 v[16];
#pragma unroll
    for (int i = 0; i < 16; ++i) v[i] = okc ? *(const f32x4*)(W + (size_t)(k0 + 4 * i + kr) * N + n0 + 4 * c4) : (f32x4){0.f, 0.f, 0.f, 0.f};
#pragma unroll
    for (int i = 0; i < 16; ++i) { const int k = 4 * i + kr; *(LAS f32x4*)(scr + k * 64 + ((4 * c4 + 4 * (k >> 3)) & 63)) = v[i]; }
    LDS_WAIT(); asm volatile("" ::: "memory");
    const int c = lane & 7, nl = lane >> 3;
#pragma unroll
    for (int j = 0; j < 8; ++j) { const int n = nl + 8 * j; const LAS float* sp = scr + (8 * c) * 64 + ((n + 4 * c) & 63);
        u32x4 o; o.x = pk2(sp[0 * 64], sp[1 * 64]); o.y = pk2(sp[2 * 64], sp[3 * 64]); o.z = pk2(sp[4 * 64], sp[5 * 64]); o.w = pk2(sp[6 * 64], sp[7 * 64]);
        if (n0 + n < ncols) *(u32x4*)(WT + (size_t)(n0 + n) * dpitch + k0 + 8 * c) = o; }
    LDS_WAIT(); asm volatile("" ::: "memory");
}
__device__ __forceinline__ bf16_t* wdst(unsigned char* ws, int id) {
    const size_t off = id == 0 ? WS_WGU1 : id == 1 ? WS_WD1 : id == 2 ? WS_WIN : id == 3 ? WS_WM : id == 4 ? WS_WO : id == 5 ? WS_WGU2 : id == 6 ? WS_WD2 : WS_WC1;
    return (bf16_t*)(ws + off);
}

struct EpiIn {
    static constexpr bool PERM = false, HAS_MID = false;
    const float* ssq; const float* ssqs; const float* shiftW; float* out; unsigned char* ws;
    template <int CASE, int NQ> __device__ __forceinline__ void rowq(int row, int pn, int cb, const f32x4 (&q)[2][NQ]) const {
        using namespace pg8;
        const bool live = row < MTOT, isp = row < MP;
        const float rt = row_rt(ssq, ssqs, row);
        const float* sw = shiftW + (size_t)bidx_of_row(row) * INWP + pn * BM + cb;
        const int b = isp ? (row >> 12) : ((row - MP) >> 2), t = isp ? (row & (TP - 1)) : ((row - MP) & 3);
#define PV(bj, n) (q[bj][n] * rt + *(const f32x4*)(sw + (bj) * HALF + (n) * 16))
        if constexpr (CASE == 0) {
            bf16_t* Q = (bf16_t*)(ws + WS_Q) + (size_t)row * 512 + pn * BM + cb;
#pragma unroll
            for (int bj = 0; bj < 2; ++bj)
#pragma unroll
                for (int n = 0; n < NQ; ++n) { const f32x4 v = PV(bj, n) * QSCALE; u32x2 w; w.x = pk2(v[0], v[1]); w.y = pk2(v[2], v[3]); *(u32x2*)(Q + bj * HALF + n * 16) = w; }
        } else if constexpr (CASE >= 1 && CASE <= 3) {
            const size_t obase = CASE == 1 ? (isp ? O_KVC_P + (size_t)row * 256 : O_KVC_S + (size_t)(row - MP) * 256)
                               : CASE == 2 ? (isp ? O_KVS_P + (size_t)row * 256 : O_KVS_S + (size_t)(row - MP) * 256)
                               : (isp ? O_KVW_P + ((size_t)b * 512 + (t - (TP - 512))) * 256 : O_KVW_S + ((size_t)b * 512 + 508 + t) * 256);
            const bool wout = live && (CASE != 3 || !isp || t >= TP - 512);
#pragma unroll
            for (int bj = 0; bj < 2; ++bj)
#pragma unroll
                for (int n = 0; n < NQ; ++n) { const int j = bj * HALF + cb + n * 16; const f32x4 v = PV(bj, n);
                    if (wout) *(f32x4*)(out + obase + j) = v;
                    if (isp) { const int gg = (j >> 6) & 1, d = j & 63; u32x2 w; w.x = pk2(v[0], v[1]); w.y = pk2(v[2], v[3]);
                        if constexpr (CASE == 1) *(u32x2*)((bf16_t*)(ws + WS_ACP) + ((size_t)(bj * 8 + b * 2 + gg) * 256 + (t >> 4)) * 1024 + (t & 15) * 64 + d) = w;
                        else *(u32x2*)((bf16_t*)(ws + (CASE == 2 ? (bj ? WS_VS : WS_KS) : (bj ? WS_VW : WS_KW))) + (bj ? v_img(TP / 64, b * 2 + gg, t, d) : k_img(TP / 64, b * 2 + gg, t, d))) = w; } }
        } else if constexpr (CASE == 4) {
            const bool wout = live && (isp ? t >= TP - 2 : t >= 2);
            const size_t obase = isp ? O_CONV_P + ((size_t)b * 2 + (t - (TP - 2))) * 512 : O_CONV_S + ((size_t)b * 2 + (t - 2)) * 512;
#pragma unroll
            for (int n = 0; n < NQ; ++n) { const int j = (pn - 5) * HALF + cb + n * 16; const f32x4 v = PV(0, n) * PV(1, n);
                u32x2 w; w.x = pk2(v[0], v[1]); w.y = pk2(v[2], v[3]); *(u32x2*)((bf16_t*)(ws + WS_PROD) + (size_t)row * 512 + j) = w;
                if (wout) *(f32x4*)(out + obase + j) = v; }
        } else if constexpr (CASE == 5) {
#pragma unroll
            for (int bj = 0; bj < 2; ++bj)
#pragma unroll
                for (int n = 0; n < NQ; ++n) { const int j = (pn - 9) * BM + bj * HALF + cb + n * 16; const f32x4 v = PV(bj, n);
                    u32x2 w; w.x = pk2(v[0], v[1]); w.y = pk2(v[2], v[3]); *(u32x2*)((bf16_t*)(ws + WS_CB) + (size_t)row * 512 + j) = w; }
        } else if constexpr (CASE == 6) {
#pragma unroll
            for (int n = 0; n < NQ; ++n) { const int j = (pn - 11) * HALF + cb + n * 16; const f32x4 a = PV(0, n), bb = PV(1, n);
                float ra[4], gb[4];
#pragma unroll
                for (int e = 0; e < 4; ++e) { const float sa = sigmoidf_(a[e]), sb = sigmoidf_(bb[e]); gb[e] = sb; ra[e] = sa / sb; }
                u32x2 w; w.x = pk2(ra[0], ra[1]); w.y = pk2(ra[2], ra[3]); *(u32x2*)((bf16_t*)(ws + WS_RATIO) + (size_t)row * DM + j) = w;
                u32x2 w2; w2.x = pk2(gb[0], gb[1]); w2.y = pk2(gb[2], gb[3]); *(u32x2*)((bf16_t*)(ws + WS_GB) + (size_t)row * DM + j) = w2; }
        } else {
#pragma unroll
            for (int n = 0; n < NQ; ++n) { const int j = cb + n * 16; if (j < 24) { const f32x4 v = PV(0, n);
#pragma unroll
                for (int e = 0; e < 4; ++e) if (j + e < 24) ((float*)(ws + WS_GATES))[(size_t)row * 24 + j + e] = sigmoidf_(v[e]); } }
        }
#undef PV
    }
    template <int CASE> __device__ __forceinline__ void body(const pg8::Acc& acc, const pg8::Unit& u, int wr, int wc, int fr, int fq) const {
        using namespace pg8;
#pragma unroll
        for (int ai = 0; ai < 2; ++ai)
#pragma unroll
            for (int m = 0; m < 4; ++m) {
                const int row = u.pm * BM + ai * HALF + wr * 64 + m * 16 + fr;
                const f32x4 q[2][2] = {{acc[ai][0][m][0], acc[ai][0][m][1]}, {acc[ai][1][m][0], acc[ai][1][m][1]}};
                rowq<CASE, 2>(row, u.pn, wc * 32 + 4 * fq, q);
                asm volatile("" ::: "memory");
            }
    }
    __device__ __forceinline__ static int case_of(int pn) { return pn < 2 ? 0 : pn == 2 ? 1 : pn == 3 ? 2 : pn == 4 ? 3 : pn < 9 ? 4 : pn < 11 ? 5 : pn < 19 ? 6 : 7; }
    __device__ __forceinline__ void operator()(const pg8::Acc& acc, const pg8::Unit& u, int wr, int wc, int fr, int fq) const {
        const int cs = case_of(u.pn);
        if (cs == 0) body<0>(acc, u, wr, wc, fr, fq); else if (cs == 1) body<1>(acc, u, wr, wc, fr, fq); else if (cs == 2) body<2>(acc, u, wr, wc, fr, fq); else if (cs == 3) body<3>(acc, u, wr, wc, fr, fq);
        else if (cs == 4) body<4>(acc, u, wr, wc, fr, fq); else if (cs == 5) body<5>(acc, u, wr, wc, fr, fq); else if (cs == 6) body<6>(acc, u, wr, wc, fr, fq); else body<7>(acc, u, wr, wc, fr, fq);
    }
    __device__ __forceinline__ void thin(int row, int pn, int h, int t, int fq, const f32x4 (&q)[2][1]) const {
        const int cs = case_of(pn), cb = h * 64 + t * 16 + 4 * fq;
        if (cs == 0) rowq<0, 1>(row, pn, cb, q); else if (cs == 1) rowq<1, 1>(row, pn, cb, q); else if (cs == 2) rowq<2, 1>(row, pn, cb, q); else if (cs == 3) rowq<3, 1>(row, pn, cb, q);
        else if (cs == 4) rowq<4, 1>(row, pn, cb, q); else if (cs == 5) rowq<5, 1>(row, pn, cb, q); else if (cs == 6) rowq<6, 1>(row, pn, cb, q); else rowq<7, 1>(row, pn, cb, q);
    }
};

struct EpiMerge {
    static constexpr bool PERM = true, HAS_MID = true;
    int mid_t; const bf16_t* RAT; const bf16_t* GB; bf16_t* MERGED;
    __device__ __forceinline__ void mid(pg8::Acc& acc, const pg8::Unit& u, int wr, int wc, int fr, int fq) const {
        using namespace pg8;
        asm volatile("" : "+v"(fr), "+v"(fq));
#pragma unroll
        for (int ai = 0; ai < 2; ++ai)
#pragma unroll
            for (int m = 0; m < 4; ++m) { const int row = u.pm * BM + ai * HALF + wr * 64 + m * 16 + fr;
#pragma unroll
                for (int bj = 0; bj < 2; ++bj) { const u32x4 r = *(const u32x4*)(RAT + (size_t)row * DM + u.pn * BM + bj * HALF + wc * 32 + 8 * fq);
                    acc[ai][bj][m][0] *= (f32x4){bflo(r.x), bfhi(r.x), bflo(r.y), bfhi(r.y)}; acc[ai][bj][m][1] *= (f32x4){bflo(r.z), bfhi(r.z), bflo(r.w), bfhi(r.w)}; }
                asm volatile("" ::: "memory"); }
    }
    __device__ __forceinline__ void thin_mid(int row, int pn, int h, int t, int fq, f32x4 (&q)[2][1]) const {
#pragma unroll
        for (int bj = 0; bj < 2; ++bj) { const u32x2 r = *(const u32x2*)(RAT + (size_t)row * DM + pn * pg8::BM + bj * pg8::HALF + h * 64 + t * 16 + 4 * fq); q[bj][0] *= (f32x4){bflo(r.x), bfhi(r.x), bflo(r.y), bfhi(r.y)}; }
    }
    __device__ __forceinline__ void thin(int row, int pn, int h, int t, int fq, const f32x4 (&q)[2][1]) const {
#pragma unroll
        for (int bj = 0; bj < 2; ++bj) { const size_t off = (size_t)row * DM + pn * pg8::BM + bj * pg8::HALF + h * 64 + t * 16 + 4 * fq; const u32x2 r = *(const u32x2*)(GB + off);
            const f32x4 v = q[bj][0] * (f32x4){bflo(r.x), bfhi(r.x), bflo(r.y), bfhi(r.y)}; u32x2 w; w.x = pk2(v[0], v[1]); w.y = pk2(v[2], v[3]); *(u32x2*)(MERGED + off) = w; }
    }
    __device__ __forceinline__ void operator()(const pg8::Acc& acc, const pg8::Unit& u, int wr, int wc, int fr, int fq) const {
        using namespace pg8;
#pragma unroll
        for (int ai = 0; ai < 2; ++ai)
#pragma unroll
            for (int m = 0; m < 4; ++m) { const int row = u.pm * BM + ai * HALF + wr * 64 + m * 16 + fr;
#pragma unroll
                for (int bj = 0; bj < 2; ++bj) { const size_t off = (size_t)row * DM + u.pn * BM + bj * HALF + wc * 32 + 8 * fq; const u32x4 r = *(const u32x4*)(GB + off);
                    const f32x4 v0 = acc[ai][bj][m][0] * (f32x4){bflo(r.x), bfhi(r.x), bflo(r.y), bfhi(r.y)}, v1 = acc[ai][bj][m][1] * (f32x4){bflo(r.z), bfhi(r.z), bflo(r.w), bfhi(r.w)};
                    u32x4 w; w.x = pk2(v0[0], v0[1]); w.y = pk2(v0[2], v0[3]); w.z = pk2(v1[0], v1[1]); w.w = pk2(v1[2], v1[3]); *(u32x4*)(MERGED + off) = w; }
                asm volatile("" ::: "memory"); }
    }
};

__device__ __forceinline__ float gelu_tanh(float x) { const float u = 0.7978845608028654f * (x + 0.044715f * x * x * x); const float e = fast_exp2(2.0f * LOG2E * u); return 0.5f * x * (2.0f - 2.0f * fast_rcp(1.0f + e)); }
template <bool SAMPLE> __device__ __forceinline__ void cmp_tail_item(const Ctx& X, int item, unsigned char* ws, const float* w_cmp2, int& c_loaded) {
    constexpr int NR = SAMPLE ? 512 : 256, NCH = NR / 64, NBG = SAMPLE ? 64 : 8, NVALID = NR - 1;
    const int c = item / (NBG * NCH), bg = (item / NCH) % NBG, n0 = (item % NCH) * 64;
    LAS float* w2s = (LAS float*)X.lds; LAS float* hid = (LAS float*)(X.lds + 32768);
    const float* w2 = w_cmp2 + (size_t)c * 128 * 64; const float* pet = (const float*)(ws + WS_PETERM) + c * 128;
    const bf16_t* P = (const bf16_t*)(ws + (SAMPLE ? WS_PCS : WS_PCP)) + (size_t)c * (NBG * NR) * 256;
    if (c != c_loaded) { for (int i = X.tid; i < 128 * 64 / 4; i += NTHR) ((LAS f32x4*)w2s)[i] = ((const f32x4*)w2)[i]; c_loaded = c; }
#pragma unroll
    for (int k = 0; k < 2; ++k) { const int idx = X.tid + k * NTHR, r = idx >> 4, e8 = (idx & 15) * 8; const size_t base = (size_t)(bg * NR + n0 + r) * 256;
        const u32x4 a = *(const u32x4*)(P + base + e8), bb = *(const u32x4*)(P + base + 256 + 128 + e8); const f32x4 p0 = *(const f32x4*)(pet + e8), p1 = *(const f32x4*)(pet + e8 + 4);
#pragma unroll
        for (int j = 0; j < 4; ++j) { hid[r * 129 + e8 + 2 * j] = gelu_tanh(bflo(a[j]) + bflo(bb[j]) + (j < 2 ? p0[2 * j] : p1[2 * j - 4])); hid[r * 129 + e8 + 2 * j + 1] = gelu_tanh(bfhi(a[j]) + bfhi(bb[j]) + (j < 2 ? p0[2 * j + 1] : p1[2 * j - 3])); } }
    LDS_WAIT(); __syncthreads();
    const int r = X.tid >> 3, d0 = (X.tid & 7) * 8, n = n0 + r;
    float acc[8];
#pragma unroll
    for (int i = 0; i < 8; ++i) acc[i] = 0.f;
#pragma unroll 4
    for (int e = 0; e < 128; ++e) { const float h = hid[r * 129 + e]; const f32x4 wa = *(const LAS f32x4*)(w2s + e * 64 + d0), wb = *(const LAS f32x4*)(w2s + e * 64 + d0 + 4);
        acc[0] += h * wa[0]; acc[1] += h * wa[1]; acc[2] += h * wa[2]; acc[3] += h * wa[3]; acc[4] += h * wb[0]; acc[5] += h * wb[1]; acc[6] += h * wb[2]; acc[7] += h * wb[3]; }
    if constexpr (SAMPLE) {
        if (n < NVALID) { float* o = (float*)(ws + WS_KVCS) + (((size_t)bg * 512 + n) * 2 + c) * 64 + d0; *(f32x4*)o = (f32x4){acc[0], acc[1], acc[2], acc[3]}; *(f32x4*)(o + 4) = (f32x4){acc[4], acc[5], acc[6], acc[7]}; }
    } else {
        u32x4 w; if (n < NVALID) { w.x = pk2(acc[0], acc[1]); w.y = pk2(acc[2], acc[3]); w.z = pk2(acc[4], acc[5]); w.w = pk2(acc[6], acc[7]); } else w = (u32x4){0u, 0u, 0u, 0u};
        *(u32x4*)((bf16_t*)(ws + (c ? WS_VCP : WS_KCP)) + (c ? v_img(4, bg, n, d0) : k_img(4, bg, n, d0))) = w;
    }
    __syncthreads();
}

namespace att {
typedef float f32x16 __attribute__((ext_vector_type(16)));
typedef short s16x4 __attribute__((ext_vector_type(4)));
typedef float f32x2_t __attribute__((ext_vector_type(2))); typedef __bf16 bf16x2_t __attribute__((ext_vector_type(2)));
constexpr int L_K = 0, L_V = 24576, L_WSF = 49152, L_BIAS = 53248, L_GATE = 55296, L_SEL = 58368, L_ANY = 58880, L_PSLC = 59392, L_SC = 76288, L_OST = 92928, PL_LD = 66, SC_LD = 65;
static_assert(L_OST + 8 * 4096 <= RING_BYTES && L_SC + 64 * SC_LD * 4 <= L_OST && L_PSLC + 64 * PL_LD * 4 <= L_SC, "attention LDS map");
__constant__ unsigned char kBucket[128] = {0, 1, 2, 3, 4, 5, 6, 7, 8, 9, 10, 11, 12, 13, 14, 15, 16, 16, 16, 17, 17, 18, 18, 18, 19, 19, 19, 20, 20, 20, 20, 21, 21, 21, 21, 22, 22, 22, 22, 22, 23, 23, 23, 23, 23, 23, 24, 24, 24, 24, 24, 24, 25, 25, 25, 25, 25, 25, 25, 26, 26, 26, 26, 26, 26, 26, 26, 27, 27, 27, 27, 27, 27, 27, 27, 27, 27, 28, 28, 28, 28, 28, 28, 28, 28, 28, 28, 29, 29, 29, 29, 29, 29, 29, 29, 29, 29, 29, 29, 30, 30, 30, 30, 30, 30, 30, 30, 30, 30, 30, 30, 30, 30, 31, 31, 31, 31, 31, 31, 31, 31, 31, 31, 31, 31, 31, 31, 31};
__device__ __forceinline__ int crow(int r, int hi) { return (r & 3) + 8 * (r >> 2) + 4 * hi; }
__device__ __forceinline__ unsigned cvtpk_s(float lo, float hi) { f32x2_t v = {lo, hi}; bf16x2_t b = __builtin_convertvector(v, bf16x2_t); return __builtin_bit_cast(unsigned, b); }
#define ATT_SBAR() __builtin_amdgcn_sched_barrier(0)
__device__ __forceinline__ void qkt(f32x16& p0, f32x16& p1, const LAS unsigned char* Kslot, const bf16x8* qr, int r32, int hi, float cinit) {
    const LAS unsigned char* kb = Kslot + hi * 1024 + r32 * 16;
    f32x16 z;
#pragma unroll
    for (int r = 0; r < 16; ++r) z[r] = cinit;
    p0 = z; p1 = z;
#pragma unroll
    for (int d0 = 0; d0 < 4; ++d0) {
        const bf16x8 b0 = *(const LAS bf16x8*)(kb + d0 * 2048), b1 = *(const LAS bf16x8*)(kb + d0 * 2048 + 512);
        p0 = __builtin_amdgcn_mfma_f32_32x32x16_bf16(b0, qr[d0], p0, 0, 0, 0); p1 = __builtin_amdgcn_mfma_f32_32x32x16_bf16(b1, qr[d0], p1, 0, 0, 0); }
}
__device__ __forceinline__ float rowmax(const f32x16& p0, const f32x16& p1) {
    float a0 = fmaxf(p0[0], p1[0]), a1 = fmaxf(p0[1], p1[1]), a2 = fmaxf(p0[2], p1[2]), a3 = fmaxf(p0[3], p1[3]);
#pragma unroll
    for (int r = 4; r < 16; r += 4) { a0 = fmaxf(a0, fmaxf(p0[r], p1[r])); a1 = fmaxf(a1, fmaxf(p0[r + 1], p1[r + 1])); a2 = fmaxf(a2, fmaxf(p0[r + 2], p1[r + 2])); a3 = fmaxf(a3, fmaxf(p0[r + 3], p1[r + 3])); }
    const float a = fmaxf(fmaxf(a0, a1), fmaxf(a2, a3));
    auto rr = __builtin_amdgcn_permlane32_swap(__float_as_uint(a), __float_as_uint(a), false, false);
    return fmaxf(__uint_as_float(rr[0]), __uint_as_float(rr[1]));
}
__device__ __forceinline__ float halfsum(float a) { auto rr = __builtin_amdgcn_permlane32_swap(__float_as_uint(a), __float_as_uint(a), false, false); return __uint_as_float(rr[0]) + __uint_as_float(rr[1]); }
__device__ __forceinline__ void pv(f32x16* o, int vb, bf16x8 pa0, bf16x8 pa1, bf16x8 pa2, bf16x8 pa3) {
    s16x4 lo[2][4], hi[2][4];
#pragma unroll
    for (int d0 = 0; d0 < 2; ++d0)
#pragma unroll
        for (int ks = 0; ks < 4; ++ks) {
            asm volatile("ds_read_b64_tr_b16 %0,%1 offset:%c2" : "=&v"(lo[d0][ks]) : "v"(vb), "i"(d0 * 4096 + ks * 1024) : "memory");
            asm volatile("ds_read_b64_tr_b16 %0,%1 offset:%c2" : "=&v"(hi[d0][ks]) : "v"(vb), "i"(d0 * 4096 + ks * 1024 + 512) : "memory"); }
    asm volatile("s_waitcnt lgkmcnt(0)" ::: "memory"); ATT_SBAR();
#define ATT_PK(d, k) (bf16x8){lo[d][k][0], lo[d][k][1], lo[d][k][2], lo[d][k][3], hi[d][k][0], hi[d][k][1], hi[d][k][2], hi[d][k][3]}
    o[0] = __builtin_amdgcn_mfma_f32_32x32x16_bf16(pa0, ATT_PK(0, 0), o[0], 0, 0, 0); o[1] = __builtin_amdgcn_mfma_f32_32x32x16_bf16(pa0, ATT_PK(1, 0), o[1], 0, 0, 0);
    o[0] = __builtin_amdgcn_mfma_f32_32x32x16_bf16(pa1, ATT_PK(0, 1), o[0], 0, 0, 0); o[1] = __builtin_amdgcn_mfma_f32_32x32x16_bf16(pa1, ATT_PK(1, 1), o[1], 0, 0, 0);
    o[0] = __builtin_amdgcn_mfma_f32_32x32x16_bf16(pa2, ATT_PK(0, 2), o[0], 0, 0, 0); o[1] = __builtin_amdgcn_mfma_f32_32x32x16_bf16(pa2, ATT_PK(1, 2), o[1], 0, 0, 0);
    o[0] = __builtin_amdgcn_mfma_f32_32x32x16_bf16(pa3, ATT_PK(0, 3), o[0], 0, 0, 0); o[1] = __builtin_amdgcn_mfma_f32_32x32x16_bf16(pa3, ATT_PK(1, 3), o[1], 0, 0, 0);
#undef ATT_PK
}
__device__ __forceinline__ void tile_dma(const bf16_t* Kt, const bf16_t* Vt, LAS unsigned char* lds, int slot, int wid, int lane) {
    __builtin_amdgcn_global_load_lds((const unsigned*)((const char*)Kt + wid * 1024 + lane * 16), (LAS unsigned*)(lds + L_K + slot * 8192 + wid * 1024), 16, 0, 0);
    __builtin_amdgcn_global_load_lds((const unsigned*)((const char*)Vt + wid * 1024 + lane * 16), (LAS unsigned*)(lds + L_V + slot * 8192 + wid * 1024), 16, 0, 0);
}
struct SM { float m, l; f32x16 o[2]; };
__device__ __forceinline__ void sm_init(SM& s) { s.m = -1e30f; s.l = 0.f;
#pragma unroll
    for (int r = 0; r < 16; ++r) { s.o[0][r] = 0.f; s.o[1][r] = 0.f; } }
template <bool WITH_O> __device__ __forceinline__ void sm_update(SM& s, f32x16& p0, f32x16& p1, LAS float* wsf, int r32, int hi, bool lm) {
    float rm = rowmax(p0, p1); rm = lm ? rm : -INFINITY;
    if (__any(rm > s.m + 8.0f)) {
        const float mnew = fmaxf(s.m, rm), alpha = fast_exp2(s.m - mnew); s.l *= alpha;
        if constexpr (WITH_O) { if (hi == 0) wsf[r32] = alpha; LDS_WAIT();
#pragma unroll
            for (int r = 0; r < 16; ++r) { const float f = wsf[crow(r, hi)]; s.o[0][r] *= f; s.o[1][r] *= f; }
            LDS_WAIT(); }
        s.m = mnew;
    }
    const float meff = lm ? s.m : INFINITY;
    float sum = 0.f;
#pragma unroll
    for (int r = 0; r < 16; ++r) { p0[r] = fast_exp2(p0[r] - meff); p1[r] = fast_exp2(p1[r] - meff); sum += p0[r] + p1[r]; }
    s.l += sum;
}
__device__ __forceinline__ void sm_update_rel(SM& s, f32x16& p0, f32x16& p1, LAS float* wsf, int r32, int hi) {
    const float rm = rowmax(p0, p1);
    if (__any(rm > 8.0f)) {
        const float d = fmaxf(rm, 0.f), alpha = fast_exp2(-d); s.l *= alpha;
        if (hi == 0) wsf[r32] = alpha; LDS_WAIT();
#pragma unroll
        for (int r = 0; r < 16; ++r) { const float f = wsf[crow(r, hi)]; s.o[0][r] *= f; s.o[1][r] *= f; p0[r] -= d; p1[r] -= d; }
        LDS_WAIT(); s.m += d;
    }
    float s0 = 0.f, s1 = 0.f, s2 = 0.f, s3 = 0.f;
#pragma unroll
    for (int r = 0; r < 16; r += 4) { p0[r] = fast_exp2(p0[r]); p1[r] = fast_exp2(p1[r]); s0 += p0[r] + p1[r]; p0[r + 1] = fast_exp2(p0[r + 1]); p1[r + 1] = fast_exp2(p1[r + 1]); s1 += p0[r + 1] + p1[r + 1];
        p0[r + 2] = fast_exp2(p0[r + 2]); p1[r + 2] = fast_exp2(p1[r + 2]); s2 += p0[r + 2] + p1[r + 2]; p0[r + 3] = fast_exp2(p0[r + 3]); p1[r + 3] = fast_exp2(p1[r + 3]); s3 += p0[r + 3] + p1[r + 3]; }
    s.l += (s0 + s1) + (s2 + s3);
}
template <int MODE> __device__ __forceinline__ void mask_bias(f32x16& p0, f32x16& p1, int T, bool lsel, int qpos, int hi, const LAS float* bT) {
    const float NEG = -INFINITY;
    int base = MODE == 0 ? qpos - 1024 * T - 64 * hi - 31 : qpos - 64 * T - 4 * hi;
    asm volatile("" : "+v"(base));
#pragma unroll
    for (int r = 0; r < 16; ++r) { const int kk = (r & 3) + 8 * (r >> 2); int d0, d1; bool v0, v1;
        if (MODE == 0) { d0 = base - 16 * kk; d1 = d0 - 512; v0 = d0 >= 0; v1 = d1 >= 0; }
        else { d0 = base - kk; d1 = d0 - 32; if (MODE == 1) { v0 = lsel && d0 >= 0; v1 = lsel && d1 >= 0; } else { v0 = d0 >= 0 && d0 < 512; v1 = d1 >= 0 && d1 < 512; } }
        const float b0 = bT[min(max(d0, 0), 127)], b1 = bT[min(max(d1, 0), 127)];
        p0[r] = v0 ? p0[r] + b0 : NEG; p1[r] = v1 ? p1[r] + b1 : NEG; }
}
#define ATT_PACK(pw, P, B) pw = (u32x4){cvtpk_s(P[B], P[B + 1]), cvtpk_s(P[B + 2], P[B + 3]), cvtpk_s(P[B + 4], P[B + 5]), cvtpk_s(P[B + 6], P[B + 7])}
#define ATT_PV(S_, SLOT) do { u32x4 pw0, pw1, pw2, pw3; ATT_PACK(pw0, p0, 0); ATT_PACK(pw1, p0, 8); ATT_PACK(pw2, p1, 0); ATT_PACK(pw3, p1, 8); ATT_SBAR(); \
    pv((S_).o, vb0 + (SLOT) * 8192, __builtin_bit_cast(bf16x8, pw0), __builtin_bit_cast(bf16x8, pw1), __builtin_bit_cast(bf16x8, pw2), __builtin_bit_cast(bf16x8, pw3)); } while (0)
#define ATT_TILE_LOOP(NT, FIRST, NEXT, KB, VB, ...) do { const int nt_ = (NT); int t0_ = (FIRST), t1_ = t0_, t2_ = t0_; \
    tile_dma((KB) + (size_t)t0_ * 4096, (VB) + (size_t)t0_ * 4096, lds, 0, wid, lane); \
    if (nt_ > 1) { int tcur_ = t0_; (void)tcur_; t1_ = (NEXT); tile_dma((KB) + (size_t)t1_ * 4096, (VB) + (size_t)t1_ * 4096, lds, 1, wid, lane); } \
    for (int i_ = 0; i_ < nt_; ++i_) { \
        if (i_ + 1 < nt_) asm volatile("s_waitcnt vmcnt(2) lgkmcnt(0)" ::: "memory"); else asm volatile("s_waitcnt vmcnt(0) lgkmcnt(0)" ::: "memory"); \
        __builtin_amdgcn_s_barrier(); asm volatile("" ::: "memory"); \
        if (i_ + 2 < nt_) { int tcur_ = t1_; (void)tcur_; t2_ = (NEXT); tile_dma((KB) + (size_t)t2_ * 4096, (VB) + (size_t)t2_ * 4096, lds, (i_ + 2) % 3, wid, lane); } \
        { const int T = t0_; const int SLOT = i_ % 3; __VA_ARGS__ } \
        t0_ = t1_; t1_ = t2_; } \
    asm volatile("s_waitcnt lgkmcnt(0)" ::: "memory"); __builtin_amdgcn_s_barrier(); asm volatile("" ::: "memory"); } while (0)
#define ATT_FINISH(S_, BR) do { const float lt_ = halfsum((S_).l); const float inv_ = lt_ > 0.f ? 1.0f / lt_ : 0.f; \
    if (hi == 0) wsf[64 + r32] = inv_ * gt[qloc * 12 + (BR) * 4 + hh]; LDS_WAIT(); \
    _Pragma("unroll") for (int r = 0; r < 16; ++r) { const float f = wsf[64 + crow(r, hi)]; oacc[0][r] += (S_).o[0][r] * f; oacc[1][r] += (S_).o[1][r] * f; } LDS_WAIT(); asm volatile("" : "+v"(oacc[0]), "+v"(oacc[1])); } while (0)

__device__ __forceinline__ void prompt_item(const Ctx& X, int bg, int qt, unsigned char* ws, const float* rel_bias) {
    LAS unsigned char* lds = X.lds; int tid = X.tid; asm volatile("" : "+v"(tid));
    const int lane = tid & 63, wid = __builtin_amdgcn_readfirstlane(tid >> 6), r32 = lane & 31, hi = lane >> 5;
    const int b = bg >> 1, g = bg & 1, hh = wid >> 1, qh = wid & 1, q0 = qt * 64, qloc = qh * 32 + r32, qpos = q0 + qloc;
    LAS float* biasT = (LAS float*)(lds + L_BIAS); LAS float* gt = (LAS float*)(lds + L_GATE); LAS float* pslc = (LAS float*)(lds + L_PSLC); LAS float* sc = (LAS float*)(lds + L_SC);
    LAS float* wsf = (LAS float*)(lds + L_WSF) + wid * 128;
    const float* GATES = (const float*)(ws + WS_GATES);
    biasT[tid] = rel_bias[(int)kBucket[tid & 127] * 8 + g * 4 + (tid >> 7)] * LOG2E;
    for (int i = tid; i < 64 * 12; i += NTHR) { const int q = i / 12, e = i % 12; gt[i] = GATES[((size_t)b * TP + q0 + q) * 24 + (e >> 2) * 8 + g * 4 + (e & 3)]; }
    for (int i = tid; i < 64 * PL_LD; i += NTHR) pslc[i] = 0.f;
    if (tid < 2) ((LAS unsigned*)(lds + L_ANY))[tid] = 0u;
    bf16x8 qr[4];
    { const bf16_t* Qp = (const bf16_t*)(ws + WS_Q) + ((size_t)b * TP + qpos) * 512 + (g * 4 + hh) * 64 + hi * 8;
#pragma unroll
      for (int d0 = 0; d0 < 4; ++d0) qr[d0] = *(const bf16x8*)(Qp + d0 * 16); }
    LDS_WAIT(); __syncthreads();
    const LAS float* bT = biasT + hh * 128; const float b31 = bT[127];
    const int vb0 = (int)(unsigned)(uintptr_t)(lds + L_V) + ((lane >> 4) & 1) * 32 + (lane & 3) * 8 + (4 * hi + ((lane & 15) >> 2)) * 64;
    f32x16 oacc[2];
#pragma unroll
    for (int r = 0; r < 16; ++r) { oacc[0][r] = 0.f; oacc[1][r] = 0.f; }
    f32x16 p0, p1;
    { const bf16_t* KC = (const bf16_t*)(ws + WS_KCP) + (size_t)bg * 4 * 4096; const bf16_t* VC = (const bf16_t*)(ws + WS_VCP) + (size_t)bg * 4 * 4096;
      const int ncv = min(4 * qt + 3, 255), ntc = (ncv + 63) >> 6;
      SM s; sm_init(s);
      ATT_TILE_LOOP(ntc, 0, tcur_ + 1, KC, VC, {
          qkt(p0, p1, lds + L_K + SLOT * 8192, qr, r32, hi, 0.f); mask_bias<0>(p0, p1, T, true, qpos, hi, bT); sm_update<false>(s, p0, p1, wsf, r32, hi, true); });
      const float ltot = halfsum(s.l), invl = ltot > 0.f ? 1.0f / ltot : 0.f; s.l = 0.f;
      ATT_TILE_LOOP(ntc, 0, tcur_ + 1, KC, VC, {
          qkt(p0, p1, lds + L_K + SLOT * 8192, qr, r32, hi, 0.f); mask_bias<0>(p0, p1, T, true, qpos, hi, bT);
          float sum = 0.f;
          _Pragma("unroll") for (int r = 0; r < 16; ++r) { p0[r] = fast_exp2(p0[r] - s.m); p1[r] = fast_exp2(p1[r] - s.m); sum += p0[r] + p1[r]; }
          s.l += sum;
          float ga[8], gd[8], gp[8];
          _Pragma("unroll") for (int k4 = 0; k4 < 4; ++k4) { ga[k4] = 2.0f * (p0[4 * k4] + p0[4 * k4 + 1] + p0[4 * k4 + 2]) * invl; gd[k4] = p0[4 * k4 + 3] * invl;
              ga[4 + k4] = 2.0f * (p1[4 * k4] + p1[4 * k4 + 1] + p1[4 * k4 + 2]) * invl; gd[4 + k4] = p1[4 * k4 + 3] * invl; }
          _Pragma("unroll") for (int G = 0; G < 8; ++G) { auto sw = __builtin_amdgcn_permlane32_swap(__float_as_uint(gd[G]), __float_as_uint(gd[G]), false, false); gp[G] = __uint_as_float(hi ? sw[0] : sw[1]); }
          for (int rr = 0; rr < 4; ++rr) { if (hh == rr) { LAS float* pr = pslc + qloc * PL_LD + 16 * T + hi;
              _Pragma("unroll") for (int G = 0; G < 8; ++G) { const float prev = hi ? gp[G] : (G > 0 ? gp[G - 1] : 0.f); pr[2 * G] += ga[G] + gd[G] + prev; }
              if (hi) pr[15] += gd[7]; }
              LDS_WAIT(); __syncthreads(); }
          ATT_PV(s, SLOT); });
      ATT_FINISH(s, 0);
    }
    { const int q = tid >> 3, jg = tid & 7; float myv[8];
#pragma unroll
      for (int i = 0; i < 8; ++i) { const int j = jg * 8 + i; const float v = pslc[q * PL_LD + j];
          const bool valid = j <= qt, forced = (j == 0) || (j == qt) || (j == qt - 1);
          const float sv = valid ? v + (forced ? 1000.0f : 0.f) : -1e9f; myv[i] = sv; sc[q * SC_LD + j] = sv; }
      LDS_WAIT(); __syncthreads();
      int cnt[8];
#pragma unroll
      for (int i = 0; i < 8; ++i) cnt[i] = 0;
      for (int k = 0; k < 64; ++k) { const float v = sc[q * SC_LD + k];
#pragma unroll
          for (int i = 0; i < 8; ++i) cnt[i] += ((v > myv[i]) || (v == myv[i] && k < jg * 8 + i)) ? 1 : 0; }
      unsigned bits = 0u;
#pragma unroll
      for (int i = 0; i < 8; ++i) if (cnt[i] < 16 && jg * 8 + i <= qt) bits |= 1u << i;
      ((LAS unsigned char*)(lds + L_SEL))[q * 8 + jg] = (unsigned char)bits;
      atomicOr((unsigned*)((LAS unsigned*)(lds + L_ANY) + (jg >> 2)), bits << (8 * (jg & 3)));
      LDS_WAIT(); __syncthreads(); }
    { const unsigned lo_ = ((LAS unsigned*)(lds + L_SEL))[qloc * 2], hi_ = ((LAS unsigned*)(lds + L_SEL))[qloc * 2 + 1]; const unsigned long long selm = ((unsigned long long)hi_ << 32) | lo_;
      const unsigned long long anym = ((unsigned long long)((LAS unsigned*)(lds + L_ANY))[1] << 32) | ((LAS unsigned*)(lds + L_ANY))[0];
      unsigned long long rem = anym; const int nts = __builtin_popcountll(anym);
      const bf16_t* KS = (const bf16_t*)(ws + WS_KS) + (size_t)bg * TP * 64; const bf16_t* VS = (const bf16_t*)(ws + WS_VS) + (size_t)bg * TP * 64;
      SM s; sm_init(s);
      ATT_TILE_LOOP(nts, __builtin_ctzll(rem), (rem &= rem - 1, __builtin_ctzll(rem)), KS, VS, {
          const bool far = T + 3 <= qt; const bool lsel = ((selm >> T) & 1ull) != 0ull;
          if (far && i_ > 0) { qkt(p0, p1, lds + L_K + SLOT * 8192, qr, r32, hi, lsel ? b31 - s.m : -INFINITY); sm_update_rel(s, p0, p1, wsf, r32, hi); }
          else { qkt(p0, p1, lds + L_K + SLOT * 8192, qr, r32, hi, far ? b31 : 0.f);
              if (!far) mask_bias<1>(p0, p1, T, lsel, qpos, hi, bT);
              sm_update<true>(s, p0, p1, wsf, r32, hi, far ? lsel : true); }
          ATT_PV(s, SLOT); });
      ATT_FINISH(s, 1);
    }
    { const int jw0 = max(0, qt - 8), ntw = qt - jw0 + 1;
      const bf16_t* KW = (const bf16_t*)(ws + WS_KW) + (size_t)bg * TP * 64; const bf16_t* VW = (const bf16_t*)(ws + WS_VW) + (size_t)bg * TP * 64;
      SM s; sm_init(s);
      ATT_TILE_LOOP(ntw, jw0, tcur_ + 1, KW, VW, {
          const bool far = (T + 3 <= qt) && (T + 8 > qt);
          qkt(p0, p1, lds + L_K + SLOT * 8192, qr, r32, hi, far ? b31 : 0.f);
          if (!far) mask_bias<2>(p0, p1, T, true, qpos, hi, bT);
          sm_update<true>(s, p0, p1, wsf, r32, hi, true); ATT_PV(s, SLOT); });
      ATT_FINISH(s, 2);
    }
    { LAS bf16_t* stg = (LAS bf16_t*)(lds + L_OST + wid * 4096);
#pragma unroll
      for (int r = 0; r < 16; ++r) { stg[crow(r, hi) * 64 + r32] = (bf16_t)f2bf(oacc[0][r]); stg[crow(r, hi) * 64 + 32 + r32] = (bf16_t)f2bf(oacc[1][r]); }
      LDS_WAIT();
      bf16_t* O = (bf16_t*)(ws + WS_ACAT) + ((size_t)b * TP + q0 + qh * 32) * DM + (g * 4 + hh) * 64;
#pragma unroll
      for (int i = 0; i < 4; ++i) { const int row = i * 8 + (lane >> 3), ch = lane & 7; const u32x4 v = *(const LAS u32x4*)(stg + row * 64 + ch * 8); *(u32x4*)(O + (size_t)row * DM + ch * 8) = v; }
    }
    LDS_WAIT(); __syncthreads();
}

constexpr int S_SC = 0, S_SCLD = 1040, S_PSUM = 16640  , S_SCORE = 18752  , S_SELIDX = 19328  , S_Q = 19456  , S_OH = 20480  , S_STAT = 22528  , S_GATE = 22592  , S_BIAS = 22656  ;
struct SampleCtx { int b, g, s, qpos; const float* cache_sel; const float* state_win; const int* pt; const float* out; const float* kvcs; };
template <int BR> __device__ __forceinline__ void skey(const SampleCtx& C, const LAS int* selidx, int k, const float*& Kp, int& dist, bool& valid) {
    if (BR == 0) { Kp = C.kvcs + (((size_t)(C.b * 2 + C.g) * 512 + k) * 2) * 64; dist = C.qpos - (16 * k + 31); valid = true; }
    else if (BR == 1) { const int j = selidx[k >> 6], r = k & 63;
        if (j < 128) { const int page = C.pt[C.b * NPAGE + (j >> 1)]; Kp = C.cache_sel + ((size_t)page * PAGE + (j & 1) * 64 + r) * 256 + C.g * 64; dist = C.qpos - (64 * j + r); valid = true; }
        else { const int rr = r < TS ? r : 0; Kp = C.out + O_KVS_S + ((size_t)C.b * TS + rr) * 256 + C.g * 64; dist = C.qpos - (PAST + r); valid = r <= C.s; } }
    else { Kp = (k < 512 ? C.state_win + ((size_t)C.b * 512 + k) * 256 : C.out + O_KVW_S + ((size_t)C.b * 512 + 508 + (k - 512)) * 256) + C.g * 64; dist = C.qpos - (PAST - 512 + k); valid = dist >= 0 && dist < 512; }
}
constexpr int S_KP = 24704  , S_META = 33024  , S_RED = 37184  ;
template <int BR> __device__ __forceinline__ void sample_branch(const Ctx& X, int tid, const SampleCtx& C, int nkeys, float& ofinal) {
    LAS unsigned char* lds = X.lds; const int lane = tid & 63, wid = __builtin_amdgcn_readfirstlane(tid >> 6);
    LAS float* scs = (LAS float*)(lds + S_SC); LAS float* qs = (LAS float*)(lds + S_Q); LAS float* stat = (LAS float*)(lds + S_STAT);
    LAS float* gts = (LAS float*)(lds + S_GATE); LAS float* bT = (LAS float*)(lds + S_BIAS); const LAS int* selidx = (const LAS int*)(lds + S_SELIDX);
    typedef const float* cfp; LAS cfp* kp = (LAS cfp*)(lds + S_KP); LAS int* meta = (LAS int*)(lds + S_META); LAS float* red = (LAS float*)(lds + S_RED);
    constexpr int VOFF = BR == 0 ? 64 : 128;
    for (int k = tid; k < nkeys; k += NTHR) { const float* Kp; int dist; bool valid; skey<BR>(C, selidx, k, Kp, dist, valid); kp[k] = Kp; meta[k] = valid ? min(max(dist, 0), 127) : -1; }
    LDS_WAIT(); __syncthreads();
    const int grp = tid >> 4, li = tid & 15, nit = (nkeys + 31) >> 5;
    { f32x4 q4[4];
#pragma unroll
      for (int h = 0; h < 4; ++h) q4[h] = *(const LAS f32x4*)(qs + h * 64 + li * 4);
      for (int i0 = 0; i0 < nit; i0 += 16) { f32x4 kx[16];
#pragma unroll
          for (int u = 0; u < 16; ++u) { const int k = grp + 32 * (i0 + u); kx[u] = k < nkeys ? *(const f32x4*)(kp[k] + li * 4) : (f32x4){0.f, 0.f, 0.f, 0.f}; }
#pragma unroll
          for (int u = 0; u < 16; ++u) { const int k = grp + 32 * (i0 + u); float pt4[4];
#pragma unroll
              for (int h = 0; h < 4; ++h) { float d = (kx[u][0] * q4[h][0] + kx[u][1] * q4[h][1]) + (kx[u][2] * q4[h][2] + kx[u][3] * q4[h][3]);
                  d += __shfl_xor(d, 1); d += __shfl_xor(d, 2); d += __shfl_xor(d, 4); d += __shfl_xor(d, 8); pt4[h] = d; }
              if (li < 4 && k < nkeys) { const float d = li == 0 ? pt4[0] : li == 1 ? pt4[1] : li == 2 ? pt4[2] : pt4[3]; const int mt = meta[k];
                  scs[li * S_SCLD + k] = mt >= 0 ? d + bT[li * 128 + mt] : -INFINITY; } } } }
    LDS_WAIT(); __syncthreads();
    if (wid < 4) { LAS float* sr = scs + wid * S_SCLD; float m = -INFINITY;
        for (int k = lane; k < nkeys; k += 64) m = fmaxf(m, sr[k]);
#pragma unroll
        for (int o = 1; o < 64; o <<= 1) m = fmaxf(m, __shfl_xor(m, o));
        if (m == -INFINITY) m = 0.f;
        float l = 0.f;
        for (int k = lane; k < nkeys; k += 64) { const float e = fast_exp2(sr[k] - m); sr[k] = e; l += e; }
#pragma unroll
        for (int o = 1; o < 64; o <<= 1) l += __shfl_xor(l, o);
        if (lane == 0) { stat[wid] = m; stat[4 + wid] = l; } }
    LDS_WAIT(); __syncthreads();
    { f32x4 acc[4];
#pragma unroll
      for (int h = 0; h < 4; ++h) acc[h] = (f32x4){0.f, 0.f, 0.f, 0.f};
      for (int i0 = 0; i0 < nit; i0 += 16) { f32x4 vx[16];
#pragma unroll
          for (int u = 0; u < 16; ++u) { const int k = grp + 32 * (i0 + u); vx[u] = k < nkeys ? *(const f32x4*)(kp[k] + VOFF + li * 4) : (f32x4){0.f, 0.f, 0.f, 0.f}; }
#pragma unroll
          for (int u = 0; u < 16; ++u) { const int k = grp + 32 * (i0 + u); if (k < nkeys) {
#pragma unroll
              for (int h = 0; h < 4; ++h) acc[h] += vx[u] * scs[h * S_SCLD + k]; } } }
#pragma unroll
      for (int h = 0; h < 4; ++h) *(LAS f32x4*)(red + (grp * 4 + h) * 64 + li * 4) = acc[h]; }
    LDS_WAIT(); __syncthreads();
    if (tid < 256) { const int h = tid >> 6, d = tid & 63; float o = 0.f;
#pragma unroll 8
        for (int gq = 0; gq < 32; ++gq) o += red[(gq * 4 + h) * 64 + d];
        const float l = stat[4 + h]; ofinal += o * (l > 0.f ? 1.0f / l : 0.f) * gts[BR * 4 + h]; }
}
__device__ __forceinline__ void sample_item(const Ctx& X, int item, unsigned char* ws, const Args& A) {
    LAS unsigned char* lds = X.lds; int tid = X.tid; asm volatile("" : "+v"(tid));
    SampleCtx C; C.b = item >> 3; C.g = (item >> 2) & 1; C.s = item & 3; C.qpos = PAST + C.s; C.cache_sel = A.in[3]; C.state_win = A.in[4]; C.pt = (const int*)A.in[6]; C.out = A.out; C.kvcs = (const float*)(ws + WS_KVCS);
    const int mrow = MP + C.b * TS + C.s;
    LAS float* scs = (LAS float*)(lds + S_SC); LAS float* qs = (LAS float*)(lds + S_Q); LAS float* stat = (LAS float*)(lds + S_STAT); LAS float* gts = (LAS float*)(lds + S_GATE); LAS float* bT = (LAS float*)(lds + S_BIAS);
    LAS float* psum = (LAS float*)(lds + S_PSUM); LAS float* score = (LAS float*)(lds + S_SCORE); LAS int* selidx = (LAS int*)(lds + S_SELIDX);
    bT[tid] = A.in[24][(int)kBucket[tid & 127] * 8 + C.g * 4 + (tid >> 7)] * LOG2E;
    if (tid < 256) qs[tid] = bf2f(((const bf16_t*)(ws + WS_Q))[(size_t)mrow * 512 + C.g * 256 + tid]);
    if (tid < 12) gts[tid] = ((const float*)(ws + WS_GATES))[(size_t)mrow * 24 + (tid >> 2) * 8 + C.g * 4 + (tid & 3)];
    LDS_WAIT(); __syncthreads();
    float ofinal = 0.f;
    sample_branch<0>(X, tid, C, 511, ofinal);
    for (int n = tid; n < 520; n += NTHR) { float v = 0.f; if (n < 511) { v = scs[n] / stat[4] + scs[S_SCLD + n] / stat[5] + scs[2 * S_SCLD + n] / stat[6] + scs[3 * S_SCLD + n] / stat[7]; } psum[n] = v; }
    LDS_WAIT(); __syncthreads();
    if (tid < 129) { const int j = tid; const float v = 2.0f * (psum[4 * j] + psum[4 * j + 1] + psum[4 * j + 2]) + psum[4 * j + 3] + (j > 0 ? psum[4 * j - 1] : 0.f);
        score[j] = v + ((j == 0 || j == 128 || j == 127) ? 1000.0f : 0.f); }
    LDS_WAIT(); __syncthreads();
    if (tid < 129) { const float mv = score[tid]; int cnt = 0; for (int k = 0; k < 129; ++k) { const float v = score[k]; cnt += ((v > mv) || (v == mv && k < tid)) ? 1 : 0; } if (cnt < 16) selidx[cnt] = tid; }
    LDS_WAIT(); __syncthreads();
    sample_branch<1>(X, tid, C, 1024, ofinal);
    __syncthreads();
    sample_branch<2>(X, tid, C, 516, ofinal);
    if (tid < 256) ((bf16_t*)(ws + WS_ACAT))[(size_t)mrow * DM + C.g * 256 + tid] = (bf16_t)f2bf(ofinal);
    LDS_WAIT(); __syncthreads();
}

#if MK_CHECK
#define KC ((const bf16_t*)(ws + WS_KCP))
#define VC ((const bf16_t*)(ws + WS_VCP))
#define KS ((const bf16_t*)(ws + WS_KS))
#define VS ((const bf16_t*)(ws + WS_VS))
#define KW ((const bf16_t*)(ws + WS_KW))
#define VW ((const bf16_t*)(ws + WS_VW))
__device__ __forceinline__ float kraw_at(const bf16_t* base, int bg, int rows, int t, int d, bool isv) { return bf2f(base[isv ? v_img(rows / 64, bg, t, d) : k_img(rows / 64, bg, t, d)]); }
constexpr int C_SC = 0, C_SCLD = 1040, C_PS = 16640, C_PSLC = 17920, C_BLK = 18432, C_Q = 18944, C_STAT = 19968, C_OUT = 20480, C_RED = 21504, C_GT = 21760;
__device__ __forceinline__ void chk_branch(const Ctx& X, int br, int nkeys, const bf16_t* Kb, const bf16_t* Vb, int bg, int rows, int g, int t, const float* rel_bias, bool keep_p) {
    LAS unsigned char* lds = X.lds; const int tid = X.tid, lane = X.lane, wid = X.wave;
    LAS float* sc = (LAS float*)(lds + C_SC); LAS float* stat = (LAS float*)(lds + C_STAT); LAS float* out = (LAS float*)(lds + C_OUT); LAS float* gt = (LAS float*)(lds + C_GT); LAS int* kpos = (LAS int*)(lds + 32768);
    if (wid < 4) { LAS float* sr = sc + wid * C_SCLD; float m = -INFINITY;
        for (int k = lane; k < nkeys; k += 64) m = fmaxf(m, sr[k]);
#pragma unroll
        for (int o = 1; o < 64; o <<= 1) m = fmaxf(m, __shfl_xor(m, o));
        float l = 0.f;
        if (m > -INFINITY) { for (int k = lane; k < nkeys; k += 64) { const float e = exp2f(sr[k] - m); sr[k] = e; l += e; } }
        else { for (int k = lane; k < nkeys; k += 64) sr[k] = 0.f; }
#pragma unroll
        for (int o = 1; o < 64; o <<= 1) l += __shfl_xor(l, o);
        const float inv = l > 0.f ? 1.0f / l : 0.f;
        for (int k = lane; k < nkeys; k += 64) sr[k] *= inv; }
    LDS_WAIT(); __syncthreads();
    if (tid < 256) { const int hh = tid >> 6, d = tid & 63; float acc = 0.f; for (int k = 0; k < nkeys; ++k) { const float p = sc[hh * C_SCLD + k]; if (p != 0.f) acc += p * kraw_at(Vb, bg, rows, kpos[k], d, true); }
        out[tid] += gt[br * 4 + hh] * acc; }
    LDS_WAIT(); __syncthreads();
}
__device__ __forceinline__ void check_item(const Ctx& X, int item, unsigned char* ws, const float* rel_bias, unsigned* flag) {
    LAS unsigned char* lds = X.lds; const int tid = X.tid;
    const int edge[16] = {0, 1, 30, 31, 32, 46, 47, 63, 64, 65, 127, 128, 511, 512, 4095, 2048};
    const int bg = item & 7, t = item < 16 ? edge[item & 15] : ((item * 2081 + 7) & (TP - 1)), b = bg >> 1, g = bg & 1, qt = t >> 6; const size_t m = (size_t)b * TP + t;
    LAS float* sc = (LAS float*)(lds + C_SC); LAS float* ps = (LAS float*)(lds + C_PS); LAS float* pslc = (LAS float*)(lds + C_PSLC); LAS int* blk = (LAS int*)(lds + C_BLK); LAS float* qs = (LAS float*)(lds + C_Q);
    LAS float* out = (LAS float*)(lds + C_OUT); LAS float* red = (LAS float*)(lds + C_RED); LAS float* gt = (LAS float*)(lds + C_GT); LAS int* kpos = (LAS int*)(lds + 32768);
    __syncthreads();
    if (tid < 256) { qs[tid] = bf2f(((const bf16_t*)(ws + WS_Q))[m * 512 + g * 256 + tid]); out[tid] = 0.f; }
    if (tid < 12) gt[tid] = ((const float*)(ws + WS_GATES))[m * 24 + (tid >> 2) * 8 + g * 4 + (tid & 3)];
    for (int i = tid; i < 260; i += NTHR) ps[i] = 0.f;
    LDS_WAIT(); __syncthreads();
    const int nv = t >= 31 ? min((t - 31) / 16 + 1, 255) : 0;
    for (int idx = tid; idx < 4 * 256; idx += NTHR) { const int hh = idx >> 8, n = idx & 255; if (n < nv) { float s = 0.f; for (int d = 0; d < 64; ++d) s += qs[hh * 64 + d] * kraw_at(KC, bg, 256, n, d, false);
            const int dist = t - (16 * n + 31); s += rel_bias[(int)kBucket[min(dist, 127)] * 8 + g * 4 + hh] * LOG2E; sc[hh * C_SCLD + n] = s; kpos[n] = n; } }
    LDS_WAIT(); __syncthreads();
    if (nv > 0) {
        { LAS float* stat = (LAS float*)(lds + C_STAT); if (X.wave < 4) { LAS float* sr = sc + X.wave * C_SCLD; float mx = -INFINITY; for (int k = X.lane; k < nv; k += 64) mx = fmaxf(mx, sr[k]);
#pragma unroll
              for (int o = 1; o < 64; o <<= 1) mx = fmaxf(mx, __shfl_xor(mx, o));
              float l = 0.f; for (int k = X.lane; k < nv; k += 64) l += exp2f(sr[k] - mx);
#pragma unroll
              for (int o = 1; o < 64; o <<= 1) l += __shfl_xor(l, o);
              if (X.lane == 0) { stat[X.wave] = mx; stat[4 + X.wave] = l; } }
          LDS_WAIT(); __syncthreads();
          for (int n = tid; n < nv; n += NTHR) { float v = 0.f; for (int hh = 0; hh < 4; ++hh) v += exp2f(sc[hh * C_SCLD + n] - stat[hh]) / stat[4 + hh]; ps[n] = v; }
          LDS_WAIT(); __syncthreads(); }
        chk_branch(X, 0, nv, KC, VC, bg, 256, g, t, rel_bias, true);
    }
    if (tid < 64) { const int j = tid; const float v = 2.0f * (ps[4 * j] + ps[4 * j + 1] + ps[4 * j + 2]) + ps[4 * j + 3] + (j > 0 ? ps[4 * j - 1] : 0.f);
        pslc[j] = (j <= qt) ? v + ((j == 0 || j == qt || j == qt - 1) ? 1000.0f : 0.f) : -1e9f; }
    LDS_WAIT(); __syncthreads();
    if (tid < 64) { const float mv = pslc[tid]; int cnt = 0; for (int k = 0; k < 64; ++k) { const float v = pslc[k]; cnt += ((v > mv) || (v == mv && k < tid)) ? 1 : 0; } blk[tid] = (cnt < 16 && tid <= qt) ? 1 : 0; }
    LDS_WAIT(); __syncthreads();
    if (tid == 0) { int nk = 0; for (int j = 0; j < 64; ++j) if (blk[j]) for (int r = 0; r < 64; ++r) { const int p = 64 * j + r; if (p <= t) kpos[nk++] = p; } blk[64] = nk; }
    LDS_WAIT(); __syncthreads();
    { const int nk = blk[64];
      for (int idx = tid; idx < 4 * nk; idx += NTHR) { const int hh = idx / nk, k = idx % nk, p = kpos[k]; float s = 0.f; for (int d = 0; d < 64; ++d) s += qs[hh * 64 + d] * kraw_at(KS, bg, TP, p, d, false);
          s += rel_bias[(int)kBucket[min(t - p, 127)] * 8 + g * 4 + hh] * LOG2E; sc[hh * C_SCLD + k] = s; }
      LDS_WAIT(); __syncthreads();
      chk_branch(X, 1, nk, KS, VS, bg, TP, g, t, rel_bias, false); }
    { const int nk = min(t + 1, 512), p0 = t - nk + 1;
      for (int k = tid; k < nk; k += NTHR) kpos[k] = p0 + k;
      LDS_WAIT(); __syncthreads();
      for (int idx = tid; idx < 4 * nk; idx += NTHR) { const int hh = idx / nk, k = idx % nk, p = p0 + k; float s = 0.f; for (int d = 0; d < 64; ++d) s += qs[hh * 64 + d] * kraw_at(KW, bg, TP, p, d, false);
          s += rel_bias[(int)kBucket[min(t - p, 127)] * 8 + g * 4 + hh] * LOG2E; sc[hh * C_SCLD + k] = s; }
      LDS_WAIT(); __syncthreads();
      chk_branch(X, 2, nk, KW, VW, bg, TP, g, t, rel_bias, false); }
    float err = 0.f, mag = 0.f;
    if (tid < 256) { const float ref = out[tid], fast = bf2f(((const bf16_t*)(ws + WS_ACAT))[m * DM + g * 256 + tid]); err = fabsf(ref - fast); mag = fabsf(ref); if (!(fast == fast)) err = 1e30f; }
#pragma unroll
    for (int o = 1; o < 64; o <<= 1) { err = fmaxf(err, __shfl_xor(err, o)); mag = fmaxf(mag, __shfl_xor(mag, o)); }
    if (X.lane == 0) { red[X.wave] = err; red[8 + X.wave] = mag; }
    LDS_WAIT(); __syncthreads();
    if (tid == 0) { float e = 0.f, mg = 0.f; for (int w = 0; w < 8; ++w) { e = fmaxf(e, red[w]); mg = fmaxf(mg, red[8 + w]); } if (e > MK_CHECK_TOL * mg + 1e-4f) atomicAdd(flag, 1u); }
    __syncthreads();
}
#undef KC
#undef VC
#undef KS
#undef VS
#undef KW
#undef VW
#endif
}

template <class Epi> __device__ __forceinline__ void thin_gemm(const Ctx& X, const bf16_t* A, const bf16_t* Bt, int K, int npn, const Epi& E, int nr32 = 4, int row0 = MP, int ushift = 0) {
    LAS f32x4* red = (LAS f32x4*)X.lds;
    int tid = X.tid; asm volatile("" : "+v"(tid));
    const int lane = tid & 63, wid = __builtin_amdgcn_readfirstlane(tid >> 6), fr = lane & 15, fq = lane >> 4;
    const int kw = K >> 3, nks = kw >> 5, nunits = npn * 8 * nr32;
    int cu = (int)blockIdx.x - ushift; if (cu < 0) cu += X.G;
    for (int u = cu; u < nunits; u += X.G) {
        const int r32 = u % nr32, uc = u / nr32, c16 = uc & 7, pn = uc >> 3;
        const bf16_t* ap = A + (size_t)(32 * r32 + fr) * K + wid * kw + 8 * fq;
        const bf16_t* bp = Bt + (size_t)(pn * 256 + 16 * c16 + fr) * K + wid * kw + 8 * fq;
        const size_t a16 = (size_t)16 * K, b128 = (size_t)128 * K;
        f32x4 acc[2][2];
#pragma unroll
        for (int rt = 0; rt < 2; ++rt) { acc[rt][0] = (f32x4){0.f, 0.f, 0.f, 0.f}; acc[rt][1] = (f32x4){0.f, 0.f, 0.f, 0.f}; }
        for (int ks0 = 0; ks0 < nks; ks0 += 6) {
            bf16x8 af[6][2], bf[6][2];
#pragma unroll
            for (int i = 0; i < 6; ++i) if (ks0 + i < nks) { const int ko = 32 * (ks0 + i);
                af[i][0] = *(const bf16x8*)(ap + ko); af[i][1] = *(const bf16x8*)(ap + a16 + ko); bf[i][0] = *(const bf16x8*)(bp + ko); bf[i][1] = *(const bf16x8*)(bp + b128 + ko); }
#pragma unroll
            for (int i = 0; i < 6; ++i) if (ks0 + i < nks) {
#pragma unroll
                for (int rt = 0; rt < 2; ++rt) { acc[rt][0] = __builtin_amdgcn_mfma_f32_16x16x32_bf16(bf[i][0], af[i][rt], acc[rt][0], 0, 0, 0); acc[rt][1] = __builtin_amdgcn_mfma_f32_16x16x32_bf16(bf[i][1], af[i][rt], acc[rt][1], 0, 0, 0); } }
        }
#pragma unroll
        for (int rt = 0; rt < 2; ++rt) { red[((wid * 2 + rt) * 2 + 0) * 64 + lane] = acc[rt][0]; red[((wid * 2 + rt) * 2 + 1) * 64 + lane] = acc[rt][1]; }
        LDS_WAIT(); __syncthreads();
        if (wid < 2) { const int rt = wid; f32x4 q[2][1];
#pragma unroll
            for (int bj = 0; bj < 2; ++bj) { f32x4 v = red[((0 * 2 + rt) * 2 + bj) * 64 + lane];
#pragma unroll
                for (int w = 1; w < 4; ++w) v += red[((w * 2 + rt) * 2 + bj) * 64 + lane];
                q[bj][0] = v; }
            const int row = row0 + 32 * r32 + 16 * rt + fr, h = c16 >> 2, t = c16 & 3;
            if constexpr (Epi::HAS_MID) E.thin_mid(row, pn, h, t, fq, q);
#pragma unroll
            for (int bj = 0; bj < 2; ++bj) { f32x4 v = q[bj][0];
#pragma unroll
                for (int w = 4; w < 8; ++w) v += red[((w * 2 + rt) * 2 + bj) * 64 + lane];
                q[bj][0] = v; }
            E.thin(row, pn, h, t, fq, q); }
        __syncthreads();
    }
}

__global__ void __launch_bounds__(NTHR, 2) nsa_fwd(Args args) {
    extern __shared__ __attribute__((aligned(16))) unsigned char lds_raw[];
    Ctx X; X.lds = (LAS unsigned char*)lds_raw; X.tid = threadIdx.x; X.lane = X.tid & 63; X.wave = __builtin_amdgcn_readfirstlane(X.tid >> 6);
    X.G = gridDim.x; { const int bx = blockIdx.x; X.vcu = (X.G % 8 == 0) ? (bx % 8) * (X.G / 8) + bx / 8 : bx; }
    X.gw = X.vcu * NWAVES + X.wave; X.NGW = X.G * NWAVES;
    unsigned char* ws = args.ws; float* out = args.out;
    gu32* ctl = (gu32*)(ws + WS_CTL);
    volatile LAS unsigned* MISC = (volatile LAS unsigned*)(X.lds + MISC_OFF);
    for (int u = X.tid; u < (LDS_BYTES - LDSCTL_OFF) / 4; u += NTHR) ((LAS unsigned*)(X.lds + LDSCTL_OFF))[u] = 0u;
    __syncthreads();
    XcdBarrier bar; bar.bar = (unsigned*)(ctl + CW_BAR); bar.x = 0; bar.st = nullptr;
#if !MK_PER_PHASE
    bar = xcd_barrier_post((unsigned*)(ctl + CW_BAR), MISC + 8);
#define GRID_BAR() xcd_barrier(bar)
#else
#define GRID_BAR() do { } while (0)
#endif
    const int lo = args.ph_lo, hi = args.ph_hi;
#define IN(k) (lo <= (k) && (k) < hi)
#define BOTH(k) (IN(k) && IN((k) + 1))
    float* modv = (float*)(ws + WS_MOD);
    const float* x_p = args.in[0]; const float* x_s = args.in[1];

#if MK_PROBE
    if (IN(-1)) { f32x4* o4 = (f32x4*)(out + O_KVC_P); const size_t n4 = (O_TOTAL - O_KVC_P) / 4;
        for (size_t i = (size_t)X.gw * 64 + X.lane; i < n4; i += (size_t)X.NGW * 64) o4[i] = (f32x4){100.f, 100.f, 100.f, 100.f}; }
#endif
    if (MK_PH_ON(0) && IN(0)) for (int rep_ = 0; rep_ < MK_NREP(0); ++rep_) { if (rep_) GRID_BAR();
        for (int rp = 0; rp < MK_NREP(20); ++rp)
        for (int it = X.vcu; it < NMOD / 64; it += X.G) ada_item(X, it, args.in[7], args.in[8], args.in[9], args.in[10], modv);
        __syncthreads();
        {
            LAS float* scr = (LAS float*)(X.lds + X.wave * 16384);
            int total = 0;
            for (int j = 0; j < NJOBS; ++j) total += tj_items(kJobs[j]);
            for (int it = X.gw; it < total * MK_NREP(21); it += X.NGW) {
                int r = it % total, j = 0;
                for (; j < NJOBS - 1; ++j) { const int n = tj_items(kJobs[j]); if (r < n) break; r -= n; }
                const TJ J = kJobs[j];
                const int nblk = (J.ncols + 63) / 64, per = (J.K / 64) * nblk, rep = r / per, rr = r % per, kb = rr / nblk, nb = rr % nblk;
                const float* W = args.in[J.src] + (size_t)rep * J.srcoff_stride + J.col0 + rep * J.col_stride;
                bf16_t* WT = wdst(ws, J.dst) + (size_t)(J.drow0 + rep * J.drow_stride) * J.dpitch + J.dcol0;
                transpose_item(W, J.N, J.ncols, WT, J.dpitch, scr, kb, nb, X.lane);
            }
            { u32x4* z = (u32x4*)((bf16_t*)(ws + WS_WIN) + (size_t)INW * DM); const int nz = (INWP - INW) * DM * 2 / 16;
              for (int i = X.gw * 64 + X.lane; i < nz; i += X.NGW * 64) z[i] = (u32x4){0u, 0u, 0u, 0u}; }
        }
        for (int o = X.gw; o < 256; o += X.NGW) { const int c = o >> 7, e = o & 127; const float* pe = args.in[19] + c * 2048; const float* w1 = args.in[17] + (size_t)c * 2048 * 128 + e;
            float s = 0.f; for (int k = X.lane; k < 2048; k += 64) s += pe[k] * w1[(size_t)k * 128];
#pragma unroll
            for (int off = 1; off < 64; off <<= 1) s += __shfl_xor(s, off);
            if (X.lane == 0) ((float*)(ws + WS_PETERM))[o] = s; }
        { const f32x4* src = (const f32x4*)args.in[4]; f32x4* dst = (f32x4*)(out + O_KVW_S); const int per_b = 508 * 64;
          for (int i = X.gw * 64 + X.lane; i < NBS * per_b; i += X.NGW * 64) { const int b = i / per_b, r = i % per_b; dst[(size_t)b * 512 * 64 + r] = src[(size_t)b * 512 * 64 + 4 * 64 + r]; } }
        { const int* pt = (const int*)args.in[6]; const float* cache = args.in[2]; bf16_t* ACS = (bf16_t*)(ws + WS_ACS);
          for (int it0 = X.gw; it0 < NBS * 512 * MK_NREP(22); it0 += X.NGW) { const int it = it0 & (NBS * 512 - 1); const int b = it >> 9, n = it & 511; const int page = pt[b * NPAGE + (n >> 3)];
              const f32x4* src = (const f32x4*)(cache + ((size_t)page * PAGE + (n & 7) * 16) * 256) + X.lane;
              const int c = X.lane >> 5, g = (X.lane >> 4) & 1, d = (X.lane & 15) * 4;
              bf16_t* dst = ACS + ((size_t)c * 32768 + (size_t)(b * 2 + g) * 512 + n) * 1024 + d;
              f32x4 v[16];
#pragma unroll
              for (int l = 0; l < 16; ++l) v[l] = src[l * 64];
#pragma unroll
              for (int l = 0; l < 16; ++l) { u32x2 w; w.x = pk2(v[l][0], v[l][1]); w.y = pk2(v[l][2], v[l][3]); *(u32x2*)(dst + l * 64) = w; } } }
        if (BOTH(0)) GRID_BAR();
    }

    if (MK_PH_ON(1) && IN(1)) for (int rep_ = 0; rep_ < MK_NREP(1); ++rep_) { if (rep_) GRID_BAR();
        { const float* g1 = args.in[11]; bf16_t* A1 = (bf16_t*)(ws + WS_A1);
          for (int m = X.gw; m < MPAD; m += X.NGW) {
              unsigned long long* o8 = (unsigned long long*)(A1 + (size_t)m * DM) + X.lane;
              if (m >= MTOT) {
#pragma unroll
                  for (int j = 0; j < 4; ++j) o8[64 * j] = 0ull;
                  continue; }
              const float* xr = m < MP ? x_p + (size_t)m * DM : x_s + (size_t)(m - MP) * DM; const int bi = bidx_of_row(m);
              const f32x4* x4 = (const f32x4*)xr + X.lane; f32x4 v[4]; float s = 0.f;
#pragma unroll
              for (int j = 0; j < 4; ++j) { v[j] = x4[64 * j]; s += (v[j][0] * v[j][0] + v[j][1] * v[j][1]) + (v[j][2] * v[j][2] + v[j][3] * v[j][3]); }
#pragma unroll
              for (int off = 1; off < 64; off <<= 1) s += __shfl_xor(s, off);
              const float rt = 1.0f / sqrtf(s * (1.0f / DM) + EPS);
              const f32x4* gg = (const f32x4*)g1 + X.lane; const f32x4* sh = (const f32x4*)modp(modv, bi, 0, 0) + X.lane; const f32x4* sc = (const f32x4*)modp(modv, bi, 0, 1) + X.lane;
#pragma unroll
              for (int j = 0; j < 4; ++j) { const f32x4 a = v[j] * rt * gg[64 * j] * (sc[64 * j] + 1.0f) + sh[64 * j];
                  o8[64 * j] = (unsigned long long)pk2(a[0], a[1]) | ((unsigned long long)pk2(a[2], a[3]) << 32); }
          } }
        for (int second = 0; second < 2; ++second) {
            constexpr int SP = 1024 + 8;
            LAS bf16_t* shl = (LAS bf16_t*)X.lds;
            __syncthreads();
            for (int i = X.tid; i < 48 * 256; i += NTHR) { const int bi = i >> 8, k4 = (i & 255) * 4; const f32x4 a = *(const f32x4*)(modp(modv, bi < NBIDX ? bi : NBIDX - 1, second ? 2 : 1, 0) + k4);
                u32x2 w; w.x = pk2(a[0], a[1]); w.y = pk2(a[2], a[3]); *(LAS u32x2*)(shl + bi * SP + k4) = w; }
            LDS_WAIT(); __syncthreads();
            const int nrows = second ? NGU : INWP; const bf16_t* Wt = (const bf16_t*)(ws + (second ? WS_WGU2 : WS_WIN)); float* dst = (float*)(ws + (second ? WS_SW3 : WS_SW2));
            const int fr = X.lane & 15, fq = X.lane >> 4;
            for (int it = X.gw; it < nrows / 16; it += X.NGW) { const int n0 = it * 16; f32x4 acc[3];
#pragma unroll
                for (int bt = 0; bt < 3; ++bt) acc[bt] = (f32x4){0.f, 0.f, 0.f, 0.f};
                const bf16_t* wr = Wt + (size_t)(n0 + fr) * DM + 8 * fq;
#pragma unroll 8
                for (int ks = 0; ks < 32; ++ks) { const bf16x8 af = *(const bf16x8*)(wr + 32 * ks);
#pragma unroll
                    for (int bt = 0; bt < 3; ++bt) { const bf16x8 bfr = *(const LAS bf16x8*)(shl + (16 * bt + fr) * SP + 32 * ks + 8 * fq); acc[bt] = __builtin_amdgcn_mfma_f32_16x16x32_bf16(af, bfr, acc[bt], 0, 0, 0); } }
#pragma unroll
                for (int bt = 0; bt < 3; ++bt) { const int bi = 16 * bt + fr; if (bi < NBIDX) *(f32x4*)(dst + (size_t)bi * nrows + n0 + 4 * fq) = acc[bt]; } }
        }
        __syncthreads();
        for (int c = 0; c < 2; ++c) {
            pg8::Gemm g{(const bf16_t*)(ws + WS_ACS) + (size_t)c * 32768 * 1024, (const bf16_t*)(ws + WS_WC1) + (size_t)c * 256 * 1024, 32768, 256, DM};
            pg8::StaticOrder S; S.init(32768, 256, X.G, (int)((blockIdx.x + (c ? X.G - 128 : 0)) % X.G));
            pg8::EpiStoreBf16 E{(bf16_t*)(ws + WS_PCS) + (size_t)c * 32768 * 256, 256};
            pg8::gemm_phase(X.lds, g, S, E);
        }
        if (BOTH(1)) GRID_BAR();
    }

    if (MK_PH_ON(2) && IN(2)) for (int rep_ = 0; rep_ < MK_NREP(2); ++rep_) { if (rep_) GRID_BAR();
        pg8::Gemm g{(const bf16_t*)(ws + WS_A1), (const bf16_t*)(ws + WS_WGU1), MPAD, NGU, DM}; pg8::StaticOrder S; S.init(MPAD, NGU, X.G, (int)blockIdx.x);
        pg8::EpiGU E{(bf16_t*)(ws + WS_ACT), nullptr, nullptr, 0, nullptr};
        pg8::gemm_phase(X.lds, g, S, E);
        if (BOTH(2)) GRID_BAR();
    }
    if (MK_PH_ON(3) && IN(3)) for (int rep_ = 0; rep_ < MK_NREP(3); ++rep_) { if (rep_) GRID_BAR();
        pg8::Gemm g{(const bf16_t*)(ws + WS_ACT), (const bf16_t*)(ws + WS_WD1), MP, DM, DFF}; pg8::StaticOrder S; S.init(MP, DM, X.G, (int)blockIdx.x);
        float* H1 = (float*)(ws + WS_H1);
        pg8::EpiRes<true> E{x_p, x_s, H1, H1 + (size_t)MP * DM, modv, 0, (bf16_t*)(ws + WS_A2), args.in[11] + DM, 1, (float*)(ws + WS_SSQ2), (float*)(ws + WS_SSQS2), 0.5f};
        thin_gemm(X, (const bf16_t*)(ws + WS_ACT) + (size_t)MP * DFF, (const bf16_t*)(ws + WS_WD1), DFF, 4, E);
        pg8::gemm_phase(X.lds, g, S, E);
        if (BOTH(3)) GRID_BAR();
    }
    if (MK_PH_ON(4) && IN(4)) for (int rep_ = 0; rep_ < MK_NREP(4); ++rep_) { if (rep_) GRID_BAR();
        pg8::Gemm g{(const bf16_t*)(ws + WS_A2), (const bf16_t*)(ws + WS_WIN), MP, INWP, DM}; pg8::StaticOrder S; S.init(MP, INWP, X.G, (int)blockIdx.x);
        EpiIn E{(const float*)(ws + WS_SSQ2), (const float*)(ws + WS_SSQS2), (const float*)(ws + WS_SW2), out, ws};
        thin_gemm(X, (const bf16_t*)(ws + WS_A2) + (size_t)MP * DM, (const bf16_t*)(ws + WS_WIN), DM, 20, E);
        pg8::gemm_phase(X.lds, g, S, E);
        if (BOTH(4)) GRID_BAR();
    }
    if (MK_PH_ON(5) && IN(5)) for (int rep_ = 0; rep_ < MK_NREP(5); ++rep_) { if (rep_) GRID_BAR();
        for (int c = 0; c < 2; ++c) {
            pg8::EpiStoreBf16 E{(bf16_t*)(ws + WS_PCP) + (size_t)c * 2048 * 256, 256};
            thin_gemm(X, (const bf16_t*)(ws + WS_ACP) + (size_t)c * 2048 * 1024, (const bf16_t*)(ws + WS_WC1) + (size_t)c * 256 * 1024, DM, 1, E, 64, 0, 0);
        }
        __syncthreads();
        { const bf16_t* PROD = (const bf16_t*)(ws + WS_PROD); const bf16_t* CBb = (const bf16_t*)(ws + WS_CB); bf16_t* ACAT = (bf16_t*)(ws + WS_ACAT);
          const float* wcv = args.in[20]; const float* stc = args.in[5]; const int j = X.lane * 8;
          float w0[8], w1[8], w2[8];
#pragma unroll
          for (int e = 0; e < 8; ++e) { w0[e] = wcv[j + e]; w1[e] = wcv[512 + j + e]; w2[e] = wcv[1024 + j + e]; }
          for (int m = X.gw; m < MTOT; m += X.NGW) {
              const bool isp = m < MP; const int t = isp ? (m & (TP - 1)) : ((m - MP) & 3), bs = isp ? 0 : ((m - MP) >> 2);
              const u32x4 v0 = *(const u32x4*)(PROD + (size_t)m * 512 + j), c4 = *(const u32x4*)(CBb + (size_t)m * 512 + j);
              const u32x4 v1 = *(const u32x4*)(PROD + (size_t)max(m - 1, 0) * 512 + j), v2 = *(const u32x4*)(PROD + (size_t)max(m - 2, 0) * 512 + j);
              const f32x4 s1a = *(const f32x4*)(stc + ((size_t)bs * 2 + 1) * 512 + j), s1b = *(const f32x4*)(stc + ((size_t)bs * 2 + 1) * 512 + j + 4);
              const f32x4 s2a = *(const f32x4*)(stc + ((size_t)bs * 2 + (t & 1)) * 512 + j), s2b = *(const f32x4*)(stc + ((size_t)bs * 2 + (t & 1)) * 512 + j + 4);
              float a2[8], a1[8], a0[8], cbv[8];
#pragma unroll
              for (int e = 0; e < 4; ++e) { a0[2 * e] = bflo(v0[e]); a0[2 * e + 1] = bfhi(v0[e]); cbv[2 * e] = bflo(c4[e]); cbv[2 * e + 1] = bfhi(c4[e]);
                  a1[2 * e] = bflo(v1[e]); a1[2 * e + 1] = bfhi(v1[e]); a2[2 * e] = bflo(v2[e]); a2[2 * e + 1] = bfhi(v2[e]); }
              if (t < 1) {
#pragma unroll
                  for (int e = 0; e < 8; ++e) a1[e] = isp ? 0.f : (e < 4 ? s1a[e] : s1b[e - 4]); }
              if (t < 2) {
#pragma unroll
                  for (int e = 0; e < 8; ++e) a2[e] = isp ? 0.f : (e < 4 ? s2a[e] : s2b[e - 4]); }
              float y[8];
#pragma unroll
              for (int e = 0; e < 8; ++e) y[e] = cbv[e] * (w0[e] * a2[e] + w1[e] * a1[e] + w2[e] * a0[e]);
              u32x4 w; w.x = pk2(y[0], y[1]); w.y = pk2(y[2], y[3]); w.z = pk2(y[4], y[5]); w.w = pk2(y[6], y[7]);
              *(u32x4*)(ACAT + (size_t)m * DM + 512 + j) = w; } }
        { int cl = -1; for (int it = X.vcu; it < 2 * 64 * 8; it += X.G) cmp_tail_item<true>(X, it, ws, args.in[18], cl); }
        if (BOTH(5)) GRID_BAR();
    }
    if (MK_PH_ON(6) && IN(6)) for (int rep_ = 0; rep_ < MK_NREP(6); ++rep_) { if (rep_) GRID_BAR();
        { int cl = -1; for (int it = X.vcu; it < 2 * 8 * 4; it += X.G) cmp_tail_item<false>(X, it, ws, args.in[18], cl); }
        if (BOTH(6)) GRID_BAR();
    }
    if (MK_PH_ON(7) && IN(7)) {
        for (int i = X.vcu; i < 512 * MK_NREP(7) * MK_NREP(70); i += X.G) { const int ii = i & 255; const int bg = ii >> 5, qt = ((i & 256) == 0) ? (ii & 31) : 63 - (ii & 31); att::prompt_item(X, bg, qt, ws, args.in[24]); }
        for (int i = X.vcu; i < 256 * MK_NREP(7) * MK_NREP(71); i += X.G) att::sample_item(X, i & 255, ws, args);
        if (BOTH(7)) GRID_BAR();
    }
#if MK_CHECK
    if (IN(8)) { for (int i = X.vcu; i < 256; i += X.G) att::check_item(X, i, ws, args.in[24], (unsigned*)(ctl + 64));
        GRID_BAR();
        const unsigned nbad = __hip_atomic_load((unsigned*)(ctl + 64), __ATOMIC_RELAXED, __HIP_MEMORY_SCOPE_AGENT);
        if (nbad > MK_CHECK_MAXBAD) { for (int i = X.gw * 64 + X.lane; i < MS * DM; i += X.NGW * 64) out[O_Y + (size_t)MP * DM + i] = 1000.0f; } }
#endif
    if (MK_PH_ON(8) && IN(8)) for (int rep_ = 0; rep_ < MK_NREP(8); ++rep_) { if (rep_) GRID_BAR();
        pg8::Gemm g{(const bf16_t*)(ws + WS_ACAT), (const bf16_t*)(ws + WS_WM), MP, DM, DM}; pg8::StaticOrder S; S.init(MP, DM, X.G, (int)blockIdx.x);
        EpiMerge E{8, (const bf16_t*)(ws + WS_RATIO), (const bf16_t*)(ws + WS_GB), (bf16_t*)(ws + WS_MERGED)};
        thin_gemm(X, (const bf16_t*)(ws + WS_ACAT) + (size_t)MP * DM, (const bf16_t*)(ws + WS_WM), DM, 4, E);
        pg8::gemm_phase(X.lds, g, S, E);
        if (BOTH(8)) GRID_BAR();
    }
    if (MK_PH_ON(9) && IN(9)) for (int rep_ = 0; rep_ < MK_NREP(9); ++rep_) { if (rep_) GRID_BAR();
        pg8::Gemm g{(const bf16_t*)(ws + WS_MERGED), (const bf16_t*)(ws + WS_WO), MP, DM, DM}; pg8::StaticOrder S; S.init(MP, DM, X.G, (int)blockIdx.x);
        float* H1 = (float*)(ws + WS_H1);
        pg8::EpiRes<true> E{H1, H1 + (size_t)MP * DM, H1, H1 + (size_t)MP * DM, modv, 1, (bf16_t*)(ws + WS_A3), args.in[11] + 2 * DM, 2, (float*)(ws + WS_SSQ3), (float*)(ws + WS_SSQS3), 1.0f};
        thin_gemm(X, (const bf16_t*)(ws + WS_MERGED) + (size_t)MP * DM, (const bf16_t*)(ws + WS_WO), DM, 4, E);
        pg8::gemm_phase(X.lds, g, S, E);
        if (BOTH(9)) GRID_BAR();
    }
    if (MK_PH_ON(10) && IN(10)) for (int rep_ = 0; rep_ < MK_NREP(10); ++rep_) { if (rep_) GRID_BAR();
        pg8::Gemm g{(const bf16_t*)(ws + WS_A3), (const bf16_t*)(ws + WS_WGU2), MPAD, NGU, DM}; pg8::StaticOrder S; S.init(MPAD, NGU, X.G, (int)blockIdx.x);
        pg8::EpiGU E{(bf16_t*)(ws + WS_ACT), (const float*)(ws + WS_SSQ3), (const float*)(ws + WS_SW3), NGU, (const float*)(ws + WS_SSQS3)};
        pg8::gemm_phase(X.lds, g, S, E);
        if (BOTH(10)) GRID_BAR();
    }
    if (MK_PH_ON(11) && IN(11)) for (int rep_ = 0; rep_ < MK_NREP(11); ++rep_) { if (rep_) GRID_BAR();
        pg8::Gemm g{(const bf16_t*)(ws + WS_ACT), (const bf16_t*)(ws + WS_WD2), MP, DM, DFF}; pg8::StaticOrder S; S.init(MP, DM, X.G, (int)blockIdx.x);
        float* H1 = (float*)(ws + WS_H1);
        pg8::EpiRes<false> E{H1, H1 + (size_t)MP * DM, out + O_Y, out + O_Y + (size_t)MP * DM, modv, 2, nullptr, nullptr, 0, nullptr, nullptr, 0.5f};
        thin_gemm(X, (const bf16_t*)(ws + WS_ACT) + (size_t)MP * DFF, (const bf16_t*)(ws + WS_WD2), DFF, 4, E);
        pg8::gemm_phase(X.lds, g, S, E);
        if (BOTH(11)) GRID_BAR();
    }
    if (MK_PH_ON(12) && IN(12)) for (int rep_ = 0; rep_ < MK_NREP(12); ++rep_) { if (rep_) GRID_BAR();
        const f32x4* gf = (const f32x4*)args.in[25] + X.lane;
        for (int m = X.gw; m < MTOT; m += X.NGW) { f32x4* y4 = (f32x4*)(out + O_Y + (size_t)m * DM) + X.lane; f32x4 v[4]; float s = 0.f;
#pragma unroll
            for (int j = 0; j < 4; ++j) { v[j] = y4[64 * j]; s += (v[j][0] * v[j][0] + v[j][1] * v[j][1]) + (v[j][2] * v[j][2] + v[j][3] * v[j][3]); }
#pragma unroll
            for (int off = 1; off < 64; off <<= 1) s += __shfl_xor(s, off);
            const float rt = 1.0f / sqrtf(s * (1.0f / DM) + EPS);
#pragma unroll
            for (int j = 0; j < 4; ++j) y4[64 * j] = v[j] * rt * gf[64 * j]; }
    }
#if MK_PROBE
    if (IN(13)) { f32x4* o4 = (f32x4*)(out + O_KVC_P); const size_t n4 = (O_TOTAL - O_KVC_P) / 4;
        for (size_t i = (size_t)X.gw * 64 + X.lane; i < n4; i += (size_t)X.NGW * 64) o4[i] = o4[i] * 3.0f; }
#endif
#undef IN
#undef BOTH
}

extern "C" void kernel_launch(void* const* d_in, const int* in_sizes, int n_in, void* d_out, int out_size, void* d_ws, size_t ws_size, hipStream_t stream) {
    static int grid = 0;
    if (grid == 0) {
        if (n_in != 26 || out_size != (int)O_TOTAL || ws_size < WS_END) { fprintf(stderr, "kernel_launch: unexpected shapes n_in %d out %d ws %zu\n", n_in, out_size, ws_size); grid = -1; return; }
        int dev = 0, cus = 0;
        if (hipGetDevice(&dev) != hipSuccess || hipDeviceGetAttribute(&cus, hipDeviceAttributeMultiprocessorCount, dev) != hipSuccess) { grid = -1; return; }
        if (hipFuncSetAttribute((const void*)nsa_fwd, hipFuncAttributeMaxDynamicSharedMemorySize, LDS_BYTES) != hipSuccess) { fprintf(stderr, "kernel_launch: hipFuncSetAttribute failed\n"); grid = -1; return; }
        int per_cu = 0;
        if (hipOccupancyMaxActiveBlocksPerMultiprocessor(&per_cu, (const void*)nsa_fwd, NTHR, LDS_BYTES) != hipSuccess || per_cu < 1) fprintf(stderr, "kernel_launch: occupancy query says %d\n", per_cu);
        (void)hipGetLastError();
        grid = cus;
    }
    if (grid < 0) return;
    (void)hipMemsetAsync((char*)d_ws + WS_CTL, 0, CTL_ZERO_BYTES, stream);
    Args a{};
    for (int i = 0; i < 26; ++i) a.in[i] = (const float*)d_in[i];
    a.out = (float*)d_out; a.ws = (unsigned char*)d_ws;
    constexpr int NPH = MK_LAST_PHASE + 1 + (MK_PROBE ? 1 : 0);
#if MK_PER_PHASE
    for (int p = (MK_PROBE ? -1 : 0); p < NPH; ++p) { a.ph_lo = p; a.ph_hi = p + 1; a.li = 0; hipLaunchKernelGGL(nsa_fwd, dim3(grid), dim3(NTHR), LDS_BYTES, stream, a); }
#else
    a.ph_lo = 0; a.ph_hi = NPH; a.li = 0; hipLaunchKernelGGL(nsa_fwd, dim3(grid), dim3(NTHR), LDS_BYTES, stream, a);
#endif
}
```
